# Optimizing an MI355X kernel written in HIP

```python
import jax, jax.numpy as jnp
from jax import lax
import numpy as np

D_MODEL = 2048
BATCH = 8
SEQ = 2048
DEPTH = 1

GRID_W = 64
CTX_LEN = 256
D_MIX = D_MODEL
D_MLSTM = D_MIX // 2
D_CMLP = D_MIX - D_MLSTM
MLSTM_HEADS = 4
MLSTM_HD = D_MLSTM // MLSTM_HEADS
MLSTM_CHUNK = 128
CONV_K = 3
CMLP_GROUPS = 4
CMLP_GD = D_CMLP // CMLP_GROUPS
CMLP_CHUNK = 128
N_GROUPS = 4
EXPERTS_PER_GROUP = 8
N_EXPERTS = N_GROUPS * EXPERTS_PER_GROUP
TOP_K_INNER = 2
D_EXPERT = D_MODEL // 2
MOE_BLOCK = 128
N_MOD = 6
N_GATE_COLS = 4 * MLSTM_HEADS
D_IN = 4 * D_MLSTM + N_GATE_COLS + 2 * D_CMLP
DEEPNORM_ALPHA = (2.0 * DEPTH) ** 0.25
DEEPNORM_BETA = (8.0 * DEPTH) ** -0.25
LN_EPS = 1e-6

kernel_name = 'hybrid_mlstm_chunkmlp_hmoe_dit_block'

F32 = jnp.float32


def _layer_norm(x, w, b):
    xf = x.astype(F32)
    mu = xf.mean(-1, keepdims=True)
    var = jnp.mean(jnp.square(xf - mu), -1, keepdims=True)
    y = (xf - mu) * lax.rsqrt(var + LN_EPS)
    return (y * w.astype(F32) + b.astype(F32)).astype(x.dtype)


def _grid_pos_embed(rows):
    r = jnp.repeat(jnp.arange(rows, dtype=F32), GRID_W)
    col = jnp.tile(jnp.arange(GRID_W, dtype=F32), rows)
    quarter = D_MODEL // 4
    omega = 1.0 / (10000.0 ** (jnp.arange(quarter, dtype=F32) / quarter))
    ar = r[:, None] * omega
    ac = col[:, None] * omega
    return jnp.concatenate([jnp.sin(ar), jnp.cos(ar), jnp.sin(ac), jnp.cos(ac)], -1)


def _dwconv_centred(x, w, b):
    ch = x.shape[-1]
    y = lax.conv_general_dilated(x, w[:, None, :].astype(x.dtype), window_strides=(1,),
                                 padding=[(CONV_K // 2, CONV_K // 2)],
                                 dimension_numbers=('NWC', 'WIO', 'NWC'), feature_group_count=ch)
    return y + b.astype(x.dtype)


def _heads(t):
    bsz, n, _ = t.shape
    return t.reshape(bsz, n, MLSTM_HEADS, MLSTM_HD).transpose(0, 2, 1, 3)


def _stream_proj(h, w_in, conv_w, conv_b, gate_bias):
    bsz, n, _ = h.shape
    p = jnp.einsum('bld,de->ble', h, w_in)
    dm = D_MLSTM
    qk = jax.nn.silu(_dwconv_centred(p[..., :2 * dm], conv_w, conv_b))
    q = _heads(qk[..., :dm])
    k = _heads(qk[..., dm:]) * (MLSTM_HD ** -0.5)
    v = _heads(p[..., 2 * dm:3 * dm])
    o = p[..., 3 * dm:4 * dm]
    g = p[..., 4 * dm:4 * dm + N_GATE_COLS].astype(F32).reshape(bsz, n, 4, MLSTM_HEADS)
    g = (g + gate_bias.astype(F32)).transpose(2, 0, 3, 1)
    gates = (g[0], jax.nn.log_sigmoid(g[1]), g[2], jax.nn.log_sigmoid(g[3]))
    uv = jax.nn.gelu(p[..., 4 * dm + N_GATE_COLS:])
    return q, k, v, o, gates, uv[..., :D_CMLP], uv[..., D_CMLP:]


def _zero_state(bsz):
    return (jnp.zeros((bsz, MLSTM_HEADS, MLSTM_HD, MLSTM_HD), F32),
            jnp.zeros((bsz, MLSTM_HEADS, MLSTM_HD), F32),
            jnp.zeros((bsz, MLSTM_HEADS), F32))


def _chunk_states(k, v, log_i, log_f, state):
    bsz, nh, n, dh = k.shape
    nc = n // MLSTM_CHUNK
    kc = k.astype(F32).reshape(bsz, nh, nc, MLSTM_CHUNK, dh)
    vc = v.astype(F32).reshape(bsz, nh, nc, MLSTM_CHUNK, dh)
    li = log_i.reshape(bsz, nh, nc, MLSTM_CHUNK)
    b = lax.cumsum(log_f.reshape(bsz, nh, nc, MLSTM_CHUNK), axis=3)
    b_last = b[..., -1]
    a = b_last[..., None] - b + li
    m_loc = a.max(-1)
    w = jnp.exp(a - m_loc[..., None])
    c_loc = jnp.einsum('bhcsd,bhcse->bhcde', vc * w[..., None], kc)
    n_loc = jnp.einsum('bhcs,bhcse->bhce', w, kc)

    def step(carry, inp):
        cm, nv, m = carry
        cl, nl, ml, bl = inp
        m_new = jnp.maximum(bl + m, ml)
        s_old = jnp.exp(bl + m - m_new)
        s_loc = jnp.exp(ml - m_new)
        c_new = s_old[..., None, None] * cm + s_loc[..., None, None] * cl
        n_new = s_old[..., None] * nv + s_loc[..., None] * nl
        return (c_new, n_new, m_new), (cm, nv, m)

    xs = (jnp.moveaxis(c_loc, 2, 0), jnp.moveaxis(n_loc, 2, 0),
          jnp.moveaxis(m_loc, 2, 0), jnp.moveaxis(b_last, 2, 0))
    final, (c_in, n_in, m_in) = lax.scan(step, state, xs)
    c_in = jnp.moveaxis(c_in, 0, 2)
    n_in = jnp.moveaxis(n_in, 0, 2)
    m_in = jnp.moveaxis(m_in, 0, 2)
    return kc, vc, li, b, c_in, n_in, m_in, final


def _mlstm_core(q, k, v, log_i, log_f, state):
    kc, vc, li, b, c_in, n_in, m_in, final = _chunk_states(k, v, log_i, log_f, state)
    bsz, nh, nc, lc, dh = kc.shape
    qc = q.astype(F32).reshape(bsz, nh, nc, lc, dh)
    order = jnp.tril(jnp.ones((lc, lc), bool))
    dmat = jnp.where(order, b[..., :, None] - b[..., None, :] + li[..., None, :], -jnp.inf)
    inter = b + m_in[..., None]
    m_t = jnp.maximum(inter, dmat.max(-1))
    s_inter = jnp.exp(inter - m_t)
    pmat = jnp.exp(dmat - m_t[..., None]) * jnp.einsum('bhctd,bhcsd->bhcts', qc, kc)
    num = (jnp.einsum('bhcts,bhcsd->bhctd', pmat, vc)
           + s_inter[..., None] * jnp.einsum('bhcde,bhcte->bhctd', c_in, qc))
    den = pmat.sum(-1) + s_inter * jnp.einsum('bhce,bhcte->bhct', n_in, qc)
    h = num / jnp.maximum(jnp.abs(den), jnp.exp(-m_t))[..., None]
    return h.reshape(bsz, nh, nc * lc, dh), final


def _flip(t):
    return jnp.flip(t, axis=2)


def _mlstm_bidir(q, k, v, gates, init_f, init_b):
    li_f, lf_f, li_b, lf_b = gates
    h_f, fin_f = _mlstm_core(q, k, v, li_f, lf_f, init_f)
    h_b, fin_b = _mlstm_core(_flip(q), _flip(k), _flip(v), _flip(li_b), _flip(lf_b), init_b)
    return h_f + _flip(h_b), fin_f, fin_b


def _mlstm_bidir_final(k, v, gates, init):
    li_f, lf_f, li_b, lf_b = gates
    fin_f = _chunk_states(k, v, li_f, lf_f, init)[-1]
    fin_b = _chunk_states(_flip(k), _flip(v), _flip(li_b), _flip(lf_b), init)[-1]
    return fin_f, fin_b


def _chunk_mlp(u, vg, norm_w, w_s, b_s):
    bsz, n, _ = u.shape
    shp = (bsz, n // CMLP_CHUNK, CMLP_CHUNK, CMLP_GROUPS, CMLP_GD)
    vf = vg.astype(F32).reshape(shp)
    mu = vf.mean(-1, keepdims=True)
    var = jnp.mean(jnp.square(vf - mu), -1, keepdims=True)
    vn = ((vf - mu) * lax.rsqrt(var + LN_EPS) * norm_w.astype(F32).reshape(CMLP_GROUPS, CMLP_GD)).astype(u.dtype)
    s = jnp.einsum('gpq,bcqgd->bcpgd', w_s, vn) + b_s.T[:, :, None]
    return (u.reshape(shp) * s).reshape(bsz, n, D_CMLP)


def _mixer_out(h_m, o, u, vg, mlstm_norm_w, cmlp_norm_w, w_s, b_s, w_out):
    bsz, nh, n, dh = h_m.shape
    mu = h_m.mean(-1, keepdims=True)
    var = jnp.mean(jnp.square(h_m - mu), -1, keepdims=True)
    hn = (h_m - mu) * lax.rsqrt(var + LN_EPS) * mlstm_norm_w.astype(F32).reshape(nh, 1, dh)
    hn = hn.transpose(0, 2, 1, 3).reshape(bsz, n, D_MLSTM).astype(o.dtype)
    y_m = hn * jax.nn.sigmoid(o)
    y_c = _chunk_mlp(u, vg, cmlp_norm_w, w_s, b_s)
    return jnp.einsum('ble,ed->bld', jnp.concatenate([y_m, y_c], -1), w_out)


def _hier_moe(h, r1_w, r1_b, r2_w, r2_b, w_gate, w_up, w_down):
    lead = h.shape[:-1]
    t = h.reshape(-1, D_MODEL)
    n_tok = t.shape[0]
    logits1 = (t @ r1_w + r1_b).astype(F32)
    grp = jnp.argmax(logits1, -1)
    p_grp = jnp.take_along_axis(jax.nn.softmax(logits1, -1), grp[:, None], -1)[:, 0]
    logits2 = (t @ r2_w + r2_b).astype(F32).reshape(n_tok, N_GROUPS, EXPERTS_PER_GROUP)
    l2 = jnp.take_along_axis(logits2, grp[:, None, None], 1)[:, 0]
    top_v, top_i = lax.top_k(l2, TOP_K_INNER)
    gate = p_grp[:, None] * jax.nn.softmax(top_v, -1)
    expert = grp[:, None] * EXPERTS_PER_GROUP + top_i
    n_asg = n_tok * TOP_K_INNER
    e_flat = expert.reshape(-1).astype(jnp.int32)
    tok = jnp.repeat(jnp.arange(n_tok, dtype=jnp.int32), TOP_K_INNER)
    order = jnp.argsort(e_flat)
    e_s, tok_s, g_s = e_flat[order], tok[order], gate.reshape(-1)[order]
    counts = jnp.zeros((N_EXPERTS,), jnp.int32).at[e_flat].add(1)
    start = jnp.cumsum(counts) - counts
    padded = (counts + MOE_BLOCK - 1) // MOE_BLOCK * MOE_BLOCK
    pad_end = jnp.cumsum(padded)
    pad_start = pad_end - padded
    pos = pad_start[e_s] + (jnp.arange(n_asg, dtype=jnp.int32) - start[e_s])
    n_blk = (n_asg + MOE_BLOCK - 1) // MOE_BLOCK + N_EXPERTS
    xp = jnp.zeros((n_blk * MOE_BLOCK, D_MODEL), t.dtype).at[pos].set(t[tok_s])
    blk_e = jnp.minimum(jnp.searchsorted(pad_end, jnp.arange(n_blk, dtype=jnp.int32) * MOE_BLOCK, side='right'),
                        N_EXPERTS - 1)

    def expert_block(args):
        xb, e = args
        return (jax.nn.silu(xb @ w_gate[e]) * (xb @ w_up[e])) @ w_down[e]

    yp = lax.map(expert_block, (xp.reshape(n_blk, MOE_BLOCK, D_MODEL), blk_e))
    ys = yp.reshape(n_blk * MOE_BLOCK, D_MODEL)[pos] * g_s[:, None].astype(t.dtype)
    out = jax.ops.segment_sum(ys, tok_s, num_segments=n_tok)
    return out.reshape(*lead, D_MODEL)


def setup_inputs(seed: int = 0) -> dict:
    key = jax.random.key(seed)
    ks = jax.random.split(key, 32)
    dm = D_MODEL

    def nrm(k, shape, s):
        return jax.random.normal(k, shape, F32) * s

    f_bias = jnp.linspace(3.0, 6.0, MLSTM_HEADS, dtype=F32)
    i_bias = jnp.zeros((MLSTM_HEADS,), F32)
    gate_base = jnp.stack([i_bias, f_bias, i_bias, f_bias])
    return {
        'x': nrm(ks[0], (BATCH, SEQ, dm), 1.0),
        'c': nrm(ks[1], (BATCH, dm), 1.0),
        'ctx': nrm(ks[2], (BATCH, CTX_LEN, dm), 1.0),
        'c_ctx': nrm(ks[3], (dm,), 1.0),
        'w_mod': nrm(ks[4], (DEPTH, dm, N_MOD * dm), 0.5 * dm ** -0.5),
        'b_mod': nrm(ks[5], (DEPTH, N_MOD * dm), 0.01),
        'w_in': nrm(ks[6], (DEPTH, dm, D_IN), dm ** -0.5),
        'conv_w': nrm(ks[7], (DEPTH, CONV_K, 2 * D_MLSTM), CONV_K ** -0.5),
        'conv_b': nrm(ks[8], (DEPTH, 2 * D_MLSTM), 0.01),
        'gate_bias': gate_base[None] + nrm(ks[9], (DEPTH, 4, MLSTM_HEADS), 0.1),
        'mlstm_norm_w': 1.0 + nrm(ks[10], (DEPTH, D_MLSTM), 0.02),
        'cmlp_norm_w': 1.0 + nrm(ks[11], (DEPTH, D_CMLP), 0.02),
        'w_s': nrm(ks[12], (DEPTH, CMLP_GROUPS, CMLP_CHUNK, CMLP_CHUNK), CMLP_CHUNK ** -0.5),
        'b_s': 1.0 + nrm(ks[13], (DEPTH, CMLP_GROUPS, CMLP_CHUNK), 0.02),
        'w_out': nrm(ks[14], (DEPTH, D_MIX, dm), DEEPNORM_BETA * D_MIX ** -0.5),
        'ln1_w': 1.0 + nrm(ks[15], (DEPTH, dm), 0.02),
        'ln1_b': nrm(ks[16], (DEPTH, dm), 0.02),
        'router1_w': nrm(ks[17], (DEPTH, dm, N_GROUPS), dm ** -0.5),
        'router1_b': nrm(ks[18], (DEPTH, N_GROUPS), 0.01),
        'router2_w': nrm(ks[19], (DEPTH, dm, N_EXPERTS), dm ** -0.5),
        'router2_b': nrm(ks[20], (DEPTH, N_EXPERTS), 0.01),
        'w_gate': nrm(ks[21], (DEPTH, N_EXPERTS, dm, D_EXPERT), dm ** -0.5),
        'w_up': nrm(ks[22], (DEPTH, N_EXPERTS, dm, D_EXPERT), dm ** -0.5),
        'w_down': nrm(ks[23], (DEPTH, N_EXPERTS, D_EXPERT, dm), DEEPNORM_BETA * D_EXPERT ** -0.5),
        'ln2_w': 1.0 + nrm(ks[24], (DEPTH, dm), 0.02),
        'ln2_b': nrm(ks[25], (DEPTH, dm), 0.02),
    }


def reference(x, c, ctx, c_ctx, w_mod, b_mod, w_in, conv_w, conv_b, gate_bias,
              mlstm_norm_w, cmlp_norm_w, w_s, b_s, w_out, ln1_w, ln1_b,
              router1_w, router1_b, router2_w, router2_b, w_gate, w_up, w_down,
              ln2_w, ln2_b):
    bsz, n_lat, dm = x.shape
    rows = n_lat // GRID_W
    x = x + _grid_pos_embed(rows).astype(x.dtype)[None]
    for layer in range(DEPTH):
        last = layer == DEPTH - 1
        mod_x = (jax.nn.silu(c) @ w_mod[layer] + b_mod[layer]).reshape(bsz, N_MOD, 1, dm)
        mod_c = (jax.nn.silu(c_ctx) @ w_mod[layer] + b_mod[layer]).reshape(N_MOD, 1, dm)
        hx = x * (1 + mod_x[:, 1]) + mod_x[:, 0]
        hc = ctx * (1 + mod_c[1]) + mod_c[0]
        qx, kx, vx, ox, gx, ux, vgx = _stream_proj(hx, w_in[layer], conv_w[layer], conv_b[layer], gate_bias[layer])
        qc, kc, vc, oc, gc, uc, vgc = _stream_proj(hc, w_in[layer], conv_w[layer], conv_b[layer], gate_bias[layer])
        zero = _zero_state(bsz)
        if last:
            fin_f, fin_b = _mlstm_bidir_final(kc, vc, gc, zero)
        else:
            hm_c, fin_f, fin_b = _mlstm_bidir(qc, kc, vc, gc, zero, zero)
        hm_x, _, _ = _mlstm_bidir(qx, kx, vx, gx, fin_f, fin_b)
        y = _mixer_out(hm_x, ox, ux, vgx, mlstm_norm_w[layer], cmlp_norm_w[layer], w_s[layer], b_s[layer], w_out[layer])
        x = _layer_norm(DEEPNORM_ALPHA * x + mod_x[:, 2] * y, ln1_w[layer], ln1_b[layer])
        y = _hier_moe(x * (1 + mod_x[:, 4]) + mod_x[:, 3], router1_w[layer], router1_b[layer],
                      router2_w[layer], router2_b[layer], w_gate[layer], w_up[layer], w_down[layer])
        x = _layer_norm(DEEPNORM_ALPHA * x + mod_x[:, 5] * y, ln2_w[layer], ln2_b[layer])
        if not last:
            yc = _mixer_out(hm_c, oc, uc, vgc, mlstm_norm_w[layer], cmlp_norm_w[layer], w_s[layer], b_s[layer], w_out[layer])
            ctx = _layer_norm(DEEPNORM_ALPHA * ctx + mod_c[2] * yc, ln1_w[layer], ln1_b[layer])
            yc = _hier_moe(ctx * (1 + mod_c[4]) + mod_c[3], router1_w[layer], router1_b[layer],
                           router2_w[layer], router2_b[layer], w_gate[layer], w_up[layer], w_down[layer])
            ctx = _layer_norm(DEEPNORM_ALPHA * ctx + mod_c[5] * yc, ln2_w[layer], ln2_b[layer])
    return x
```

```cpp
#include <hip/hip_runtime.h>
#include <cstdio>
#include <cstdint>

typedef unsigned short bf16_t;

constexpr int DM = 2048, NB = 8, SEQ = 2048, CTXL = 256;
constexpr int NTOK = NB * SEQ;
constexpr int NCTX = NB * CTXL;
constexpr int NROWS = NTOK + NCTX;
constexpr int DIN = 6160, DML = 1024, NH = 4, HD = 256, CHK = 128;
constexpr int NGATE = 16;
constexpr int PW = 6144;
constexpr int NE = 32, DE = 1024;
constexpr int NMOD = 6;
constexpr float ALPHA = 1.189207115002721f;
constexpr float LN_EPS = 1e-6f;
constexpr int HCAP = 40960;

constexpr size_t al256(size_t x) { return (x + 255) & ~(size_t)255; }
constexpr size_t WS_CTL   = 0;
constexpr size_t CTL_BYTES = 65536;
constexpr size_t WS_MOD   = WS_CTL + CTL_BYTES;
constexpr size_t MOD_BYTES = al256((size_t)9 * NMOD * DM * 4);
constexpr size_t WS_STATS = WS_MOD + MOD_BYTES;
constexpr size_t WS_ZERO_END = WS_STATS + al256((size_t)NTOK * 2 * 4);
constexpr size_t WS_POS   = WS_ZERO_END;
constexpr size_t WS_HX    = WS_POS + al256((size_t)96 * 1024 * 4);
constexpr size_t WS_GATES = WS_HX + al256((size_t)NROWS * DM * 2);
constexpr size_t WS_P     = WS_GATES + al256((size_t)NROWS * NGATE * 4);
constexpr size_t WS_PC    = WS_P + al256((size_t)NTOK * PW * 2);
constexpr size_t WS_YCAT  = WS_PC + al256((size_t)NCTX * 2048 * 2);
constexpr size_t WS_T     = WS_YCAT;
constexpr size_t WS_X1    = WS_YCAT + al256((size_t)NTOK * DM * 2);
constexpr size_t WS_LIST  = WS_X1 + al256((size_t)NTOK * DM * 4);
constexpr size_t WS_RT    = WS_LIST + al256((size_t)NE * NTOK * 4);
constexpr size_t WS_H     = WS_P;
constexpr size_t WS_Y2    = WS_RT + al256((size_t)NTOK * 2 * 4);
constexpr size_t WS_HDIR  = WS_Y2;
constexpr size_t WS_BTIN  = WS_Y2 + al256((size_t)NTOK * 2 * DM * 2);
constexpr size_t WS_BTOUT = WS_BTIN + al256((size_t)PW * DM * 2);
constexpr size_t WS_BTGU  = WS_BTOUT + al256((size_t)DM * DM * 2);
constexpr size_t WS_BTDN  = WS_BTGU + al256((size_t)NE * 2 * DE * DM * 2);
constexpr size_t WS_NST   = WS_BTDN + al256((size_t)NE * DM * DE * 2);
constexpr size_t WS_MST   = WS_NST + al256((size_t)64 * 16 * 256 * 4);
constexpr size_t WS_CST   = WS_Y2;
constexpr size_t WS_RWT   = WS_MST + al256((size_t)64 * 16 * 4);
constexpr size_t WS_RWH   = WS_RWT + al256((size_t)36 * DM * 4);
constexpr size_t WS_HX8   = WS_RWH + al256((size_t)2 * 48 * DM * 2);
constexpr size_t WS_WGT   = WS_HX8 + al256((size_t)NTOK * DM);
constexpr size_t WS_END   = WS_WGT + al256((size_t)NGATE * DM * 4);

constexpr int CW_CNT = 0;

struct Params {
    const float *x, *c, *ctx, *c_ctx, *w_mod, *b_mod, *w_in, *conv_w, *conv_b, *gate_bias, *mlstm_norm_w, *cmlp_norm_w, *w_s, *b_s, *w_out,
                *ln1_w, *ln1_b, *r1_w, *r1_b, *r2_w, *r2_b, *w_gate, *w_up, *w_down, *ln2_w, *ln2_b;
    float* out;
    unsigned char* ws;
};

__device__ __forceinline__ bf16_t f2bf(float f) { return __builtin_bit_cast(bf16_t, (__bf16)f); }
__device__ __forceinline__ float bf2f(bf16_t b) { return __uint_as_float(((unsigned)b) << 16); }
__device__ __forceinline__ float silu_f(float x) { return x * __builtin_amdgcn_rcpf(1.0f + __expf(-x)); }
__device__ __forceinline__ float sigmoid_f(float x) { return __builtin_amdgcn_rcpf(1.0f + __expf(-x)); }
__device__ __forceinline__ float logsigmoid_f(float x) { return fminf(x, 0.0f) - log1pf(__expf(-fabsf(x))); }
__device__ __forceinline__ float gelu_tanh_f(float x) {
    const float z = 0.7978845608028654f * (x + 0.044715f * x * x * x);
    const float e = __expf(2.0f * z);
    const float th = 1.0f - 2.0f * __builtin_amdgcn_rcpf(e + 1.0f);
    return 0.5f * x * (1.0f + th);
}
__device__ __forceinline__ float wave_sum(float v) {
#pragma unroll
    for (int o = 32; o > 0; o >>= 1) v += __shfl_xor(v, o, 64);
    return v;
}
__device__ __forceinline__ float pos_val(const float* pos, int tok_in_seq, int col) {
    const int r = tok_in_seq >> 6, cc = tok_in_seq & 63;
    return col < 1024 ? pos[r * 1024 + col] : pos[32 * 1024 + cc * 1024 + (col - 1024)];
}

#define LAS __attribute__((address_space(3)))
typedef short bf16x8 __attribute__((ext_vector_type(8)));
typedef float f32x4 __attribute__((ext_vector_type(4)));
typedef unsigned u32x4 __attribute__((ext_vector_type(4)));
constexpr int LDS_STAGE = 131072;
constexpr int LDS_TOTAL = 163840;
constexpr int LDS_ROWS  = 131072;
constexpr int LDS_TAB   = 150528;
constexpr int LDS_MISC  = 163840 - 256;

typedef int i32x4 __attribute__((ext_vector_type(4)));
typedef int i32x8 __attribute__((ext_vector_type(8)));
__device__ __forceinline__ i32x8 cat8(const bf16x8 lo, const bf16x8 hi) { return __builtin_shufflevector(__builtin_bit_cast(i32x4, lo), __builtin_bit_cast(i32x4, hi), 0, 1, 2, 3, 4, 5, 6, 7); }
constexpr int F8_SCALE_W = 0x79797979;
constexpr int F8_SCALE_A = 0x7f7f7f7f;
constexpr float F8_WMUL = 64.0f;
__device__ __forceinline__ unsigned pack4_fp8(float a, float b, float c, float d) { int w = 0; w = __builtin_amdgcn_cvt_pk_fp8_f32(a, b, w, false); w = __builtin_amdgcn_cvt_pk_fp8_f32(c, d, w, true); return (unsigned)w; }
typedef float f32x2_t __attribute__((ext_vector_type(2)));
__device__ __forceinline__ void unpack8_fp8(const unsigned lo, const unsigned hi, float (&f)[8]) {
    const f32x2_t a = __builtin_amdgcn_cvt_pk_f32_fp8((int)lo, false), b = __builtin_amdgcn_cvt_pk_f32_fp8((int)lo, true), c = __builtin_amdgcn_cvt_pk_f32_fp8((int)hi, false), d = __builtin_amdgcn_cvt_pk_f32_fp8((int)hi, true);
    f[0] = a[0]; f[1] = a[1]; f[2] = b[0]; f[3] = b[1]; f[4] = c[0]; f[5] = c[1]; f[6] = d[0]; f[7] = d[1];
}
typedef _Float16 h16x2 __attribute__((ext_vector_type(2)));
__device__ __forceinline__ unsigned pack2_h16(float a, float b) { h16x2 h; h.x = (_Float16)a; h.y = (_Float16)b; return __builtin_bit_cast(unsigned, h); }
__device__ __forceinline__ void unpack2_h16(unsigned w, float& a, float& b) { const h16x2 h = __builtin_bit_cast(h16x2, w); a = (float)h.x; b = (float)h.y; }
typedef unsigned u32x2 __attribute__((ext_vector_type(2)));
typedef __bf16 bf16x2_t __attribute__((ext_vector_type(2)));
typedef float f32x2v_t __attribute__((ext_vector_type(2)));
__device__ __forceinline__ unsigned cvt_pk_bf16(float lo, float hi) { const f32x2v_t v = {lo, hi}; return __builtin_bit_cast(unsigned, __builtin_convertvector(v, bf16x2_t)); }
__device__ __forceinline__ void unpack8(const u32x4 v, float (&f)[8]) {
    f[0] = __uint_as_float(v.x << 16); f[1] = __uint_as_float(v.x & 0xffff0000u); f[2] = __uint_as_float(v.y << 16); f[3] = __uint_as_float(v.y & 0xffff0000u);
    f[4] = __uint_as_float(v.z << 16); f[5] = __uint_as_float(v.z & 0xffff0000u); f[6] = __uint_as_float(v.w << 16); f[7] = __uint_as_float(v.w & 0xffff0000u);
}
__device__ __forceinline__ u32x4 pack8(const float (&f)[8]) { u32x4 w; w.x = cvt_pk_bf16(f[0], f[1]); w.y = cvt_pk_bf16(f[2], f[3]); w.z = cvt_pk_bf16(f[4], f[5]); w.w = cvt_pk_bf16(f[6], f[7]); return w; }


__device__ __forceinline__ void phase_mod(const Params& p, LAS unsigned char* lds) {
    LAS float* sc = (LAS float*)lds;
    LAS float* red = sc + 9 * 128;
    float* MOD = (float*)(p.ws + WS_MOD);
    const int tid = threadIdx.x;
    for (int item = blockIdx.x; item < 768; item += gridDim.x) {
        const int cb = item % 48, kb = item / 48;
        __syncthreads();
        for (int i = tid; i < 9 * 128; i += 512) {
            const int r = i / 128, k = i % 128;
            const float v = r < 8 ? p.c[r * DM + kb * 128 + k] : p.c_ctx[kb * 128 + k];
            sc[r * 128 + k] = silu_f(v);
        }
        __syncthreads();
        const int col = cb * 256 + (tid & 255), kh = tid >> 8;
        float acc[9];
#pragma unroll
        for (int r = 0; r < 9; ++r) acc[r] = 0.f;
        const float* wp = p.w_mod + (size_t)(kb * 128 + kh * 64) * (NMOD * DM) + col;
#pragma unroll 8
        for (int k = 0; k < 64; ++k) {
            const float w = wp[(size_t)k * (NMOD * DM)];
#pragma unroll
            for (int r = 0; r < 9; ++r) acc[r] += sc[r * 128 + kh * 64 + k] * w;
        }
        if (kh == 1) {
#pragma unroll
            for (int r = 0; r < 9; ++r) red[(tid & 255) * 9 + r] = acc[r];
        }
        __syncthreads();
        if (kh == 0) {
            const float bias = kb == 0 ? p.b_mod[col] : 0.f;
#pragma unroll
            for (int r = 0; r < 9; ++r) atomicAdd(&MOD[r * (NMOD * DM) + col], acc[r] + red[tid * 9 + r] + bias);
        }
    }
    __syncthreads();
}
__device__ __forceinline__ void phase_postab(const Params& p) {
    float* pos = (float*)(p.ws + WS_POS);
    for (int i = blockIdx.x * 512 + threadIdx.x; i < 96 * 1024; i += gridDim.x * 512) {
        const int row = i / 1024, j = i % 1024, jj = j & 511;
        const float omega = 1.0f / powf(10000.0f, (float)jj / 512.0f);
        const float pv = row < 32 ? (float)row : (float)(row - 32);
        const float a = pv * omega;
        pos[i] = j < 512 ? sinf(a) : cosf(a);
    }
    float* rwt = (float*)(p.ws + WS_RWT);
    for (int i = blockIdx.x * 512 + threadIdx.x; i < 36 * DM; i += gridDim.x * 512) {
        const int k = i / 36, j = i % 36;
        rwt[j * DM + k] = j < 4 ? p.r1_w[k * 4 + j] : p.r2_w[k * 32 + (j - 4)];
    }
    bf16_t* rwh = (bf16_t*)(p.ws + WS_RWH);
    for (int i = blockIdx.x * 512 + threadIdx.x; i < 48 * DM; i += gridDim.x * 512) {
        const int j = i / DM, k = i % DM;
        const float w = j < 4 ? p.r1_w[k * 4 + j] : j < 36 ? p.r2_w[k * 32 + (j - 4)] : 0.f;
        const bf16_t hi = f2bf(w); const bf16_t lo = f2bf(w - bf2f(hi));
        rwh[i] = hi; rwh[48 * DM + i] = lo;
    }
    float* wgt = (float*)(p.ws + WS_WGT);
    for (int i = blockIdx.x * 512 + threadIdx.x; i < NGATE * DM; i += gridDim.x * 512) { const int k = i >> 4, g = i & 15; wgt[g * DM + k] = p.w_in[(size_t)k * DIN + 4096 + g]; }
}

#define GLDS16(gptr, lptr) __builtin_amdgcn_global_load_lds((const unsigned*)(gptr), (LAS unsigned*)(lptr), 16, 0, 0)
constexpr int HXB = 68 * 256;
__device__ __forceinline__ void hx_stage(const Params& p, LAS float* ldsf, int buf, int chunk, int rowb, int wid, int lane) {
    const float* MOD = (const float*)(p.ws + WS_MOD); const float* pos = (const float*)(p.ws + WS_POS); const float* wgt = (const float*)(p.ws + WS_WGT);
    LAS float* xb = ldsf + buf * HXB; LAS float* pb = xb + 24 * 256; LAS float* mb = xb + 48 * 256; LAS float* wb = xb + 52 * 256;
    const int co = chunk * 256 + lane * 4;
#pragma unroll
    for (int r = 0; r < 3; ++r) { const int row = rowb + wid * 3 + r; const bool isx = row < NTOK; const int ts = row % SEQ;
        GLDS16((isx ? p.x + (size_t)row * DM : p.ctx + (size_t)(row - NTOK) * DM) + co, xb + (wid * 3 + r) * 256);
        if (isx) GLDS16((chunk < 4 ? pos + (ts >> 6) * 1024 : pos + 32 * 1024 + (ts & 63) * 1024 - 1024) + co, pb + (wid * 3 + r) * 256); }
    if (wid < 4) { const int row = (wid & 2) ? rowb + 23 : rowb; const int b = row < NTOK ? row / SEQ : 8;
        GLDS16(MOD + (size_t)b * (NMOD * DM) + ((wid & 1) ? 0 : DM) + co, mb + wid * 256); }
    for (int j = wid; j < 16; j += 8) GLDS16(wgt + (size_t)j * DM + co, wb + j * 256);
}
__device__ __forceinline__ void phase_hx(const Params& p, LAS unsigned char* lds) {
    bf16_t* HX = (bf16_t*)(p.ws + WS_HX); unsigned char* HX8 = (unsigned char*)(p.ws + WS_HX8);
    float* G = (float*)(p.ws + WS_GATES);
    LAS float* ldsf = (LAS float*)lds;
    const int tid = threadIdx.x, lane = tid & 63, wid = __builtin_amdgcn_readfirstlane(tid >> 6);
    for (int bt = blockIdx.x; bt < NROWS / 24; bt += gridDim.x) {
        const int rowb = bt * 24, row0 = rowb + wid * 3;
        const int bfirst = rowb < NTOK ? rowb / SEQ : 8;
        bool isx[3]; int pset[3];
#pragma unroll
        for (int r = 0; r < 3; ++r) { const int row = row0 + r; isx[r] = row < NTOK; pset[r] = ((row < NTOK ? row / SEQ : 8) != bfirst) ? 2 : 0; }
        float acc[3][NGATE];
#pragma unroll
        for (int r = 0; r < 3; ++r)
#pragma unroll
            for (int g = 0; g < NGATE; ++g) acc[r][g] = 0.f;
        asm volatile("s_waitcnt vmcnt(0) lgkmcnt(0)" ::: "memory"); __builtin_amdgcn_s_barrier();
        hx_stage(p, ldsf, 0, 0, rowb, wid, lane);
#pragma unroll 1
        for (int chunk = 0; chunk < 8; ++chunk) {
            asm volatile("s_waitcnt vmcnt(0) lgkmcnt(0)" ::: "memory"); __builtin_amdgcn_s_barrier();
            if (chunk < 7) hx_stage(p, ldsf, (chunk + 1) & 1, chunk + 1, rowb, wid, lane);
            const LAS float* xb = ldsf + (chunk & 1) * HXB + lane * 4; const LAS float* pb = xb + 24 * 256; const LAS float* mb = xb + 48 * 256; const LAS float* wb = xb + 52 * 256;
            const int col = chunk * 256 + lane * 4;
            f32x4 hv[3];
#pragma unroll
            for (int r = 0; r < 3; ++r) { f32x4 v = *(const LAS f32x4*)(xb + (wid * 3 + r) * 256);
                if (isx[r]) v += *(const LAS f32x4*)(pb + (wid * 3 + r) * 256);
                hv[r] = v * (*(const LAS f32x4*)(mb + pset[r] * 256) + 1.0f) + *(const LAS f32x4*)(mb + (pset[r] + 1) * 256);
                u32x2 o; o.x = cvt_pk_bf16(hv[r][0], hv[r][1]); o.y = cvt_pk_bf16(hv[r][2], hv[r][3]);
                *(u32x2*)(HX + (size_t)(row0 + r) * DM + col) = o;
                if (isx[r]) *(unsigned*)(HX8 + (size_t)(row0 + r) * DM + col) = pack4_fp8(hv[r][0], hv[r][1], hv[r][2], hv[r][3]); }
#pragma unroll
            for (int g = 0; g < NGATE; ++g) { const f32x4 w = *(const LAS f32x4*)(wb + g * 256);
#pragma unroll
                for (int r = 0; r < 3; ++r) acc[r][g] += hv[r][0] * w[0] + hv[r][1] * w[1] + hv[r][2] * w[2] + hv[r][3] * w[3]; }
        }
        {
            float v24[24], v12[12], v6[6];
            const bool h5 = lane & 32, h4 = lane & 16, h3 = lane & 8, h2 = lane & 4;
#pragma unroll
            for (int f = 0; f < 24; ++f) { const float lo = acc[f / 16][f % 16], hi = acc[(f + 24) / 16][(f + 24) % 16]; v24[f] = (h5 ? hi : lo) + __shfl_xor(h5 ? lo : hi, 32, 64); }
#pragma unroll
            for (int f = 0; f < 12; ++f) v12[f] = (h4 ? v24[f + 12] : v24[f]) + __shfl_xor(h4 ? v24[f] : v24[f + 12], 16, 64);
#pragma unroll
            for (int f = 0; f < 6; ++f) v6[f] = (h3 ? v12[f + 6] : v12[f]) + __shfl_xor(h3 ? v12[f] : v12[f + 6], 8, 64);
            const int f0 = (h5 ? 24 : 0) + (h4 ? 12 : 0) + (h3 ? 6 : 0) + (h2 ? 3 : 0);
#pragma unroll
            for (int f = 0; f < 3; ++f) { float x = (h2 ? v6[f + 3] : v6[f]) + __shfl_xor(h2 ? v6[f] : v6[f + 3], 4, 64); x += __shfl_xor(x, 2, 64); x += __shfl_xor(x, 1, 64);
                if ((lane & 3) == 0) { const int ff = f0 + f, r = ff >> 4, g = ff & 15; float v = x + p.gate_bias[g]; if ((g >> 2) & 1) v = logsigmoid_f(v); G[(size_t)(row0 + r) * NGATE + g] = v; } }
        }
    }
    asm volatile("s_waitcnt vmcnt(0) lgkmcnt(0)" ::: "memory"); __builtin_amdgcn_s_barrier();
}

constexpr int L1_X = 0, L1_P = 16384, L1_W = 16384 + 4096, L1_BUF = L1_W + 2 * 24576, L1_RED = 2 * L1_BUF;
constexpr int L1_LG = L1_RED;
__device__ __forceinline__ void ln1_stage(const Params& p, LAS unsigned char* lds, int buf, int chunk, int tokb, int b, int wid, int lane) {
    const bf16_t* X1 = (const bf16_t*)(p.ws + WS_X1); const bf16_t* RW = (const bf16_t*)(p.ws + WS_RWH); const float* MOD = (const float*)(p.ws + WS_MOD);
    LAS unsigned char* base = lds + buf * L1_BUF;
#pragma unroll
    for (int r2 = 0; r2 < 2; ++r2) { const int row = wid * 4 + 2 * r2 + (lane >> 5); const int gc = (lane & 31) ^ (row & 31);
        GLDS16(X1 + (size_t)(tokb + row) * DM + chunk * 256 + gc * 8, base + L1_X + (wid * 4 + 2 * r2) * 512); }
#pragma unroll
    for (int q = 0; q < 6; ++q) { const int rr = (wid * 6 + q) * 2 + (lane >> 5); const int n = rr % 48; const int gc = (lane & 31) ^ (n & 31);
        GLDS16(RW + (size_t)rr * DM + chunk * 256 + gc * 8, base + L1_W + (wid * 6 + q) * 1024); }
    const int cf = chunk * 256 + lane * 4;
    if (wid == 4) GLDS16(p.ln1_w + cf, base + L1_P);
    if (wid == 5) GLDS16(p.ln1_b + cf, base + L1_P + 1024);
    if (wid == 6) GLDS16(MOD + (size_t)b * (NMOD * DM) + 4 * DM + cf, base + L1_P + 2048);
    if (wid == 7) GLDS16(MOD + (size_t)b * (NMOD * DM) + 3 * DM + cf, base + L1_P + 3072);
}
__device__ __forceinline__ void phase_ln1(const Params& p, LAS unsigned char* lds) {
    const float* ST = (const float*)(p.ws + WS_STATS);
    unsigned char* T = (unsigned char*)(p.ws + WS_T);
    unsigned* cnt = (unsigned*)(p.ws + WS_CTL) + CW_CNT;
    int* list = (int*)(p.ws + WS_LIST);
    float* RT = (float*)(p.ws + WS_RT);
    LAS float* ldsf = (LAS float*)lds;
    const int tid = threadIdx.x, lane = tid & 63, wid = __builtin_amdgcn_readfirstlane(tid >> 6), li_ = lane & 15, lg = lane >> 4;
    for (int rb = blockIdx.x; rb < NTOK / 32; rb += gridDim.x) {
        const int tokb = rb * 32, b = tokb / SEQ, row0 = tokb + wid * 4;
        float mean[2], rstd[2];
#pragma unroll
        for (int m = 0; m < 2; ++m) { const float s1 = ST[(size_t)(tokb + 16 * m + li_) * 2], s2 = ST[(size_t)(tokb + 16 * m + li_) * 2 + 1];
            mean[m] = s1 * (1.0f / DM); rstd[m] = rsqrtf(fmaxf(s2 * (1.0f / DM) - mean[m] * mean[m], 0.f) + LN_EPS); }
        f32x4 acc[2][3];
#pragma unroll
        for (int m = 0; m < 2; ++m)
#pragma unroll
            for (int n = 0; n < 3; ++n) acc[m][n] = (f32x4){0.f, 0.f, 0.f, 0.f};
        asm volatile("s_waitcnt vmcnt(0) lgkmcnt(0)" ::: "memory"); __builtin_amdgcn_s_barrier();
        ln1_stage(p, lds, 0, 0, tokb, b, wid, lane);
#pragma unroll 1
        for (int chunk = 0; chunk < 8; ++chunk) {
            asm volatile("s_waitcnt vmcnt(0) lgkmcnt(0)" ::: "memory"); __builtin_amdgcn_s_barrier();
            if (chunk < 7) ln1_stage(p, lds, (chunk + 1) & 1, chunk + 1, tokb, b, wid, lane);
            const LAS unsigned char* base = lds + (chunk & 1) * L1_BUF;
            const int kc = 4 * wid + lg;
            const LAS float* pp = (const LAS float*)(base + L1_P) + kc * 8;
            const f32x4 lw0 = *(const LAS f32x4*)(pp), lw1 = *(const LAS f32x4*)(pp + 4), lb0 = *(const LAS f32x4*)(pp + 256), lb1 = *(const LAS f32x4*)(pp + 260);
            const f32x4 sc0 = *(const LAS f32x4*)(pp + 512) + 1.0f, sc1 = *(const LAS f32x4*)(pp + 516) + 1.0f, sh0 = *(const LAS f32x4*)(pp + 768), sh1 = *(const LAS f32x4*)(pp + 772);
            bf16x8 ahi[2], alo[2];
#pragma unroll
            for (int m = 0; m < 2; ++m) { const int row = 16 * m + li_;
                const u32x4 xw = *(const LAS u32x4*)(base + L1_X + row * 512 + ((kc ^ (row & 31)) << 4));
                float x[8]; unpack2_h16(xw.x, x[0], x[1]); unpack2_h16(xw.y, x[2], x[3]); unpack2_h16(xw.z, x[4], x[5]); unpack2_h16(xw.w, x[6], x[7]);
                float t[8];
#pragma unroll
                for (int j = 0; j < 4; ++j) { t[j] = ((x[j] - mean[m]) * rstd[m] * lw0[j] + lb0[j]) * sc0[j] + sh0[j]; t[4 + j] = ((x[4 + j] - mean[m]) * rstd[m] * lw1[j] + lb1[j]) * sc1[j] + sh1[j]; }
                u32x2 tw; tw.x = pack4_fp8(t[0], t[1], t[2], t[3]); tw.y = pack4_fp8(t[4], t[5], t[6], t[7]);
                *(u32x2*)(T + (size_t)(tokb + row) * DM + chunk * 256 + kc * 8) = tw;
                u32x4 hw, lw_; float r_[8];
                hw.x = cvt_pk_bf16(t[0], t[1]); hw.y = cvt_pk_bf16(t[2], t[3]); hw.z = cvt_pk_bf16(t[4], t[5]); hw.w = cvt_pk_bf16(t[6], t[7]);
                unpack8(hw, r_);
#pragma unroll
                for (int j = 0; j < 8; ++j) r_[j] = t[j] - r_[j];
                lw_.x = cvt_pk_bf16(r_[0], r_[1]); lw_.y = cvt_pk_bf16(r_[2], r_[3]); lw_.z = cvt_pk_bf16(r_[4], r_[5]); lw_.w = cvt_pk_bf16(r_[6], r_[7]);
                ahi[m] = __builtin_bit_cast(bf16x8, hw); alo[m] = __builtin_bit_cast(bf16x8, lw_); }
#pragma unroll
            for (int n = 0; n < 3; ++n) { const int rown = 16 * n + li_;
                const bf16x8 bhi = *(const LAS bf16x8*)(base + L1_W + rown * 512 + ((kc ^ (rown & 31)) << 4));
                const bf16x8 blo = *(const LAS bf16x8*)(base + L1_W + 24576 + rown * 512 + ((kc ^ (rown & 31)) << 4));
#pragma unroll
                for (int m = 0; m < 2; ++m) {
                    acc[m][n] = __builtin_amdgcn_mfma_f32_16x16x32_bf16(ahi[m], bhi, acc[m][n], 0, 0, 0);
                    acc[m][n] = __builtin_amdgcn_mfma_f32_16x16x32_bf16(ahi[m], blo, acc[m][n], 0, 0, 0);
                    acc[m][n] = __builtin_amdgcn_mfma_f32_16x16x32_bf16(alo[m], bhi, acc[m][n], 0, 0, 0); } }
        }
        asm volatile("s_waitcnt vmcnt(0) lgkmcnt(0)" ::: "memory"); __builtin_amdgcn_s_barrier();
        {   LAS float* red = (LAS float*)lds + wid * (32 * 48);
#pragma unroll
            for (int m = 0; m < 2; ++m)
#pragma unroll
                for (int n = 0; n < 3; ++n)
#pragma unroll
                    for (int j = 0; j < 4; ++j) red[(16 * m + 4 * lg + j) * 48 + 16 * n + li_] = acc[m][n][j]; }
        asm volatile("s_waitcnt lgkmcnt(0)" ::: "memory"); __builtin_amdgcn_s_barrier();
        LAS float* lgt = (LAS float*)(lds + L1_LG);
        for (int i = tid; i < 32 * 36; i += 512) { const int tkn = i / 36, j = i % 36; float sum = 0.f;
#pragma unroll
            for (int w = 0; w < 8; ++w) sum += ((const LAS float*)lds)[w * (32 * 48) + tkn * 48 + j];
            lgt[i] = sum; }
        asm volatile("s_waitcnt lgkmcnt(0)" ::: "memory"); __builtin_amdgcn_s_barrier();
        LAS int* esel = (LAS int*)(lds + L1_LG + 32 * 36 * 4);
        if (lane < 4) {
            const int tok = row0 + lane;
            const LAS float* lg = lgt + (wid * 4 + lane) * 36;
            int grp = 0; float l1[4];
#pragma unroll
            for (int j = 0; j < 4; ++j) l1[j] = lg[j] + p.r1_b[j];
            float best = l1[0];
#pragma unroll
            for (int j = 1; j < 4; ++j) if (l1[j] > best) { best = l1[j]; grp = j; }
            float se = 0.f;
#pragma unroll
            for (int j = 0; j < 4; ++j) se += __expf(l1[j] - best);
            const float pg = 1.0f / se;
            float v0 = -3.0e38f, v1 = -3.0e38f; int i0 = 0, i1 = 0;
#pragma unroll
            for (int j = 0; j < 8; ++j) {
                const float l = lg[4 + grp * 8 + j] + p.r2_b[grp * 8 + j];
                if (l > v0) { v1 = v0; i1 = i0; v0 = l; i0 = j; } else if (l > v1) { v1 = l; i1 = j; }
            }
            const float ex = __expf(v1 - v0);
            RT[tok * 2 + 0] = pg / (1.0f + ex); RT[tok * 2 + 1] = pg * ex / (1.0f + ex);
            esel[(wid * 4 + lane) * 2 + 0] = grp * 8 + i0; esel[(wid * 4 + lane) * 2 + 1] = grp * 8 + i1;
        }
        asm volatile("s_waitcnt lgkmcnt(0)" ::: "memory"); __builtin_amdgcn_s_barrier();
        if (tid < 32) {
            int c = 0;
            for (int i = 0; i < 64; ++i) c += (esel[i] == tid) ? 1 : 0;
            esel[64 + tid] = c > 0 ? (int)atomicAdd(&cnt[tid], (unsigned)c) : 0;
        }
        asm volatile("s_waitcnt vmcnt(0) lgkmcnt(0)" ::: "memory"); __builtin_amdgcn_s_barrier();
        if (tid < 64) {
            const int e = esel[tid]; int lr = 0;
            for (int i = 0; i < tid; ++i) lr += (esel[i] == e) ? 1 : 0;
            list[(size_t)e * NTOK + esel[64 + e] + lr] = (rb * 32 + (tid >> 1)) * 2 + (tid & 1);
        }
    }
    asm volatile("s_waitcnt vmcnt(0) lgkmcnt(0)" ::: "memory"); __builtin_amdgcn_s_barrier();
}

struct FinRaw { u32x2 ya[4], yb[4]; u32x4 x[4]; u32x2 g, st; };
__device__ __forceinline__ void fin_request(const Params& p, int tok, int lane, FinRaw& r) {
    const bf16_t* X1 = (const bf16_t*)(p.ws + WS_X1); const unsigned char* Y2 = (const unsigned char*)(p.ws + WS_Y2);
    const float* RT = (const float*)(p.ws + WS_RT); const float* ST = (const float*)(p.ws + WS_STATS);
#pragma unroll
    for (int i = 0; i < 4; ++i) { const int col = i * 512 + lane * 8;
        const unsigned char* a0 = Y2 + (size_t)(tok * 2) * DM + col; const unsigned char* a1 = a0 + DM; const bf16_t* a2 = X1 + (size_t)tok * DM + col;
        asm volatile("global_load_dwordx2 %0, %1, off" : "=v"(r.ya[i]) : "v"(a0) : "memory");
        asm volatile("global_load_dwordx2 %0, %1, off" : "=v"(r.yb[i]) : "v"(a1) : "memory");
        asm volatile("global_load_dwordx4 %0, %1, off" : "=v"(r.x[i]) : "v"(a2) : "memory"); }
    { const float* a3 = RT + tok * 2; const float* a4 = ST + (size_t)tok * 2;
      asm volatile("global_load_dwordx2 %0, %1, off" : "=v"(r.g) : "v"(a3) : "memory");
      asm volatile("global_load_dwordx2 %0, %1, off" : "=v"(r.st) : "v"(a4) : "memory"); }
}
__device__ __forceinline__ void phase_final(const Params& p, LAS unsigned char* lds) {
    const float* MOD = (const float*)(p.ws + WS_MOD);
    const int tid = threadIdx.x, lane = tid & 63, wid = __builtin_amdgcn_readfirstlane(tid >> 6);
    LAS float* PRM = (LAS float*)lds;
    LAS float* GT = PRM + 4 * DM;
    asm volatile("s_waitcnt vmcnt(0) lgkmcnt(0)" ::: "memory"); __builtin_amdgcn_s_barrier();
    {   const int col = tid * 4; const int pidx = (((col >> 9) * 2 + ((col >> 2) & 1)) * 64 + ((col & 511) >> 3)) * 4;
        *(LAS f32x4*)(PRM + pidx) = *(const f32x4*)(p.ln1_w + col) * ALPHA; *(LAS f32x4*)(PRM + DM + pidx) = *(const f32x4*)(p.ln1_b + col) * ALPHA;
        *(LAS f32x4*)(PRM + 2 * DM + pidx) = *(const f32x4*)(p.ln2_w + col); *(LAS f32x4*)(PRM + 3 * DM + pidx) = *(const f32x4*)(p.ln2_b + col);
#pragma unroll
        for (int b = 0; b < NB; ++b) *(LAS f32x4*)(GT + b * DM + pidx) = *(const f32x4*)(MOD + (size_t)b * (NMOD * DM) + 5 * DM + col);
    }
    asm volatile("s_waitcnt vmcnt(0) lgkmcnt(0)" ::: "memory"); __builtin_amdgcn_s_barrier();
    const int stride = gridDim.x * 8;
    int tok = blockIdx.x * 8 + wid;
    if (tok >= NTOK) return;
    FinRaw r; fin_request(p, tok, lane, r);
    bool first = true;
#pragma unroll 1
    for (; tok < NTOK; tok += stride) {
        if (first) asm volatile("s_waitcnt vmcnt(0)" ::: "memory"); else asm volatile("s_waitcnt vmcnt(8)" ::: "memory");
        first = false;
        const LAS float* gt = GT + (tok / SEQ) * DM;
        const unsigned ug0 = r.g.x, ug1 = r.g.y, us1 = r.st.x, us2 = r.st.y;
        const float g0 = __uint_as_float(ug0) * 0.0625f, g1 = __uint_as_float(ug1) * 0.0625f;
        const float st1 = __uint_as_float(us1), st2 = __uint_as_float(us2);
        const float mean1 = st1 * (1.0f / DM), rstd1 = rsqrtf(fmaxf(st2 * (1.0f / DM) - mean1 * mean1, 0.f) + LN_EPS);
        float v[32]; float s = 0.f;
#pragma unroll
        for (int i = 0; i < 4; ++i) {
            float ya[8], yb[8]; unpack8_fp8(r.ya[i].x, r.ya[i].y, ya); unpack8_fp8(r.yb[i].x, r.yb[i].y, yb);
            float xr[8]; unpack2_h16(r.x[i].x, xr[0], xr[1]); unpack2_h16(r.x[i].y, xr[2], xr[3]); unpack2_h16(r.x[i].z, xr[4], xr[5]); unpack2_h16(r.x[i].w, xr[6], xr[7]);
            const int o0 = (i * 2 * 64 + lane) * 4, o1 = o0 + 256;
            const f32x4 xa = ((f32x4){xr[0], xr[1], xr[2], xr[3]} - mean1) * rstd1 * *(const LAS f32x4*)(PRM + o0) + *(const LAS f32x4*)(PRM + DM + o0);
            const f32x4 xb = ((f32x4){xr[4], xr[5], xr[6], xr[7]} - mean1) * rstd1 * *(const LAS f32x4*)(PRM + o1) + *(const LAS f32x4*)(PRM + DM + o1);
            const f32x4 ga = *(const LAS f32x4*)(gt + o0), gb = *(const LAS f32x4*)(gt + o1);
#pragma unroll
            for (int j = 0; j < 4; ++j) { v[i * 8 + j] = xa[j] + ga[j] * (g0 * ya[j] + g1 * yb[j]); v[i * 8 + 4 + j] = xb[j] + gb[j] * (g0 * ya[4 + j] + g1 * yb[4 + j]); }
#pragma unroll
            for (int j = 0; j < 8; ++j) s += v[i * 8 + j];
        }
        {   const int tn = tok + stride < NTOK ? tok + stride : tok;
            fin_request(p, tn, lane, r); }
        const float mu = wave_sum(s) * (1.0f / DM);
        float q = 0.f;
#pragma unroll
        for (int i = 0; i < 32; ++i) { const float dlt = v[i] - mu; q += dlt * dlt; }
        const float rstd = rsqrtf(wave_sum(q) * (1.0f / DM) + LN_EPS);
#pragma unroll
        for (int i = 0; i < 4; ++i) {
            const int col = i * 512 + lane * 8;
            const int o0 = (i * 2 * 64 + lane) * 4, o1 = o0 + 256;
            const f32x4 wa = *(const LAS f32x4*)(PRM + 2 * DM + o0), wb = *(const LAS f32x4*)(PRM + 2 * DM + o1), ba = *(const LAS f32x4*)(PRM + 3 * DM + o0), bb = *(const LAS f32x4*)(PRM + 3 * DM + o1);
            f32x4 oa, ob;
#pragma unroll
            for (int j = 0; j < 4; ++j) { oa[j] = (v[i * 8 + j] - mu) * rstd * wa[j] + ba[j]; ob[j] = (v[i * 8 + 4 + j] - mu) * rstd * wb[j] + bb[j]; }
            *(f32x4*)(p.out + (size_t)tok * DM + col) = oa; *(f32x4*)(p.out + (size_t)tok * DM + col + 4) = ob;
        }
    }
    asm volatile("s_waitcnt vmcnt(0)" ::: "memory");
}

__device__ __forceinline__ void conv_item_src(const Params& p, int item, const float*& src, int& ld, unsigned char*& dst, int& K, bool& f8) {
    f8 = false;
    if (item < 1536) {
        const int nt = item % 48, kt = item / 48; const int n0 = nt * 128, sc = n0 < 4096 ? n0 : n0 + NGATE;
        ld = DIN; K = DM; src = p.w_in + (size_t)(kt * 64) * DIN + sc;
        if (n0 < 3072 || n0 >= 4096) dst = (unsigned char*)(p.ws + WS_BTIN) + ((size_t)n0 * DM + kt * 64) * 2;
        else { dst = (unsigned char*)(p.ws + WS_BTIN) + (size_t)3072 * DM * 2 + (size_t)(n0 - 3072) * DM + kt * 64; f8 = true; }
        return;
    }
    item -= 1536;
    if (item < 512) {
        const int nt = item % 16, kt = item / 16;
        ld = DM; K = DM; src = p.w_out + (size_t)(kt * 64) * DM + nt * 128; dst = (unsigned char*)(p.ws + WS_BTOUT) + ((size_t)(nt * 128) * DM + kt * 64) * 2; return;
    }
    item -= 512;
    if (item < 16384) {
        const int kt = item & 31, pn = (item >> 5) & 7, which = (item >> 8) & 1, e = item >> 9;
        ld = DE; K = DM; src = (which ? p.w_up : p.w_gate) + (size_t)e * DM * DE + (size_t)(kt * 64) * DE + pn * 128;
        dst = (unsigned char*)(p.ws + WS_BTGU) + ((size_t)(e * 8 + pn) * 256 + which * 128) * DM + kt * 64; f8 = true; return;
    }
    item -= 16384;
    {
        const int kt = item & 15, nt = (item >> 4) & 15, e = item >> 8;
        ld = DM; K = DE; src = p.w_down + (size_t)e * DE * DM + (size_t)(kt * 64) * DM + nt * 128;
        dst = (unsigned char*)(p.ws + WS_BTDN) + ((size_t)e * DM + nt * 128) * DE + kt * 64; f8 = true;
    }
}
constexpr int CONV_ITEMS_ALL = 1536 + 512 + 16384 + 8192;
constexpr int CT_B1 = 10;
constexpr int CONV_TAIL = 128 * CT_B1;
__device__ __forceinline__ void phase_convert(const Params& p, LAS unsigned char* lds, const int first, const int CONV_ITEMS, const int start, const int stride) {
    LAS float* tile = (LAS float*)lds;
    const int tid = threadIdx.x;
    float4 r[4];
    int item = first + start;
    const float* src; int ld; unsigned char* dst; int K; bool f8;
    if (item < CONV_ITEMS) {
        conv_item_src(p, item, src, ld, dst, K, f8);
#pragma unroll
        for (int i = 0; i < 4; ++i) { const int idx = tid + 512 * i; r[i] = *(const float4*)(src + (size_t)(idx >> 5) * ld + (idx & 31) * 4); }
    }
    for (; item < CONV_ITEMS; item += stride) {
        __syncthreads();
#pragma unroll
        for (int i = 0; i < 4; ++i) { const int idx = tid + 512 * i; LAS float* t = tile + (idx >> 5) * 129 + (idx & 31) * 4; t[0] = r[i].x; t[1] = r[i].y; t[2] = r[i].z; t[3] = r[i].w; }
        unsigned char* cdst = dst; const int cK = K; const bool cf8 = f8;
        const int nitem = item + stride;
        if (nitem < CONV_ITEMS) {
            conv_item_src(p, nitem, src, ld, dst, K, f8);
#pragma unroll
            for (int i = 0; i < 4; ++i) { const int idx = tid + 512 * i; r[i] = *(const float4*)(src + (size_t)(idx >> 5) * ld + (idx & 31) * 4); }
        }
        __syncthreads();
#pragma unroll
        for (int i = 0; i < 2; ++i) {
            const int o = tid + 512 * i, kg = o & 7, n = o >> 3;
            const LAS float* t = tile + (kg * 8) * 129 + n;
            if (cf8) { u32x2 w;
                w.x = pack4_fp8(t[0 * 129] * F8_WMUL, t[1 * 129] * F8_WMUL, t[2 * 129] * F8_WMUL, t[3 * 129] * F8_WMUL);
                w.y = pack4_fp8(t[4 * 129] * F8_WMUL, t[5 * 129] * F8_WMUL, t[6 * 129] * F8_WMUL, t[7 * 129] * F8_WMUL);
                *(u32x2*)(cdst + (size_t)n * cK + kg * 8) = w;
            } else { u32x4 w;
                w.x = cvt_pk_bf16(t[0 * 129], t[1 * 129]); w.y = cvt_pk_bf16(t[2 * 129], t[3 * 129]);
                w.z = cvt_pk_bf16(t[4 * 129], t[5 * 129]); w.w = cvt_pk_bf16(t[6 * 129], t[7 * 129]);
                *(u32x4*)(cdst + ((size_t)n * cK + kg * 8) * 2) = w; }
        }
    }
    __syncthreads();
}

namespace pg8 {
constexpr int BM = 256, BK = 64, HALF = 128, HTB = HALF * BK * 2, STAGE_BYTES = 8 * HTB;
__device__ __forceinline__ int lds_byte(int r, int c) { const int st = (r >> 4) * 2 + (c >> 5), rr = r & 15, cc = c & 31, ob = rr * 64 + cc * 2; return st * 1024 + (ob ^ (((ob >> 9) & 1) << 5)); }
__device__ __forceinline__ void stage_rc(int b, int& R, int& C) { const int st = b / 1024, sb = b % 1024, swz = sb ^ (((sb >> 9) & 1) << 5); R = (st >> 1) * 16 + swz / 64; C = (st & 1) * 32 + (swz % 64) / 2; }
__device__ __forceinline__ int perm32(int rho) { const int n = rho >> 4, i = rho & 15; return 8 * (i >> 2) + 4 * n + (i & 3); }

struct Unit {
    const char* a;
    const char* b;
    const int* rows;
    int rows_lds;
    int nvalid;
    int pm, pn, e, aux;
};

template <bool PERM, bool F8, class Epi, class Sched>
__device__ __forceinline__ void gemm_phase(LAS unsigned char* lds, const int KB, const Sched& S, const Epi& E) {
    const int tid = threadIdx.x, wid = __builtin_amdgcn_readfirstlane(tid >> 6), lane = tid & 63, wr = wid >> 2, wc = wid & 3, fr = lane & 15, fq = lane >> 4;
    const int nt = KB / 128;
    unsigned vb0, vb1;
    { int Rr[2], Cc[2]; stage_rc(tid * 16, Rr[0], Cc[0]); stage_rc(tid * 16 + 8192, Rr[1], Cc[1]);
      const int Rb0 = PERM ? ((Rr[0] & ~31) + perm32(Rr[0] & 31)) : Rr[0], Rb1 = PERM ? ((Rr[1] & ~31) + perm32(Rr[1] & 31)) : Rr[1];
      vb0 = (unsigned)(Rb0 * KB + 2 * Cc[0]); vb1 = (unsigned)(Rb1 * KB + 2 * Cc[1]); }
    const size_t kstep = (size_t)(BK * 2);
    const size_t hstepB = (size_t)HALF * KB;
    const unsigned ldsw = (unsigned)wid * 1024u;
    const int aoff = lds_byte(wr * 64 + fr, fq * 8), boff = lds_byte(wc * 32 + fr, fq * 8);
#define PG8_SA(b, h) (((b) * 2 + (h)) * HTB)
#define PG8_SB(b, h) ((4 + (b) * 2 + (h)) * HTB)
#define PG8_STAGE2(bufoff, gbase, v0, v1) do { \
        __builtin_amdgcn_global_load_lds((const unsigned*)((const char*)(gbase) + (v0)), (LAS unsigned*)(lds + (bufoff) + ldsw), 16, 0, 0); \
        __builtin_amdgcn_global_load_lds((const unsigned*)((const char*)(gbase) + (v1)), (LAS unsigned*)(lds + (bufoff) + ldsw + 8192), 16, 0, 0); } while (0)
#define PG8_LD16(off) (*(const LAS i32x4*)(lds + (off)))
#define PG8_LDA(dst, b, h) do { if constexpr (F8) { _Pragma("unroll") for (int m = 0; m < 4; ++m) dst##8[m] = __builtin_shufflevector(PG8_LD16(PG8_SA(b, h) + aoff + m * 2048), PG8_LD16(PG8_SA(b, h) + aoff + m * 2048 + 1024), 0, 1, 2, 3, 4, 5, 6, 7); } \
        else { _Pragma("unroll") for (int m = 0; m < 4; ++m) _Pragma("unroll") for (int k = 0; k < 2; ++k) dst[m][k] = *(const LAS bf16x8*)(lds + PG8_SA(b, h) + aoff + m * 2048 + k * 1024); } } while (0)
#define PG8_LDB(dst, b, h) do { if constexpr (F8) { _Pragma("unroll") for (int n = 0; n < 2; ++n) dst##8[n] = __builtin_shufflevector(PG8_LD16(PG8_SB(b, h) + boff + n * 2048), PG8_LD16(PG8_SB(b, h) + boff + n * 2048 + 1024), 0, 1, 2, 3, 4, 5, 6, 7); } \
        else { _Pragma("unroll") for (int n = 0; n < 2; ++n) _Pragma("unroll") for (int k = 0; k < 2; ++k) dst[n][k] = *(const LAS bf16x8*)(lds + PG8_SB(b, h) + boff + n * 2048 + k * 1024); } } while (0)
#define PG8_MMA(ai, bj, At, Bt) do { __builtin_amdgcn_s_setprio(1); \
        if constexpr (F8) { _Pragma("unroll") for (int m = 0; m < 4; ++m) _Pragma("unroll") for (int n = 0; n < 2; ++n) \
            asm volatile("v_mfma_scale_f32_16x16x128_f8f6f4 %0, %1, %2, %0, %3, %4 op_sel_hi:[0,0,0]" : "+v"(acc[ai][bj][m][n]) : "v"(Bt##8[n]), "v"(At##8[m]), "v"(f8sw), "v"(f8sa)); } \
        else { _Pragma("unroll") for (int m = 0; m < 4; ++m) _Pragma("unroll") for (int n = 0; n < 2; ++n) _Pragma("unroll") for (int k = 0; k < 2; ++k) \
            acc[ai][bj][m][n] = __builtin_amdgcn_mfma_f32_16x16x32_bf16(Bt[n][k], At[m][k], acc[ai][bj][m][n], 0, 0, 0); } \
        __builtin_amdgcn_s_setprio(0); } while (0)
#define PG8_WAIT_V(n) asm volatile("s_waitcnt vmcnt(" #n ")" ::: "memory")
#define PG8_WAIT_L(n) asm volatile("s_waitcnt lgkmcnt(" #n ")" ::: "memory")
#define PG8_BAR __builtin_amdgcn_s_barrier()
#define PG8_SCHED __builtin_amdgcn_sched_barrier(0)
#define PG8_VOFF(u, v00, v01, v10, v11) do { int Rr[2], Cc[2]; int tq = tid; asm volatile("" : "+v"(tq)); stage_rc(tq * 16, Rr[0], Cc[0]); stage_rc(tq * 16 + 8192, Rr[1], Cc[1]); \
        if ((u).rows_lds >= 0) { const int nvm = (u).nvalid - 1; const LAS int* rl_ = (const LAS int*)(lds + (u).rows_lds); \
            const int r00 = Rr[0] < nvm ? Rr[0] : nvm, r01 = Rr[1] < nvm ? Rr[1] : nvm, r10 = (Rr[0] + 128) < nvm ? (Rr[0] + 128) : nvm, r11 = (Rr[1] + 128) < nvm ? (Rr[1] + 128) : nvm; \
            v00 = (unsigned)((rl_[r00] >> 1) * KB + 2 * Cc[0]); v01 = (unsigned)((rl_[r01] >> 1) * KB + 2 * Cc[1]); \
            v10 = (unsigned)((rl_[r10] >> 1) * KB + 2 * Cc[0]); v11 = (unsigned)((rl_[r11] >> 1) * KB + 2 * Cc[1]); \
        } else { v00 = (unsigned)(Rr[0] * KB + 2 * Cc[0]); v01 = (unsigned)(Rr[1] * KB + 2 * Cc[1]); v10 = (unsigned)((Rr[0] + 128) * KB + 2 * Cc[0]); v11 = (unsigned)((Rr[1] + 128) * KB + 2 * Cc[1]); } } while (0)
    Unit cur, nxt; int ui = 0;
    if (!S.next(0, cur)) return;
    f32x4 acc[2][2][4][2];
#pragma unroll
    for (int a = 0; a < 2; ++a)
#pragma unroll
        for (int b = 0; b < 2; ++b)
#pragma unroll
            for (int m = 0; m < 4; ++m)
#pragma unroll
                for (int n = 0; n < 2; ++n) acc[a][b][m][n] = (f32x4){0.f, 0.f, 0.f, 0.f};
    bf16x8 At[4][2], B0[2][2], B1[2][2]; i32x8 At8[4], B08[2], B18[2];
    const int f8sw = F8_SCALE_W, f8sa = F8_SCALE_A;
    unsigned vc00, vc01, vc10, vc11, vn00, vn01, vn10, vn11;
    PG8_VOFF(cur, vc00, vc01, vc10, vc11);
    const char* cA = cur.a; const char* cB = cur.b;
    PG8_STAGE2(PG8_SB(0, 0), cB, vb0, vb1); PG8_STAGE2(PG8_SA(0, 0), cA, vc00, vc01); PG8_STAGE2(PG8_SB(0, 1), cB + hstepB, vb0, vb1); PG8_STAGE2(PG8_SA(0, 1), cA, vc10, vc11);
    if (wr == 1) PG8_BAR;
    PG8_WAIT_V(4); PG8_BAR;
    PG8_STAGE2(PG8_SB(1, 0), cB + kstep, vb0, vb1); PG8_STAGE2(PG8_SA(1, 0), cA + kstep, vc00, vc01); PG8_STAGE2(PG8_SB(1, 1), cB + hstepB + kstep, vb0, vb1);
    PG8_WAIT_V(6); PG8_BAR;
    for (;;) {
        const bool has_next = S.next(ui + 1, nxt);
        const char* nA = has_next ? nxt.a : cA; const char* nB = has_next ? nxt.b : cB;
        if (has_next) { PG8_VOFF(nxt, vn00, vn01, vn10, vn11); } else { vn00 = vc00; vn01 = vc01; vn10 = vc10; vn11 = vc11; }
        for (int t = 0; t < nt; t += 2) {
            const bool last = (t == nt - 2);
            const char* a1 = cA + (size_t)(t + 1) * kstep;
            const char* a2 = last ? nA : cA + (size_t)(t + 2) * kstep; const char* b2 = last ? nB : cB + (size_t)(t + 2) * kstep;
            const char* a3 = a2 + kstep; const char* b3 = b2 + kstep;
            const unsigned w00 = last ? vn00 : vc00, w01 = last ? vn01 : vc01, w10 = last ? vn10 : vc10, w11 = last ? vn11 : vc11;
            PG8_LDB(B0, 0, 0); PG8_SCHED; PG8_LDA(At, 0, 0); PG8_STAGE2(PG8_SA(1, 1), a1, vc10, vc11);
            PG8_WAIT_L(8); PG8_BAR; PG8_WAIT_L(0); PG8_MMA(0, 0, At, B0); PG8_BAR; PG8_SCHED;
            PG8_LDB(B1, 0, 1); PG8_STAGE2(PG8_SB(0, 0), b2, vb0, vb1);
            PG8_BAR; PG8_WAIT_L(0); PG8_MMA(0, 1, At, B1); PG8_BAR;
            PG8_LDA(At, 0, 1); PG8_STAGE2(PG8_SA(0, 0), a2, w00, w01);
            PG8_BAR; PG8_WAIT_L(0); PG8_MMA(1, 0, At, B0); PG8_BAR; PG8_SCHED;
            PG8_STAGE2(PG8_SB(0, 1), b2 + hstepB, vb0, vb1);
            PG8_WAIT_V(6); PG8_BAR; PG8_MMA(1, 1, At, B1); PG8_BAR;
            PG8_LDB(B0, 1, 0); PG8_SCHED; PG8_LDA(At, 1, 0); PG8_STAGE2(PG8_SA(0, 1), a2, w10, w11);
            PG8_WAIT_L(8); PG8_BAR; PG8_WAIT_L(0); PG8_MMA(0, 0, At, B0); PG8_BAR; PG8_SCHED;
            PG8_LDB(B1, 1, 1); PG8_STAGE2(PG8_SB(1, 0), b3, vb0, vb1);
            PG8_BAR; PG8_WAIT_L(0); PG8_MMA(0, 1, At, B1); PG8_BAR;
            PG8_LDA(At, 1, 1); PG8_STAGE2(PG8_SA(1, 0), a3, w00, w01);
            PG8_BAR; PG8_WAIT_L(0); PG8_MMA(1, 0, At, B0); PG8_BAR; PG8_SCHED;
            PG8_STAGE2(PG8_SB(1, 1), b3 + hstepB, vb0, vb1);
            PG8_WAIT_V(6); PG8_BAR; PG8_MMA(1, 1, At, B1); PG8_BAR;
        }
        if constexpr (F8) asm volatile("s_nop 15\n\ts_nop 15" ::: "memory");
        E(acc, cur, wr, wc, fr, fq);
        if (!has_next) break;
#pragma unroll
        for (int a = 0; a < 2; ++a)
#pragma unroll
            for (int b = 0; b < 2; ++b)
#pragma unroll
                for (int m = 0; m < 4; ++m)
#pragma unroll
                    for (int n = 0; n < 2; ++n) acc[a][b][m][n] = (f32x4){0.f, 0.f, 0.f, 0.f};
        cur = nxt; cA = nA; cB = nB; vc00 = vn00; vc01 = vn01; vc10 = vn10; vc11 = vn11; ++ui;
    }
    PG8_WAIT_V(0);
    if (wr == 0) PG8_BAR;
    PG8_BAR;
#undef PG8_SA
#undef PG8_SB
#undef PG8_STAGE2
#undef PG8_LDA
#undef PG8_LDB
#undef PG8_LD16
#undef PG8_MMA
#undef PG8_WAIT_V
#undef PG8_WAIT_L
#undef PG8_BAR
#undef PG8_SCHED
#undef PG8_VOFF
}

__device__ __forceinline__ void static_tile(int L, int nM, int nN, int& pm, int& pn) {
    const int nwg = nM * nN; int wgid = L;
    { const int q = nwg / 8, r = nwg % 8, xcd = wgid % 8, off = wgid / 8; wgid = (xcd < r ? xcd * (q + 1) : r * (q + 1) + (xcd - r) * q) + off; }
    const int nig = 8 * nN, gid = wgid / nig, fm = gid * 8, gsz = (nM - fm) < 8 ? (nM - fm) : 8;
    pm = fm + ((wgid % nig) % gsz); pn = (wgid % nig) / gsz;
}
}

struct SchedIn {
    const Params* p;
    __device__ __forceinline__ bool next(int i, pg8::Unit& u) const {
        const long L = (long)i * gridDim.x + blockIdx.x;
        const char* HXb = (const char*)(p->ws + WS_HX); const char* BT = (const char*)(p->ws + WS_BTIN);
        u.rows = nullptr; u.rows_lds = -1; u.nvalid = 256; u.e = 0;
        if (L < 1280) { int j; pg8::static_tile((int)L, 64, 20, u.pm, j); u.pn = j < 12 ? j : j + 4; u.aux = 0; u.a = HXb + (size_t)u.pm * 256 * DM * 2; u.b = BT + (size_t)u.pn * 256 * DM * 2; return true; }
        if (L < 1344) { const int l = (int)L - 1280; u.pm = l >> 3; u.pn = l & 7; u.aux = 1; u.a = HXb + (size_t)(NTOK + u.pm * 256) * DM * 2; u.b = BT + (size_t)(4 + u.pn) * 256 * DM * 2; return true; }
        return false;
    }
};
struct SchedIn8 {
    const Params* p;
    __device__ __forceinline__ bool next(int i, pg8::Unit& u) const {
        int U;
        if (gridDim.x == 256) { const int c = blockIdx.x;
            if (c < 64) return false; else if (c < 192) { if (i >= 1) return false; U = c - 64; } else { if (i >= 2) return false; U = 128 + (c - 192) * 2 + i; }
        } else { const long L = (long)i * gridDim.x + blockIdx.x; if (L >= 256) return false; U = (int)L; }
        u.rows = nullptr; u.rows_lds = -1; u.nvalid = 256; u.e = 0; u.aux = 0; u.pm = U >> 2; u.pn = 12 + (U & 3);
        u.a = (const char*)(p->ws + WS_HX8) + (size_t)u.pm * 256 * DM; u.b = (const char*)(p->ws + WS_BTIN) + (size_t)3072 * DM * 2 + (size_t)(u.pn - 12) * 256 * DM; return true;
    }
};
struct EpiIn {
    const Params* p;
    __device__ __forceinline__ void operator()(const f32x4 (&acc)[2][2][4][2], const pg8::Unit& u, int wr, int wc, int fr, int fq) const {
        bf16_t* O; int ldc; bool act = false;
        if (u.aux == 0) { O = (bf16_t*)(p->ws + WS_P); ldc = PW; act = u.pn >= 16; } else { O = (bf16_t*)(p->ws + WS_PC); ldc = 2048; }
        const int row0 = u.pm * 256 + wr * 64 + fr, col0 = u.pn * 256 + wc * 32 + 8 * fq;
#pragma unroll
        for (int ai = 0; ai < 2; ++ai)
#pragma unroll
            for (int m = 0; m < 4; ++m) { bf16_t* rowp = O + (size_t)(row0 + ai * 128 + m * 16) * ldc + col0;
#pragma unroll
                for (int bj = 0; bj < 2; ++bj) { f32x4 v0 = acc[ai][bj][m][0], v1 = acc[ai][bj][m][1];
                    if (act) {
#pragma unroll
                        for (int j = 0; j < 4; ++j) { v0[j] = gelu_tanh_f(v0[j]); v1[j] = gelu_tanh_f(v1[j]); } }
                    u32x4 w; w.x = cvt_pk_bf16(v0[0], v0[1]); w.y = cvt_pk_bf16(v0[2], v0[3]); w.z = cvt_pk_bf16(v1[0], v1[1]); w.w = cvt_pk_bf16(v1[2], v1[3]);
                    *(u32x4*)(rowp + bj * 128) = w; } }
    }
};
struct SchedOut {
    const Params* p;
    __device__ __forceinline__ bool next(int i, pg8::Unit& u) const {
        const long L = (long)i * gridDim.x + blockIdx.x; if (L >= 512) return false;
        pg8::static_tile((int)L, 64, 8, u.pm, u.pn); u.rows = nullptr; u.rows_lds = -1; u.nvalid = 256; u.e = 0; u.aux = 0;
        u.a = (const char*)(p->ws + WS_YCAT) + (size_t)u.pm * 256 * DM * 2; u.b = (const char*)(p->ws + WS_BTOUT) + (size_t)u.pn * 256 * DM * 2; return true;
    }
};
struct EpiOut {
    const Params* p;
    __device__ __forceinline__ void operator()(const f32x4 (&acc)[2][2][4][2], const pg8::Unit& u, int wr, int wc, int fr, int fq) const {
        bf16_t* X1 = (bf16_t*)(p->ws + WS_X1); const float* pos = (const float*)(p->ws + WS_POS); const float* MOD = (const float*)(p->ws + WS_MOD); float* ST = (float*)(p->ws + WS_STATS);
        const int row0 = u.pm * 256 + wr * 64 + fr, col0 = u.pn * 256 + wc * 32 + 4 * fq;
        const int b = (u.pm * 256) / SEQ;
        f32x4 g1[2][2];
#pragma unroll
        for (int bj = 0; bj < 2; ++bj)
#pragma unroll
            for (int n = 0; n < 2; ++n) g1[bj][n] = *(const f32x4*)(MOD + (size_t)b * (NMOD * DM) + 2 * DM + col0 + bj * 128 + n * 16);
#pragma unroll
        for (int ai = 0; ai < 2; ++ai)
#pragma unroll
            for (int mp = 0; mp < 2; ++mp) {
                f32x4 xv[2][2][2], pv[2][2][2];
#pragma unroll
                for (int mm = 0; mm < 2; ++mm) { const int row = row0 + ai * 128 + (mp * 2 + mm) * 16; const int ts = row % SEQ, rr = ts >> 6, cc = ts & 63;
#pragma unroll
                    for (int bj = 0; bj < 2; ++bj)
#pragma unroll
                        for (int n = 0; n < 2; ++n) { const int col = col0 + bj * 128 + n * 16;
                            xv[mm][bj][n] = *(const f32x4*)(p->x + (size_t)row * DM + col);
                            pv[mm][bj][n] = *(const f32x4*)(col < 1024 ? pos + rr * 1024 + col : pos + 32 * 1024 + cc * 1024 + (col - 1024)); } }
#pragma unroll
                for (int mm = 0; mm < 2; ++mm) { const int m = mp * 2 + mm; const int row = row0 + ai * 128 + m * 16;
                    float s1 = 0.f, s2 = 0.f;
#pragma unroll
                    for (int bj = 0; bj < 2; ++bj)
#pragma unroll
                        for (int n = 0; n < 2; ++n) { const int col = col0 + bj * 128 + n * 16;
                            const f32x4 v = (xv[mm][bj][n] + pv[mm][bj][n]) * ALPHA + g1[bj][n] * acc[ai][bj][m][n];
                            { u32x2 o; o.x = pack2_h16(v[0], v[1]); o.y = pack2_h16(v[2], v[3]); *(u32x2*)(X1 + (size_t)row * DM + col) = o; }
                            s1 += (v[0] + v[1]) + (v[2] + v[3]); s2 += (v[0] * v[0] + v[1] * v[1]) + (v[2] * v[2] + v[3] * v[3]); }
                    s1 += __shfl_xor(s1, 16, 64); s2 += __shfl_xor(s2, 16, 64); s1 += __shfl_xor(s1, 32, 64); s2 += __shfl_xor(s2, 32, 64);
                    if (fq == 0) { atomicAdd(ST + (size_t)row * 2, s1); atomicAdd(ST + (size_t)row * 2 + 1, s2); } }
            }
    }
};
__device__ __forceinline__ bool moe_unit(int i, const LAS int* tab, int& P, int& nt) {
    const int G = gridDim.x, c = blockIdx.x;
    const int wgid = (G % 8 == 0) ? (c % 8) * (G / 8) + c / 8 : c;
    const long L = (long)i * G + wgid; P = (int)(L >> 3); nt = (int)(L & 7);
    return P < tab[160 * 4];
}
__device__ __forceinline__ void moe_build_table(const Params& p, LAS int* tab) {
    if (threadIdx.x == 0) {
        const unsigned* cnt = (const unsigned*)(p.ws + WS_CTL) + CW_CNT;
        int np = 0, off = 0;
        for (int e = 0; e < NE; ++e) { const int c = (int)cnt[e]; const int nmt = (c + 255) >> 8;
            for (int mt = 0; mt < nmt; ++mt) { tab[np * 4 + 0] = e; tab[np * 4 + 1] = mt; tab[np * 4 + 2] = off + mt * 256; tab[np * 4 + 3] = (c - mt * 256) < 256 ? (c - mt * 256) : 256; ++np; }
            off += nmt * 256; }
        tab[160 * 4] = np;
    }
    __syncthreads();
    LAS int* rl = (LAS int*)((LAS unsigned char*)tab - LDS_TAB + LDS_ROWS);
    for (int i = 0; i < 8; ++i) { int P, nt; if (!moe_unit(i, tab, P, nt)) break;
        const int e = tab[P * 4], mt = tab[P * 4 + 1];
        if (threadIdx.x < 256) rl[i * 256 + threadIdx.x] = ((const int*)(p.ws + WS_LIST))[(size_t)e * NTOK + mt * 256 + threadIdx.x]; }
    __syncthreads();
}
struct SchedMoe1 {
    const Params* p; const LAS int* tab;
    __device__ __forceinline__ bool next(int i, pg8::Unit& u) const {
        int P, nt; if (!moe_unit(i, tab, P, nt)) return false;
        const int e = tab[P * 4], mt = tab[P * 4 + 1];
        u.e = e; u.pm = P; u.pn = nt; u.aux = tab[P * 4 + 2]; u.nvalid = tab[P * 4 + 3];
        u.rows = nullptr; u.rows_lds = LDS_ROWS + i * 1024;
        u.a = (const char*)(p->ws + WS_T); u.b = (const char*)(p->ws + WS_BTGU) + (size_t)(e * 8 + nt) * 256 * DM; return true;
    }
};
struct EpiMoe1 {
    const Params* p;
    __device__ __forceinline__ void operator()(const f32x4 (&acc)[2][2][4][2], const pg8::Unit& u, int wr, int wc, int fr, int fq) const {
        unsigned char* H = (unsigned char*)(p->ws + WS_H);
        const int row0 = u.aux + wr * 64 + fr, col0 = u.pn * 128 + wc * 32 + 8 * fq;
#pragma unroll
        for (int ai = 0; ai < 2; ++ai)
#pragma unroll
            for (int m = 0; m < 4; ++m) { unsigned char* rowp = H + (size_t)(row0 + ai * 128 + m * 16) * DE + col0;
                float h[8];
#pragma unroll
                for (int n = 0; n < 2; ++n)
#pragma unroll
                    for (int j = 0; j < 4; ++j) h[n * 4 + j] = silu_f(acc[ai][0][m][n][j]) * acc[ai][1][m][n][j];
                u32x2 w; w.x = pack4_fp8(h[0], h[1], h[2], h[3]); w.y = pack4_fp8(h[4], h[5], h[6], h[7]);
                *(u32x2*)rowp = w; }
    }
};
struct SchedMoe2 {
    const Params* p; const LAS int* tab;
    __device__ __forceinline__ bool next(int i, pg8::Unit& u) const {
        int P, nt; if (!moe_unit(i, tab, P, nt)) return false;
        const int e = tab[P * 4], mt = tab[P * 4 + 1];
        u.e = LDS_ROWS + i * 1024; u.pm = P; u.pn = nt; u.aux = mt; u.nvalid = tab[P * 4 + 3]; u.rows = nullptr; u.rows_lds = -1;
        u.a = (const char*)(p->ws + WS_H) + (size_t)tab[P * 4 + 2] * DE; u.b = (const char*)(p->ws + WS_BTDN) + ((size_t)e * DM + nt * 256) * DE; return true;
    }
};
struct EpiMoe2 {
    const Params* p; LAS unsigned char* lds;
    __device__ __forceinline__ void operator()(const f32x4 (&acc)[2][2][4][2], const pg8::Unit& u, int wr, int wc, int fr, int fq) const {
        unsigned char* Y2 = (unsigned char*)(p->ws + WS_Y2);
        const LAS int* list = (const LAS int*)(lds + u.e);
        const int r0 = wr * 64 + fr, col0 = u.pn * 256 + wc * 32 + 8 * fq;
        int ents[2][4];
#pragma unroll
        for (int ai = 0; ai < 2; ++ai)
#pragma unroll
            for (int m = 0; m < 4; ++m) { const int r = r0 + ai * 128 + m * 16; ents[ai][m] = r < u.nvalid ? list[r] : 0; }
#pragma unroll
        for (int ai = 0; ai < 2; ++ai)
#pragma unroll
            for (int m = 0; m < 4; ++m) { const int r = r0 + ai * 128 + m * 16;
                if (r < u.nvalid) { const int ent = ents[ai][m]; unsigned char* rowp = Y2 + (size_t)ent * DM + col0;
#pragma unroll
                    for (int bj = 0; bj < 2; ++bj) { const f32x4 v0 = acc[ai][bj][m][0] * 16.0f, v1 = acc[ai][bj][m][1] * 16.0f;
                        u32x2 w; w.x = pack4_fp8(v0[0], v0[1], v0[2], v0[3]); w.y = pack4_fp8(v1[0], v1[1], v1[2], v1[3]);
                        *(u32x2*)(rowp + bj * 128) = w; } } }
    }
};

typedef short s16x4 __attribute__((ext_vector_type(4)));
__device__ __forceinline__ s16x4 tr16(const LAS unsigned char* p) { return __builtin_bit_cast(s16x4, __builtin_amdgcn_ds_read_tr16_b64_v4i16((LAS s16x4*)p)); }
__device__ __forceinline__ bf16x8 tr_frag(const LAS unsigned char* tile, int pitchB, int k0, int c0, int lane) {
    const int g = lane >> 4, i = lane & 15;
    const LAS unsigned char* a = tile + (k0 + 8 * g + (i >> 2)) * pitchB + (c0 + 4 * (i & 3)) * 2;
    const s16x4 lo = tr16(a), hi = tr16(a + 4 * pitchB);
    return (bf16x8){lo[0], lo[1], lo[2], lo[3], hi[0], hi[1], hi[2], hi[3]};
}
__device__ __forceinline__ bf16x8 row_frag(const LAS unsigned char* tile, int pitchB, int r0, int k0, int lane) {
    return *(const LAS bf16x8*)(tile + (r0 + (lane & 15)) * pitchB + (k0 + 8 * (lane >> 4)) * 2);
}
#define DPPF(old_, src_, ctrl_, rmask_) __int_as_float(__builtin_amdgcn_update_dpp(__float_as_int(old_), __float_as_int(src_), (ctrl_), (rmask_), 0xf, false))
__device__ __forceinline__ float row16_sum(float v) {
    v += DPPF(0.f, v, 0x128, 0xf); v += DPPF(0.f, v, 0x124, 0xf); v += DPPF(0.f, v, 0x122, 0xf); v += DPPF(0.f, v, 0x121, 0xf); return v;
}
__device__ __forceinline__ float wscan_sum(float v, int) {
    v += DPPF(0.f, v, 0x111, 0xf); v += DPPF(0.f, v, 0x112, 0xf); v += DPPF(0.f, v, 0x114, 0xf); v += DPPF(0.f, v, 0x118, 0xf);
    v += DPPF(0.f, v, 0x142, 0xa); v += DPPF(0.f, v, 0x143, 0xc); return v;
}
__device__ __forceinline__ float wscan_max(float v, int) {
    const float ninf = -3.0e38f;
    v = fmaxf(v, DPPF(ninf, v, 0x111, 0xf)); v = fmaxf(v, DPPF(ninf, v, 0x112, 0xf)); v = fmaxf(v, DPPF(ninf, v, 0x114, 0xf)); v = fmaxf(v, DPPF(ninf, v, 0x118, 0xf));
    v = fmaxf(v, DPPF(ninf, v, 0x142, 0xa)); v = fmaxf(v, DPPF(ninf, v, 0x143, 0xc)); return v;
}
__device__ __forceinline__ float wave_max(float v) {
#pragma unroll
    for (int o = 32; o > 0; o >>= 1) v = fmaxf(v, __shfl_xor(v, o, 64));
    return v;
}
__device__ __forceinline__ void conv8x8_load(const bf16_t* src, size_t pitch, int tfirst, int len, u32x4 (&raw)[10]) {
#pragma unroll
    for (int i = 0; i < 10; ++i) { const int ts = tfirst - 1 + i; raw[i] = (ts >= 0 && ts < len) ? *(const u32x4*)(src + (size_t)ts * pitch) : (u32x4){0u, 0u, 0u, 0u}; }
}
__device__ __forceinline__ void conv8x8_compute(const u32x4 (&raw)[10], const float* cw, const float* cb, int ch, float scale, LAS unsigned char* dst, int dpitchB) {
    float w0[8], w1[8], w2[8], bb[8];
#pragma unroll
    for (int j = 0; j < 8; ++j) { w0[j] = cw[ch + j]; w1[j] = cw[2048 + ch + j]; w2[j] = cw[4096 + ch + j]; bb[j] = cb[ch + j]; }
    float a[8], b[8], c[8];
    unpack8(raw[0], a); unpack8(raw[1], b);
#pragma unroll
    for (int r = 0; r < 8; ++r) {
        unpack8(raw[r + 2], c);
        float o[8];
#pragma unroll
        for (int j = 0; j < 8; ++j) o[j] = silu_f(bb[j] + w0[j] * a[j] + w1[j] * b[j] + w2[j] * c[j]) * scale;
        *(LAS u32x4*)(dst + r * dpitchB) = pack8(o);
#pragma unroll
        for (int j = 0; j < 8; ++j) { a[j] = b[j]; b[j] = c[j]; }
    }
}
__device__ __forceinline__ void conv8x8(const bf16_t* src, size_t pitch, int tfirst, int len, const float* cw, const float* cb, int ch, float scale, LAS unsigned char* dst, int dpitchB) {
    u32x4 raw[10]; conv8x8_load(src, pitch, tfirst, len, raw); conv8x8_compute(raw, cw, cb, ch, scale, dst, dpitchB);
}

constexpr int SC_V0 = 0, SC_V1 = 65536, SC_K = 131072, SC_VEC = SC_K + 18432;
struct ScanSrc { const bf16_t* src; size_t pitch; int kcol, vcol, len, t0, c; const float* grow; bool isx; };
__device__ __forceinline__ ScanSrc scan_src(const Params& p, int step, int b, int h, int dir, int es) {
    ScanSrc q; q.isx = step >= 2;
    q.c = q.isx ? (dir ? 17 - step : step - 2) : (dir ? 1 - step : step);
    q.src = q.isx ? (const bf16_t*)(p.ws + WS_P) + (size_t)(b * SEQ) * PW : (const bf16_t*)(p.ws + WS_PC) + (size_t)(b * CTXL) * 2048;
    q.pitch = q.isx ? PW : 2048;
    q.kcol = (q.isx ? 1024 : 0) + h * HD + es * 64; q.vcol = (q.isx ? 2048 : 1024) + h * HD; q.len = q.isx ? SEQ : CTXL; q.t0 = q.c * CHK;
    q.grow = (const float*)(p.ws + WS_GATES) + (size_t)(q.isx ? b * SEQ + q.t0 : NTOK + b * CTXL + q.t0) * NGATE + dir * 8 + h;
    return q;
}
__device__ __forceinline__ void glds16_asm(const void* g, unsigned ldsaddr) {
    asm volatile("s_mov_b32 m0, %1\n\ts_nop 0\n\tglobal_load_lds_dwordx4 %0, off" :: "v"(g), "s"(ldsaddr) : "memory", "m0");
}
__device__ __forceinline__ void scan_vdma(const ScanSrc& q, LAS unsigned char* vb, int wid, int lane) {
    const unsigned base = __builtin_amdgcn_readfirstlane((unsigned)(__SIZE_TYPE__)(vb + 8 * wid * 1024));
#pragma unroll
    for (int i = 0; i < 8; ++i) { const int row = 2 * (8 * wid + i) + (lane >> 5); const int gc = (lane & 31) ^ (row & 7);
        glds16_asm(q.src + (size_t)(q.t0 + row) * q.pitch + q.vcol + gc * 8, base + i * 1024); }
}
__device__ __forceinline__ bf16x8 tr_frag_swz(const LAS unsigned char* tile, int k0, int c0, int lane) {
    const int g = lane >> 4, i = lane & 15, r = i >> 2, col = c0 + 4 * (i & 3);
    const int row = k0 + 8 * g + r;
    const LAS unsigned char* a0 = tile + row * 512 + (((col >> 3) ^ r) << 4) + ((col & 4) << 1);
    const LAS unsigned char* a1 = tile + (row + 4) * 512 + (((col >> 3) ^ (r + 4)) << 4) + ((col & 4) << 1);
    const s16x4 lo = tr16(a0), hi = tr16(a1);
    return (bf16x8){lo[0], lo[1], lo[2], lo[3], hi[0], hi[1], hi[2], hi[3]};
}
__device__ __forceinline__ void conv4x8_load(const bf16_t* src, size_t pitch, int tfirst, int len, u32x4 (&raw)[6]) {
#pragma unroll
    for (int i = 0; i < 6; ++i) { const int ts = tfirst - 1 + i; raw[i] = (ts >= 0 && ts < len) ? *(const u32x4*)(src + (size_t)ts * pitch) : (u32x4){0u, 0u, 0u, 0u}; }
}
__device__ __forceinline__ void conv4x8_load_async(const bf16_t* src, size_t pitch, int tfirst, int len, u32x4 (&raw)[6]) {
#pragma unroll
    for (int i = 0; i < 6; ++i) { const int ts = tfirst - 1 + i; const bf16_t* a = src + (size_t)ts * pitch;
        raw[i] = (u32x4){0u, 0u, 0u, 0u};
        if (ts >= 0 && ts < len) asm volatile("global_load_dwordx4 %0, %1, off" : "+v"(raw[i]) : "v"(a) : "memory"); }
}
__device__ __forceinline__ void conv4x8_compute(const u32x4 (&raw)[6], const float (&w0)[8], const float (&w1)[8], const float (&w2)[8], const float (&bb)[8], const LAS float* wrow, LAS unsigned char* dst, int dpitchB) {
    float a[8], b[8], c[8];
    unpack8(raw[0], a); unpack8(raw[1], b);
#pragma unroll
    for (int r = 0; r < 4; ++r) {
        unpack8(raw[r + 2], c);
        const float sc = 0.0625f * wrow[r];
        float o[8];
#pragma unroll
        for (int j = 0; j < 8; ++j) o[j] = silu_f(bb[j] + w0[j] * a[j] + w1[j] * b[j] + w2[j] * c[j]) * sc;
        const u32x4 pk = pack8(o);
        *(LAS u32x2*)(dst + r * dpitchB) = (u32x2){pk.x, pk.y}; *(LAS u32x2*)(dst + r * dpitchB + 32) = (u32x2){pk.z, pk.w};
#pragma unroll
        for (int j = 0; j < 8; ++j) { a[j] = b[j]; b[j] = c[j]; }
    }
}
__device__ __forceinline__ void phase_scan(const Params& p, LAS unsigned char* lds) {
    const int tid = threadIdx.x, lane = tid & 63, wid = __builtin_amdgcn_readfirstlane(tid >> 6), wm = wid >> 1, wn = wid & 1;
    LAS float* wtab = (LAS float*)(lds + SC_VEC);
    LAS float* sbl = wtab + 18 * 128;
    bf16_t* CST = (bf16_t*)(p.ws + WS_CST); float* NST = (float*)(p.ws + WS_NST); float* MST = (float*)(p.ws + WS_MST);
    const int cg = tid & 7, rb = (tid >> 3) & 31;
    const bf16x8 ones = (bf16x8){0x3f80, 0x3f80, 0x3f80, 0x3f80, 0x3f80, 0x3f80, 0x3f80, 0x3f80};
    for (int unit0 = blockIdx.x; unit0 < 256; unit0 += gridDim.x) {
        const int es = (unit0 >> 3) & 3, combo = (unit0 >> 5) * 8 + (unit0 & 7);
        const int dir = combo & 1, h = (combo >> 1) & 3, b = combo >> 3;
        const int sidx = (b * 4 + h) * 2 + dir;
        const int s0 = dir ? 127 - lane : lane, s1 = dir ? 63 - lane : 64 + lane;
        asm volatile("s_waitcnt vmcnt(0) lgkmcnt(0)" ::: "memory"); __builtin_amdgcn_s_barrier();
        LAS float* taps = sbl + 160;
        if (tid < 64) { const int ch = 1024 + h * HD + es * 64 + tid;
            taps[tid] = p.conv_w[ch]; taps[64 + tid] = p.conv_w[2048 + ch]; taps[128 + tid] = p.conv_w[4096 + ch]; taps[192 + tid] = p.conv_b[ch]; }
        u32x4 kraw[6], krb[6];
#pragma unroll
        for (int i = 0; i < 6; ++i) krb[i] = (u32x4){0u, 0u, 0u, 0u};
        {   const ScanSrc q = scan_src(p, 0, b, h, dir, es);
            scan_vdma(q, lds + SC_V0, wid, lane);
            if (tid < 256) conv4x8_load_async(q.src + q.kcol + cg * 8, q.pitch, q.t0 + rb * 4, q.len, kraw); }
        for (int st = wid; st < 18; st += 8) {
            const ScanSrc q = scan_src(p, st, b, h, dir, es);
            const float li0 = q.grow[(size_t)s0 * NGATE], lf0 = q.grow[(size_t)s0 * NGATE + 4], li1 = q.grow[(size_t)s1 * NGATE], lf1 = q.grow[(size_t)s1 * NGATE + 4];
            const float b0 = wscan_sum(lf0, lane); const float tot0 = __shfl(b0, 63, 64); const float b1 = wscan_sum(lf1, lane) + tot0; const float blast = __shfl(b1, 63, 64);
            const float a0 = blast - b0 + li0, a1 = blast - b1 + li1;
            const float mloc = wave_max(fmaxf(a0, a1));
            wtab[st * 128 + s0] = a0; wtab[st * 128 + s1] = a1;
            if (lane == 0) { sbl[st] = blast; sbl[32 + st] = mloc; }
        }
        asm volatile("s_waitcnt lgkmcnt(0)" ::: "memory"); __builtin_amdgcn_s_barrier();
        if (tid == 0) { float m = 0.f;
            for (int st = 0; st < 18; ++st) { const float bl = sbl[st], ml = sbl[32 + st]; const float mn = fmaxf(bl + m, ml); sbl[64 + st] = __expf(bl + m - mn); sbl[96 + st] = m; sbl[128 + st] = mn; m = mn; } }
        asm volatile("s_waitcnt lgkmcnt(0)" ::: "memory"); __builtin_amdgcn_s_barrier();
        for (int i = tid; i < 18 * 128; i += 512) wtab[i] = __expf(wtab[i] - sbl[128 + (i >> 7)]);
        f32x4 acc[2][4], accn[2];
#pragma unroll
        for (int n = 0; n < 2; ++n) { accn[n] = (f32x4){0.f, 0.f, 0.f, 0.f};
#pragma unroll
            for (int m = 0; m < 4; ++m) acc[n][m] = (f32x4){0.f, 0.f, 0.f, 0.f}; }
#define SCAN_STEP(step, KCUR, KNXT) do { \
            const ScanSrc q = scan_src(p, (step), b, h, dir, es); \
            if ((step) >= 3) asm volatile("s_waitcnt vmcnt(4) lgkmcnt(0)" ::: "memory"); else asm volatile("s_waitcnt vmcnt(0) lgkmcnt(0)" ::: "memory");     \
            __builtin_amdgcn_s_barrier();      \
            if (q.isx) { \
                if (wm == 0 && (lane & 15) == 0) { _Pragma("unroll") for (int n = 0; n < 2; ++n) *(f32x4*)(NST + ((size_t)sidx * 16 + q.c) * 256 + es * 64 + 32 * wn + 8 * (lane >> 4) + 4 * n) = accn[n]; } \
                if (es == 0 && tid == 0) MST[sidx * 16 + q.c] = sbl[96 + (step)]; \
            } \
            if ((step) < 17) { const ScanSrc qn = scan_src(p, (step) + 1, b, h, dir, es); scan_vdma(qn, lds + (((step) + 1) & 1 ? SC_V1 : SC_V0), wid, lane); }     \
            if ((step) < 17 && tid < 256) { const ScanSrc qn = scan_src(p, (step) + 1, b, h, dir, es); conv4x8_load_async(qn.src + qn.kcol + cg * 8, qn.pitch, qn.t0 + rb * 4, qn.len, KNXT); }     \
            asm volatile("" ::: "memory"); \
            if (q.isx) {                                                          \
                bf16_t* cdst = CST + ((size_t)sidx * 16 + q.c) * 65536 + es * 64 + 32 * wn + 8 * (lane >> 4); \
                _Pragma("unroll") for (int m = 0; m < 4; ++m) { u32x4 o; o.x = cvt_pk_bf16(acc[0][m][0], acc[0][m][1]); o.y = cvt_pk_bf16(acc[0][m][2], acc[0][m][3]); o.z = cvt_pk_bf16(acc[1][m][0], acc[1][m][1]); o.w = cvt_pk_bf16(acc[1][m][2], acc[1][m][3]); \
                        *(u32x4*)(cdst + (size_t)(64 * wm + 16 * m + (lane & 15)) * 256) = o; } \
            } \
            if (tid < 256) { float cw0[8], cw1[8], cw2[8], cbb[8]; \
                _Pragma("unroll") for (int hh = 0; hh < 2; ++hh) { const f32x4 t0 = *(const LAS f32x4*)(taps + cg * 8 + hh * 4), t1 = *(const LAS f32x4*)(taps + 64 + cg * 8 + hh * 4), t2 = *(const LAS f32x4*)(taps + 128 + cg * 8 + hh * 4), t3 = *(const LAS f32x4*)(taps + 192 + cg * 8 + hh * 4); \
                    _Pragma("unroll") for (int j = 0; j < 4; ++j) { cw0[hh * 4 + j] = t0[j]; cw1[hh * 4 + j] = t1[j]; cw2[hh * 4 + j] = t2[j]; cbb[hh * 4 + j] = t3[j]; } } \
                conv4x8_compute(KCUR, cw0, cw1, cw2, cbb, wtab + (step) * 128 + rb * 4, lds + SC_K + (rb * 4) * 144 + (cg >> 2) * 64 + (cg & 3) * 8, 144); } \
            asm volatile("s_waitcnt lgkmcnt(0)" ::: "memory"); __builtin_amdgcn_s_barrier();                 \
            const LAS unsigned char* vt = lds + (((step) & 1) ? SC_V1 : SC_V0); \
            const float so = sbl[64 + (step)]; \
            _Pragma("unroll") for (int n = 0; n < 2; ++n) { accn[n] *= so; _Pragma("unroll") for (int m = 0; m < 4; ++m) acc[n][m] *= so; } \
            _Pragma("unroll") for (int ks = 0; ks < 4; ++ks) { \
                bf16x8 af[4], bfr[2]; \
                _Pragma("unroll") for (int m = 0; m < 4; ++m) af[m] = tr_frag_swz(vt, ks * 32, 64 * wm + 16 * m, lane); \
                _Pragma("unroll") for (int n = 0; n < 2; ++n) bfr[n] = tr_frag(lds + SC_K, 144, ks * 32, 32 * wn + 16 * n, lane); \
                _Pragma("unroll") for (int n = 0; n < 2; ++n) { accn[n] = __builtin_amdgcn_mfma_f32_16x16x32_bf16(bfr[n], ones, accn[n], 0, 0, 0); \
                    _Pragma("unroll") for (int m = 0; m < 4; ++m) acc[n][m] = __builtin_amdgcn_mfma_f32_16x16x32_bf16(bfr[n], af[m], acc[n][m], 0, 0, 0); } \
            } } while (0)
#pragma unroll 1
        for (int step = 0; step < 18; step += 2) { SCAN_STEP(step, kraw, krb); SCAN_STEP(step + 1, krb, kraw); }
#undef SCAN_STEP
    }
    asm volatile("s_waitcnt vmcnt(0) lgkmcnt(0)" ::: "memory"); __builtin_amdgcn_s_barrier();
}

constexpr int MX_Q = 0, MX_K = 67584, MX_P = 100352, MX_VEC = 135168;
enum { V_GF = 0, V_GB = 128, V_MF = 256, V_MB = 384, V_SIF = 512, V_SIB = 640, V_EMF = 768, V_EMB = 896, V_RF = 1024, V_RB = 1152, V_AF = 1280, V_AB = 1408, V_DQF = 1536, V_DQB = 1664,
       V_NF = 1792, V_NB = 2048, V_RSF = 2304, V_RSB = 2816, V_END = 3328 };
__device__ __forceinline__ void mix_unit(const Params& p, LAS unsigned char* lds, int unit) {
    const int tid = threadIdx.x, lane = tid & 63, wid = __builtin_amdgcn_readfirstlane(tid >> 6), wm = wid >> 2, wn = wid & 3, lg = lane >> 4, li_ = lane & 15;
    LAS float* vec = (LAS float*)(lds + MX_VEC);
    const int c = unit & 15, h = (unit >> 4) & 3, b = unit >> 6;
    const bf16_t* P = (const bf16_t*)(p.ws + WS_P); const float* G = (const float*)(p.ws + WS_GATES);
    const bf16_t* CST = (const bf16_t*)(p.ws + WS_CST); const float* NST = (const float*)(p.ws + WS_NST); const float* MST = (const float*)(p.ws + WS_MST);
    const int sf = (b * 4 + h) * 2, sb = sf + 1;
    const int t0 = c * CHK; const size_t tok0 = (size_t)b * SEQ + t0;
    const bf16_t* srcb = P + (size_t)(b * SEQ) * PW;
    __syncthreads();
    float gq[5] = {0.f, 0.f, 0.f, 0.f, 0.f}, nfq = 0.f, nbq = 0.f;
    if (wid < 2) { const int dir = wid; const float* grow = G + tok0 * NGATE + dir * 8 + h; const int s0 = dir ? 127 - lane : lane, s1 = dir ? 63 - lane : 64 + lane;
        gq[0] = grow[(size_t)s0 * NGATE]; gq[1] = grow[(size_t)s0 * NGATE + 4]; gq[2] = grow[(size_t)s1 * NGATE]; gq[3] = grow[(size_t)s1 * NGATE + 4]; gq[4] = MST[(dir ? sb : sf) * 16 + c]; }
    if (tid < 256) { nfq = NST[((size_t)sf * 16 + c) * 256 + tid]; nbq = NST[((size_t)sb * 16 + c) * 256 + tid]; }
    { const int cg = tid & 31, rb = tid >> 5;
      u32x4 qraw[10], kraw[10];
      conv8x8_load(srcb + h * HD + cg * 8, PW, t0 + rb * 8, SEQ, qraw); conv8x8_load(srcb + 1024 + h * HD + cg * 8, PW, t0 + rb * 8, SEQ, kraw);
      conv8x8_compute(qraw, p.conv_w, p.conv_b, h * HD + cg * 8, 1.0f, lds + MX_Q + (rb * 8) * 528 + cg * 16, 528);
      conv8x8_compute(kraw, p.conv_w, p.conv_b, 1024 + h * HD + cg * 8, 0.0625f, lds + MX_K + (rb * 8) * 528 + cg * 16, 528); }
    if (tid < 256) { vec[V_NF + tid] = nfq; vec[V_NB + tid] = nbq; }
    if (wid < 2) {
        const int dir = wid;
        const int s0 = dir ? 127 - lane : lane, s1 = dir ? 63 - lane : 64 + lane;
        const float min_ = gq[4], li0 = gq[0], lf0 = gq[1], li1 = gq[2], lf1 = gq[3];
        const float b0 = wscan_sum(lf0, lane); const float tot0 = __shfl(b0, 63, 64); const float b1 = wscan_sum(lf1, lane) + tot0;
        const float g0 = li0 - b0, g1 = li1 - b1;
        const float cm0 = wscan_max(g0, lane); const float tm0 = __shfl(cm0, 63, 64); const float cm1 = fmaxf(wscan_max(g1, lane), tm0);
        const float M0 = fmaxf(min_, cm0), M1 = fmaxf(min_, cm1);
        const int o = dir * 128;
        vec[V_GF + o + s0] = g0; vec[V_GF + o + s1] = g1; vec[V_MF + o + s0] = M0; vec[V_MF + o + s1] = M1;
        vec[V_SIF + o + s0] = __expf(min_ - M0); vec[V_SIF + o + s1] = __expf(min_ - M1);
        vec[V_EMF + o + s0] = __expf(-b0 - M0); vec[V_EMF + o + s1] = __expf(-b1 - M1);
    }
    __syncthreads();
    f32x4 sacc[4][2];
#pragma unroll
    for (int m = 0; m < 4; ++m)
#pragma unroll
        for (int n = 0; n < 2; ++n) sacc[m][n] = (f32x4){0.f, 0.f, 0.f, 0.f};
#pragma unroll 2
    for (int ks = 0; ks < 8; ++ks) {
        bf16x8 af[4], bfr[2];
#pragma unroll
        for (int m = 0; m < 4; ++m) af[m] = row_frag(lds + MX_Q, 528, 64 * wm + 16 * m, ks * 32, lane);
#pragma unroll
        for (int n = 0; n < 2; ++n) bfr[n] = row_frag(lds + MX_K, 528, 32 * wn + 16 * n, ks * 32, lane);
#pragma unroll
        for (int m = 0; m < 4; ++m)
#pragma unroll
            for (int n = 0; n < 2; ++n) sacc[m][n] = __builtin_amdgcn_mfma_f32_16x16x32_bf16(af[m], bfr[n], sacc[m][n], 0, 0, 0);
    }
    {
        const int t = tid >> 2, part = tid & 3; float df = 0.f, db = 0.f;
#pragma unroll 4
        for (int i = 0; i < 8; ++i) { float f[8]; unpack8(*(const LAS u32x4*)(lds + MX_Q + t * 528 + (part * 64 + i * 8) * 2), f);
#pragma unroll
            for (int j = 0; j < 8; ++j) { df += f[j] * vec[V_NF + part * 64 + i * 8 + j]; db += f[j] * vec[V_NB + part * 64 + i * 8 + j]; } }
        df += __shfl_xor(df, 1, 64); df += __shfl_xor(df, 2, 64); db += __shfl_xor(db, 1, 64); db += __shfl_xor(db, 2, 64);
        if (part == 0) { vec[V_DQF + t] = df; vec[V_DQB + t] = db; }
    }
    f32x4 pf[4][2], pb[4][2];
    {
        float gf[2], gb[2];
#pragma unroll
        for (int n = 0; n < 2; ++n) { const int s_ = 32 * wn + 16 * n + li_; gf[n] = vec[V_GF + s_]; gb[n] = vec[V_GB + s_]; }
#pragma unroll
        for (int m = 0; m < 4; ++m)
#pragma unroll
            for (int j = 0; j < 4; ++j) {
                const int t = 64 * wm + 16 * m + 4 * lg + j; const float Mf = vec[V_MF + t], Mb = vec[V_MB + t];
                float rsf = 0.f, rsb = 0.f;
#pragma unroll
                for (int n = 0; n < 2; ++n) { const int s_ = 32 * wn + 16 * n + li_;
                    const float ef = (s_ <= t) ? __expf(fminf(gf[n] - Mf, 0.f)) : 0.f, eb = (s_ >= t) ? __expf(fminf(gb[n] - Mb, 0.f)) : 0.f;
                    const float sv = sacc[m][n][j]; pf[m][n][j] = sv * ef; pb[m][n][j] = sv * eb; rsf += pf[m][n][j]; rsb += pb[m][n][j]; }
                rsf = row16_sum(rsf); rsb = row16_sum(rsb);
                if (li_ == 0) { vec[V_RSF + t * 4 + wn] = rsf; vec[V_RSB + t * 4 + wn] = rsb; }
            }
    }
    __syncthreads();
    if (tid < 128) { const int t = tid;
        const float denf = vec[V_RSF + t * 4] + vec[V_RSF + t * 4 + 1] + vec[V_RSF + t * 4 + 2] + vec[V_RSF + t * 4 + 3] + vec[V_SIF + t] * vec[V_DQF + t];
        const float denb = vec[V_RSB + t * 4] + vec[V_RSB + t * 4 + 1] + vec[V_RSB + t * 4 + 2] + vec[V_RSB + t * 4 + 3] + vec[V_SIB + t] * vec[V_DQB + t];
        const float rf = 1.0f / fmaxf(fabsf(denf), vec[V_EMF + t]), rb = 1.0f / fmaxf(fabsf(denb), vec[V_EMB + t]);
        vec[V_RF + t] = rf; vec[V_RB + t] = rb; vec[V_AF + t] = rf * vec[V_SIF + t]; vec[V_AB + t] = rb * vec[V_SIB + t]; }
    __syncthreads();
#pragma unroll
    for (int m = 0; m < 4; ++m)
#pragma unroll
        for (int j = 0; j < 4; ++j) { const int t = 64 * wm + 16 * m + 4 * lg + j; const float rf = vec[V_RF + t], rb = vec[V_RB + t];
#pragma unroll
            for (int n = 0; n < 2; ++n) *(LAS bf16_t*)(lds + MX_P + t * 272 + (32 * wn + 16 * n + li_) * 2) = f2bf(rf * pf[m][n][j] + rb * pb[m][n][j]); }
    f32x4 acc[4][4];
    {
        const bf16_t* cqf = CST + ((size_t)sf * 16 + c) * 65536 + (size_t)(64 * wn + li_) * 256 + 8 * lg;
        const bf16_t* cqb = CST + ((size_t)sb * 16 + c) * 65536 + (size_t)(64 * wn + li_) * 256 + 8 * lg;
        bf16x8 bq0[4], bq1[4];
#pragma unroll
        for (int n = 0; n < 4; ++n) bq0[n] = *(const bf16x8*)(cqf + (size_t)(16 * n) * 256);
#pragma unroll 1
        for (int dirq = 0; dirq < 2; ++dirq) {
            f32x4 accx[4][4];
#pragma unroll
            for (int m = 0; m < 4; ++m)
#pragma unroll
                for (int n = 0; n < 4; ++n) accx[m][n] = (f32x4){0.f, 0.f, 0.f, 0.f};
            const bf16_t* cx = dirq ? cqb : cqf;
#pragma unroll 1
            for (int ks = 0; ks < 8; ks += 2) {
#pragma unroll
                for (int n = 0; n < 4; ++n) bq1[n] = *(const bf16x8*)(cx + (size_t)(16 * n) * 256 + (ks + 1) * 32);
                {   bf16x8 af[4];
#pragma unroll
                    for (int m = 0; m < 4; ++m) af[m] = row_frag(lds + MX_Q, 528, 64 * wm + 16 * m, ks * 32, lane);
#pragma unroll
                    for (int m = 0; m < 4; ++m)
#pragma unroll
                        for (int n = 0; n < 4; ++n) accx[m][n] = __builtin_amdgcn_mfma_f32_16x16x32_bf16(af[m], bq0[n], accx[m][n], 0, 0, 0); }
                {   const bf16_t* nx = ks < 6 ? cx + (ks + 2) * 32 : cqb;
#pragma unroll
                    for (int n = 0; n < 4; ++n) bq0[n] = *(const bf16x8*)(nx + (size_t)(16 * n) * 256); }
                {   bf16x8 af[4];
#pragma unroll
                    for (int m = 0; m < 4; ++m) af[m] = row_frag(lds + MX_Q, 528, 64 * wm + 16 * m, (ks + 1) * 32, lane);
#pragma unroll
                    for (int m = 0; m < 4; ++m)
#pragma unroll
                        for (int n = 0; n < 4; ++n) accx[m][n] = __builtin_amdgcn_mfma_f32_16x16x32_bf16(af[m], bq1[n], accx[m][n], 0, 0, 0); }
            }
#pragma unroll
            for (int m = 0; m < 4; ++m)
#pragma unroll
                for (int j = 0; j < 4; ++j) { const int t = 64 * wm + 16 * m + 4 * lg + j; const float a_x = vec[(dirq ? V_AB : V_AF) + t];
#pragma unroll
                    for (int n = 0; n < 4; ++n) acc[m][n][j] = dirq ? acc[m][n][j] + a_x * accx[m][n][j] : a_x * accx[m][n][j]; }
        }
    }
    u32x4 vreg[8];
#pragma unroll
    for (int i = 0; i < 8; ++i) { const int piece = tid + 512 * i; vreg[i] = *(const u32x4*)(srcb + (size_t)(t0 + (piece >> 5)) * PW + 2048 + h * HD + (piece & 31) * 8); }
    __syncthreads();
#pragma unroll
    for (int i = 0; i < 8; ++i) { const int piece = tid + 512 * i, row = piece >> 5; *(LAS u32x4*)(lds + MX_Q + row * 528 + (piece & 31) * 16) = vreg[i]; }
    __syncthreads();
#pragma unroll
    for (int ks = 0; ks < 4; ++ks) {
        bf16x8 af[4], bfr[4];
#pragma unroll
        for (int m = 0; m < 4; ++m) af[m] = row_frag(lds + MX_P, 272, 64 * wm + 16 * m, ks * 32, lane);
#pragma unroll
        for (int n = 0; n < 4; ++n) bfr[n] = tr_frag(lds + MX_Q, 528, ks * 32, 64 * wn + 16 * n, lane);
#pragma unroll
        for (int m = 0; m < 4; ++m)
#pragma unroll
            for (int n = 0; n < 4; ++n) acc[m][n] = __builtin_amdgcn_mfma_f32_16x16x32_bf16(af[m], bfr[n], acc[m][n], 0, 0, 0);
    }
    u32x4 oraw[8];
#pragma unroll
    for (int i = 0; i < 8; ++i) { const int piece = tid + 512 * i; oraw[i] = *(const u32x4*)(P + (tok0 + (piece >> 5)) * PW + 3072 + h * HD + (piece & 31) * 8); }
#pragma unroll
    for (int m = 0; m < 4; ++m)
#pragma unroll
        for (int j = 0; j < 4; ++j) { const float sm = row16_sum(acc[m][0][j] + acc[m][1][j] + acc[m][2][j] + acc[m][3][j]);
            if (li_ == 0) vec[V_RSF + (64 * wm + 16 * m + 4 * lg + j) * 4 + wn] = sm; }
    __syncthreads();
    float mu[4][4];
#pragma unroll
    for (int m = 0; m < 4; ++m)
#pragma unroll
        for (int j = 0; j < 4; ++j) { const int t = 64 * wm + 16 * m + 4 * lg + j;
            mu[m][j] = (vec[V_RSF + t * 4] + vec[V_RSF + t * 4 + 1] + vec[V_RSF + t * 4 + 2] + vec[V_RSF + t * 4 + 3]) * (1.0f / 256.0f);
            float sq = 0.f;
#pragma unroll
            for (int n = 0; n < 4; ++n) { const float dl = acc[m][n][j] - mu[m][j]; sq += dl * dl; }
            sq = row16_sum(sq);
            if (li_ == 0) vec[V_RSB + t * 4 + wn] = sq; }
    __syncthreads();
#pragma unroll
    for (int m = 0; m < 4; ++m)
#pragma unroll
        for (int j = 0; j < 4; ++j) { const int t = 64 * wm + 16 * m + 4 * lg + j;
            const float rstd = rsqrtf((vec[V_RSB + t * 4] + vec[V_RSB + t * 4 + 1] + vec[V_RSB + t * 4 + 2] + vec[V_RSB + t * 4 + 3]) * (1.0f / 256.0f) + LN_EPS);
#pragma unroll
            for (int n = 0; n < 4; ++n) *(LAS float*)(lds + (t * 260 + 64 * wn + 16 * n + li_) * 4) = (acc[m][n][j] - mu[m][j]) * rstd; }
    __syncthreads();
    bf16_t* Y = (bf16_t*)(p.ws + WS_YCAT);
#pragma unroll
    for (int i = 0; i < 8; ++i) { const int piece = tid + 512 * i, row = piece >> 5, dg = piece & 31; const int col = h * HD + dg * 8;
        float o[8]; unpack8(oraw[i], o);
        const f32x4 h0 = *(const LAS f32x4*)(lds + (row * 260 + dg * 8) * 4), h1 = *(const LAS f32x4*)(lds + (row * 260 + dg * 8 + 4) * 4);
        const f32x4 w0 = *(const f32x4*)(p.mlstm_norm_w + col), w1 = *(const f32x4*)(p.mlstm_norm_w + col + 4);
        float y[8];
#pragma unroll
        for (int j = 0; j < 4; ++j) { y[j] = h0[j] * w0[j] * sigmoid_f(o[j]); y[4 + j] = h1[j] * w1[j] * sigmoid_f(o[4 + j]); }
        *(u32x4*)(Y + (tok0 + row) * DM + col) = pack8(y); }
}

constexpr int CM_W = 0, CM_V = 34816;
__device__ __forceinline__ void cmlp_unit(const Params& p, LAS unsigned char* lds, int unit) {
    const int tid = threadIdx.x, lane = tid & 63, wid = __builtin_amdgcn_readfirstlane(tid >> 6), wm = wid >> 2, wn = wid & 3, lg = lane >> 4, li_ = lane & 15;
    const int g = unit & 3, bc = unit >> 2;
    const size_t tok0 = (size_t)bc * CHK;
    const bf16_t* P = (const bf16_t*)(p.ws + WS_P);
    __syncthreads();
#pragma unroll
    for (int i = 0; i < 8; ++i) { const int idx = tid + 512 * i, row = idx >> 5, c4 = idx & 31;
        const float4 w = *(const float4*)(p.w_s + ((size_t)g * CHK + row) * CHK + c4 * 4);
        u32x2 o; o.x = cvt_pk_bf16(w.x, w.y); o.y = cvt_pk_bf16(w.z, w.w);
        *(LAS u32x2*)(lds + CM_W + row * 272 + c4 * 8) = o; }
#pragma unroll 2
    for (int i = 0; i < 8; ++i) { const int piece = tid + 512 * i, row = piece >> 5, dg = piece & 31;
        float f[8]; unpack8(*(const u32x4*)(P + (tok0 + row) * PW + 5120 + g * 256 + dg * 8), f);
        float sm = 0.f;
#pragma unroll
        for (int j = 0; j < 8; ++j) sm += f[j];
        sm = row16_sum(sm); sm += __shfl_xor(sm, 16, 64);
        const float mu = sm * (1.0f / 256.0f); float sq = 0.f;
#pragma unroll
        for (int j = 0; j < 8; ++j) { f[j] -= mu; sq += f[j] * f[j]; }
        sq = row16_sum(sq); sq += __shfl_xor(sq, 16, 64);
        const float rstd = rsqrtf(sq * (1.0f / 256.0f) + LN_EPS);
#pragma unroll
        for (int j = 0; j < 8; ++j) f[j] = f[j] * rstd * p.cmlp_norm_w[g * 256 + dg * 8 + j];
        *(LAS u32x4*)(lds + CM_V + row * 528 + dg * 16) = pack8(f); }
    __syncthreads();
    f32x4 acc[4][4];
#pragma unroll
    for (int m = 0; m < 4; ++m)
#pragma unroll
        for (int n = 0; n < 4; ++n) acc[m][n] = (f32x4){0.f, 0.f, 0.f, 0.f};
#pragma unroll
    for (int ks = 0; ks < 4; ++ks) {
        bf16x8 af[4], bfr[4];
#pragma unroll
        for (int m = 0; m < 4; ++m) af[m] = row_frag(lds + CM_W, 272, 64 * wm + 16 * m, ks * 32, lane);
#pragma unroll
        for (int n = 0; n < 4; ++n) bfr[n] = tr_frag(lds + CM_V, 528, ks * 32, 64 * wn + 16 * n, lane);
#pragma unroll
        for (int m = 0; m < 4; ++m)
#pragma unroll
            for (int n = 0; n < 4; ++n) acc[m][n] = __builtin_amdgcn_mfma_f32_16x16x32_bf16(af[m], bfr[n], acc[m][n], 0, 0, 0);
    }
    __syncthreads();
#pragma unroll
    for (int m = 0; m < 4; ++m)
#pragma unroll
        for (int j = 0; j < 4; ++j) { const int pp = 64 * wm + 16 * m + 4 * lg + j; const float bs = p.b_s[g * CHK + pp];
#pragma unroll
            for (int n = 0; n < 4; ++n) *(LAS float*)(lds + (pp * 260 + 64 * wn + 16 * n + li_) * 4) = acc[m][n][j] + bs; }
    __syncthreads();
    bf16_t* Y = (bf16_t*)(p.ws + WS_YCAT);
#pragma unroll 2
    for (int i = 0; i < 8; ++i) { const int piece = tid + 512 * i, row = piece >> 5, dg = piece & 31;
        float u[8]; unpack8(*(const u32x4*)(P + (tok0 + row) * PW + 4096 + g * 256 + dg * 8), u);
        const f32x4 s0 = *(const LAS f32x4*)(lds + (row * 260 + dg * 8) * 4), s1 = *(const LAS f32x4*)(lds + (row * 260 + dg * 8 + 4) * 4);
        float y[8];
#pragma unroll
        for (int j = 0; j < 4; ++j) { y[j] = u[j] * s0[j]; y[4 + j] = u[4 + j] * s1[j]; }
        *(u32x4*)(Y + (tok0 + row) * DM + 1024 + g * 256 + dg * 8) = pack8(y); }
}
__device__ __forceinline__ void phase_mix(const Params& p, LAS unsigned char* lds) {
#pragma unroll 1
    for (int u = blockIdx.x; u < 512; u += gridDim.x) mix_unit(p, lds, u);
#pragma unroll 1
    for (int u = blockIdx.x; u < 512; u += gridDim.x) cmlp_unit(p, lds, u);
    __syncthreads();
}

#define XB_TMO      128
#define XB_XCNT(j)  (256  + 64 * (j))
#define XB_XSUB(j)  (1280 + 64 * (j))
#define XB_XGEN(j)  (2304 + 64 * (j))
#define XB_TOP      3328
#define XB_TOPGEN   3392
#define XCD_BAR_WORDS 3456
#define XB_SPIN_CAP (1u << 18)

__device__ __forceinline__ unsigned xb_ld(unsigned* p)              { return __hip_atomic_load(p, __ATOMIC_RELAXED, __HIP_MEMORY_SCOPE_AGENT); }
__device__ __forceinline__ unsigned xb_add(unsigned* p, unsigned v) { return __hip_atomic_fetch_add(p, v, __ATOMIC_RELAXED, __HIP_MEMORY_SCOPE_AGENT); }
__device__ __forceinline__ unsigned xb_xcc_id() { return (unsigned)__builtin_amdgcn_s_getreg((3 << 11) | 20) & 0xFu; }
#define XB_SPIN(cond, bar) do { unsigned _sp = 0; while (cond) { __builtin_amdgcn_s_sleep(1); \
    if ((++_sp & 255u) == 0u) { if (xb_ld(&(bar)[XB_TMO])) break; if (_sp > XB_SPIN_CAP) { atomicAdd(&(bar)[XB_TMO], 1u); break; } } } } while (0)

struct XcdBarrier {
    unsigned* bar; unsigned x;
    volatile LAS unsigned* st;
};
__device__ __forceinline__ XcdBarrier xcd_barrier_post(unsigned* bar, volatile LAS unsigned* st) {
    XcdBarrier b; b.bar = bar; b.x = xb_xcc_id(); b.st = st;
    if (threadIdx.x == 0) (void)xb_add(&bar[XB_XCNT(b.x)], 1u);
    return b;
}
__device__ __forceinline__ void xcd_barrier_complete(unsigned* bar, unsigned x, unsigned& nloc, unsigned& nx) {
    const unsigned G = gridDim.x * gridDim.y * gridDim.z;
    unsigned sum, cnt, mine, sp = 0u;
    for (;;) {
        sum = 0u; cnt = 0u; mine = 0u;
#pragma unroll
        for (unsigned j = 0; j < 16; ++j) { const unsigned c = xb_ld(&bar[XB_XCNT(j)]); sum += c; cnt += (c > 0u) ? 1u : 0u; mine = (j == x) ? c : mine; }
        if (sum == G) break;
        __builtin_amdgcn_s_sleep(1);
        if ((++sp & 255u) == 0u) { if (xb_ld(&bar[XB_TMO])) break; if (sp > XB_SPIN_CAP) { atomicAdd(&bar[XB_TMO], 1u); break; } }
    }
    nloc = mine > 0u ? mine : 1u; nx = cnt > 0u ? cnt : 1u;
}
__device__ __forceinline__ void xcd_barrier(const XcdBarrier& b) {
    asm volatile("s_waitcnt vmcnt(0)" ::: "memory");
    __syncthreads();
    if (threadIdx.x == 0) {
        unsigned* bar = b.bar;
        __builtin_amdgcn_s_waitcnt(0);
        unsigned nloc = b.st[0], nx = b.st[1];
        if (nloc == 0u) { xcd_barrier_complete(bar, b.x, nloc, nx); b.st[0] = nloc; b.st[1] = nx; }
        const unsigned old = xb_add(&bar[XB_XSUB(b.x)], 1u);
        const unsigned gen = old / nloc;
        if (old + 1u == (gen + 1u) * nloc) {
            __builtin_amdgcn_fence(__ATOMIC_RELEASE, "agent");
            asm volatile("s_waitcnt vmcnt(0)" ::: "memory");
            const unsigned og = xb_add(&bar[XB_TOP], 1u);
            const unsigned tg = og / nx;
            if (og + 1u == (tg + 1u) * nx) xb_add(&bar[XB_TOPGEN], 1u);
            else XB_SPIN(xb_ld(&bar[XB_TOPGEN]) == tg, bar);
            __builtin_amdgcn_fence(__ATOMIC_ACQUIRE, "agent");
            xb_add(&bar[XB_XGEN(b.x)], 1u);
            asm volatile("s_waitcnt vmcnt(0)" ::: "memory");
        } else {
            XB_SPIN(xb_ld(&bar[XB_XGEN(b.x)]) == gen, bar);
            __builtin_amdgcn_fence(__ATOMIC_ACQUIRE, "agent");
            asm volatile("s_waitcnt vmcnt(0)" ::: "memory");
        }
    }
    __syncthreads();
}

enum { PH_PREP = 0, PH_HX = 1, PH_INPROJ = 2, PH_SCAN = 3, PH_MIX = 4, PH_OUTPROJ = 5, PH_LN1 = 6, PH_MOE1 = 7, PH_MOE2 = 8, PH_FINAL = 9, PH_END = 10 };
#ifndef DUP_PHASE
#define DUP_PHASE (-1)
#endif
constexpr int CW_BAR = 256;
__global__ void __launch_bounds__(512, 2) fwd(Params p, int lo, int hi) {
    extern __shared__ __attribute__((aligned(16))) unsigned char shm[];
    LAS unsigned char* lds = (LAS unsigned char*)shm;
    if (threadIdx.x < 4) ((LAS unsigned*)(lds + LDS_MISC))[threadIdx.x] = 0u;
    __syncthreads();
    XcdBarrier bar; bar.bar = (unsigned*)(p.ws + WS_CTL) + CW_BAR; bar.x = 0; bar.st = (volatile LAS unsigned*)(lds + LDS_MISC);
    if (hi - lo > 1) bar = xcd_barrier_post((unsigned*)(p.ws + WS_CTL) + CW_BAR, (volatile LAS unsigned*)(lds + LDS_MISC));
#define IN(k) (lo <= (k) && (k) < hi)
#define SEAM(k) do { if (IN(k) && IN((k) + 1)) xcd_barrier(bar); } while (0)
#define PHASE(k, ...) do { if (IN(k)) { __VA_ARGS__; if (DUP_PHASE == (k)) { xcd_barrier(bar); __VA_ARGS__; } } SEAM(k); } while (0)
    PHASE(PH_PREP, { phase_mod(p, lds); phase_postab(p); phase_convert(p, lds, 0, gridDim.x == 256 ? CONV_ITEMS_ALL - CONV_TAIL : CONV_ITEMS_ALL, blockIdx.x, gridDim.x); });
    PHASE(PH_HX, phase_hx(p, lds));
    PHASE(PH_INPROJ, { { SchedIn S{&p}; EpiIn E{&p}; pg8::gemm_phase<true, false>(lds, DM * 2, S, E); }
        { SchedIn8 S{&p}; EpiIn E{&p}; pg8::gemm_phase<true, true>(lds, DM, S, E); }
        if (gridDim.x == 256 && blockIdx.x >= 64 && blockIdx.x < 192) {
            const int f = CONV_ITEMS_ALL - CONV_TAIL + ((int)blockIdx.x - 64) * CT_B1; phase_convert(p, lds, f, f + CT_B1, 0, 1); } });
    PHASE(PH_SCAN, phase_scan(p, lds));
    PHASE(PH_MIX, phase_mix(p, lds));
    PHASE(PH_OUTPROJ, { SchedOut S{&p}; EpiOut E{&p}; pg8::gemm_phase<false, false>(lds, DM * 2, S, E); });
    PHASE(PH_LN1, phase_ln1(p, lds));
    PHASE(PH_MOE1, { LAS int* tab = (LAS int*)(lds + LDS_TAB); moe_build_table(p, tab); SchedMoe1 S{&p, tab}; EpiMoe1 E{&p}; pg8::gemm_phase<true, true>(lds, DM, S, E); });
    PHASE(PH_MOE2, { LAS int* tab = (LAS int*)(lds + LDS_TAB); moe_build_table(p, tab); SchedMoe2 S{&p, tab}; EpiMoe2 E{&p, lds}; pg8::gemm_phase<true, true>(lds, DE, S, E); });
    PHASE(PH_FINAL, phase_final(p, lds));
#undef PHASE
#undef IN
#undef SEAM
}

#ifndef MK_N_LAUNCHES
#define MK_N_LAUNCHES 1
#endif
extern "C" void kernel_launch(void* const* d_in, const int* in_sizes, int n_in, void* d_out, int out_size, void* d_ws, size_t ws_size, hipStream_t stream) {
    static int grid = 0;
    if (grid == 0) {
        if (n_in != 26 || out_size != NTOK * DM || ws_size < WS_END) { fprintf(stderr, "kernel_launch: unexpected shapes: n_in %d out %d ws %zu (need %zu)\n", n_in, out_size, ws_size, (size_t)WS_END); grid = -1; return; }
        int dev = 0, cus = 0, per_cu = 0;
        if (hipGetDevice(&dev) != hipSuccess || hipDeviceGetAttribute(&cus, hipDeviceAttributeMultiprocessorCount, dev) != hipSuccess) { grid = -1; return; }
        if (hipFuncSetAttribute((const void*)fwd, hipFuncAttributeMaxDynamicSharedMemorySize, LDS_TOTAL) != hipSuccess) { fprintf(stderr, "kernel_launch: hipFuncSetAttribute failed\n"); grid = -1; return; }
        if (hipOccupancyMaxActiveBlocksPerMultiprocessor(&per_cu, (const void*)fwd, 512, LDS_TOTAL) != hipSuccess || per_cu < 1) { fprintf(stderr, "kernel_launch: occupancy query says %d\n", per_cu); }
        (void)hipGetLastError();
        grid = cus;
    }
    if (grid < 0) return;
    Params p{};
    const float* const* in = (const float* const*)d_in;
    p.x = in[0]; p.c = in[1]; p.ctx = in[2]; p.c_ctx = in[3]; p.w_mod = in[4]; p.b_mod = in[5]; p.w_in = in[6]; p.conv_w = in[7]; p.conv_b = in[8]; p.gate_bias = in[9];
    p.mlstm_norm_w = in[10]; p.cmlp_norm_w = in[11]; p.w_s = in[12]; p.b_s = in[13]; p.w_out = in[14]; p.ln1_w = in[15]; p.ln1_b = in[16];
    p.r1_w = in[17]; p.r1_b = in[18]; p.r2_w = in[19]; p.r2_b = in[20]; p.w_gate = in[21]; p.w_up = in[22]; p.w_down = in[23]; p.ln2_w = in[24]; p.ln2_b = in[25];
    p.out = (float*)d_out; p.ws = (unsigned char*)d_ws;
    (void)hipMemsetAsync(p.ws, 0, WS_ZERO_END, stream);
#if MK_N_LAUNCHES == 1
    fwd<<<grid, 512, LDS_TOTAL, stream>>>(p, 0, PH_END);
#else
    for (int ph = 0; ph < PH_END; ++ph) fwd<<<grid, 512, LDS_TOTAL, stream>>>(p, ph, ph + 1);
#endif
}
```

```cpp
#include <hip/hip_runtime.h>
#include <cstdio>
#include <cstdint>

typedef unsigned short bf16_t;

constexpr int DM = 2048, NB = 8, SEQ = 2048, CTXL = 256;
constexpr int NTOK = NB * SEQ;
constexpr int NCTX = NB * CTXL;
constexpr int NROWS = NTOK + NCTX;
constexpr int DIN = 6160, DML = 1024, NH = 4, HD = 256, CHK = 128;
constexpr int NGATE = 16;
constexpr int PW = 6144;
constexpr int NE = 32, DE = 1024;
constexpr int NMOD = 6;
constexpr float ALPHA = 1.189207115002721f;
constexpr float LN_EPS = 1e-6f;
constexpr int HCAP = 40960;

constexpr size_t al256(size_t x) { return (x + 255) & ~(size_t)255; }
constexpr size_t WS_CTL   = 0;
constexpr size_t CTL_BYTES = 65536;
constexpr size_t WS_MOD   = WS_CTL + CTL_BYTES;
constexpr size_t MOD_BYTES = al256((size_t)9 * NMOD * DM * 4);
constexpr size_t WS_STATS = WS_MOD + MOD_BYTES;
constexpr size_t WS_ZERO_END = WS_STATS + al256((size_t)NTOK * 2 * 4);
constexpr size_t WS_POS   = WS_ZERO_END;
constexpr size_t WS_HX    = WS_POS + al256((size_t)96 * 1024 * 4);
constexpr size_t WS_GATES = WS_HX + al256((size_t)NROWS * DM * 2);
constexpr size_t WS_P     = WS_GATES + al256((size_t)NROWS * NGATE * 4);
constexpr size_t WS_PC    = WS_P + al256((size_t)NTOK * PW * 2);
constexpr size_t WS_YCAT  = WS_PC + al256((size_t)NCTX * 2048 * 2);
constexpr size_t WS_T     = WS_YCAT;
constexpr size_t WS_X1    = WS_YCAT + al256((size_t)NTOK * DM * 2);
constexpr size_t WS_LIST  = WS_X1 + al256((size_t)NTOK * DM * 4);
constexpr size_t WS_RT    = WS_LIST + al256((size_t)NE * NTOK * 4);
constexpr size_t WS_H     = WS_P;
constexpr size_t WS_Y2    = WS_RT + al256((size_t)NTOK * 2 * 4);
constexpr size_t WS_HDIR  = WS_Y2;
constexpr size_t WS_BTIN  = WS_Y2 + al256((size_t)NTOK * 2 * DM * 2);
constexpr size_t WS_BTOUT = WS_BTIN + al256((size_t)PW * DM * 2);
constexpr size_t WS_BTGU  = WS_BTOUT + al256((size_t)DM * DM * 2);
constexpr size_t WS_BTDN  = WS_BTGU + al256((size_t)NE * 2 * DE * DM * 2);
constexpr size_t WS_NST   = WS_BTDN + al256((size_t)NE * DM * DE * 2);
constexpr size_t WS_MST   = WS_NST + al256((size_t)64 * 16 * 256 * 4);
constexpr size_t WS_CST   = WS_Y2;
constexpr size_t WS_RWT   = WS_MST + al256((size_t)64 * 16 * 4);
constexpr size_t WS_RWH   = WS_RWT + al256((size_t)36 * DM * 4);
constexpr size_t WS_HX8   = WS_RWH + al256((size_t)2 * 48 * DM * 2);
constexpr size_t WS_WGT   = WS_HX8 + al256((size_t)NTOK * DM);
constexpr size_t WS_END   = WS_WGT + al256((size_t)NGATE * DM * 4);

constexpr int CW_CNT = 0;

struct Params {
    const float *x, *c, *ctx, *c_ctx, *w_mod, *b_mod, *w_in, *conv_w, *conv_b, *gate_bias, *mlstm_norm_w, *cmlp_norm_w, *w_s, *b_s, *w_out,
                *ln1_w, *ln1_b, *r1_w, *r1_b, *r2_w, *r2_b, *w_gate, *w_up, *w_down, *ln2_w, *ln2_b;
    float* out;
    unsigned char* ws;
};

__device__ __forceinline__ bf16_t f2bf(float f) { return __builtin_bit_cast(bf16_t, (__bf16)f); }
__device__ __forceinline__ float bf2f(bf16_t b) { return __uint_as_float(((unsigned)b) << 16); }
__device__ __forceinline__ float silu_f(float x) { return x * __builtin_amdgcn_rcpf(1.0f + __expf(-x)); }
__device__ __forceinline__ float sigmoid_f(float x) { return __builtin_amdgcn_rcpf(1.0f + __expf(-x)); }
__device__ __forceinline__ float logsigmoid_f(float x) { return fminf(x, 0.0f) - log1pf(__expf(-fabsf(x))); }
__device__ __forceinline__ float gelu_tanh_f(float x) {
    const float z = 0.7978845608028654f * (x + 0.044715f * x * x * x);
    const float e = __expf(2.0f * z);
    const float th = 1.0f - 2.0f * __builtin_amdgcn_rcpf(e + 1.0f);
    return 0.5f * x * (1.0f + th);
}
__device__ __forceinline__ float wave_sum(float v) {
#pragma unroll
    for (int o = 32; o > 0; o >>= 1) v += __shfl_xor(v, o, 64);
    return v;
}
__device__ __forceinline__ float pos_val(const float* pos, int tok_in_seq, int col) {
    const int r = tok_in_seq >> 6, cc = tok_in_seq & 63;
    return col < 1024 ? pos[r * 1024 + col] : pos[32 * 1024 + cc * 1024 + (col - 1024)];
}

#define LAS __attribute__((address_space(3)))
typedef short bf16x8 __attribute__((ext_vector_type(8)));
typedef float f32x4 __attribute__((ext_vector_type(4)));
typedef unsigned u32x4 __attribute__((ext_vector_type(4)));
constexpr int LDS_STAGE = 131072;
constexpr int LDS_TOTAL = 163840;
constexpr int LDS_ROWS  = 131072;
constexpr int LDS_TAB   = 150528;
constexpr int LDS_MISC  = 163840 - 256;

typedef int i32x4 __attribute__((ext_vector_type(4)));
typedef int i32x8 __attribute__((ext_vector_type(8)));
__device__ __forceinline__ i32x8 cat8(const bf16x8 lo, const bf16x8 hi) { return __builtin_shufflevector(__builtin_bit_cast(i32x4, lo), __builtin_bit_cast(i32x4, hi), 0, 1, 2, 3, 4, 5, 6, 7); }
constexpr int F8_SCALE_W = 0x79797979;
constexpr int F8_SCALE_A = 0x7f7f7f7f;
constexpr float F8_WMUL = 64.0f;
__device__ __forceinline__ unsigned pack4_fp8(float a, float b, float c, float d) { int w = 0; w = __builtin_amdgcn_cvt_pk_fp8_f32(a, b, w, false); w = __builtin_amdgcn_cvt_pk_fp8_f32(c, d, w, true); return (unsigned)w; }
typedef float f32x2_t __attribute__((ext_vector_type(2)));
__device__ __forceinline__ void unpack8_fp8(const unsigned lo, const unsigned hi, float (&f)[8]) {
    const f32x2_t a = __builtin_amdgcn_cvt_pk_f32_fp8((int)lo, false), b = __builtin_amdgcn_cvt_pk_f32_fp8((int)lo, true), c = __builtin_amdgcn_cvt_pk_f32_fp8((int)hi, false), d = __builtin_amdgcn_cvt_pk_f32_fp8((int)hi, true);
    f[0] = a[0]; f[1] = a[1]; f[2] = b[0]; f[3] = b[1]; f[4] = c[0]; f[5] = c[1]; f[6] = d[0]; f[7] = d[1];
}
typedef _Float16 h16x2 __attribute__((ext_vector_type(2)));
__device__ __forceinline__ unsigned pack2_h16(float a, float b) { h16x2 h; h.x = (_Float16)a; h.y = (_Float16)b; return __builtin_bit_cast(unsigned, h); }
__device__ __forceinline__ void unpack2_h16(unsigned w, float& a, float& b) { const h16x2 h = __builtin_bit_cast(h16x2, w); a = (float)h.x; b = (float)h.y; }
typedef unsigned u32x2 __attribute__((ext_vector_type(2)));
typedef __bf16 bf16x2_t __attribute__((ext_vector_type(2)));
typedef float f32x2v_t __attribute__((ext_vector_type(2)));
__device__ __forceinline__ unsigned cvt_pk_bf16(float lo, float hi) { const f32x2v_t v = {lo, hi}; return __builtin_bit_cast(unsigned, __builtin_convertvector(v, bf16x2_t)); }
__device__ __forceinline__ void unpack8(const u32x4 v, float (&f)[8]) {
    f[0] = __uint_as_float(v.x << 16); f[1] = __uint_as_float(v.x & 0xffff0000u); f[2] = __uint_as_float(v.y << 16); f[3] = __uint_as_float(v.y & 0xffff0000u);
    f[4] = __uint_as_float(v.z << 16); f[5] = __uint_as_float(v.z & 0xffff0000u); f[6] = __uint_as_float(v.w << 16); f[7] = __uint_as_float(v.w & 0xffff0000u);
}
__device__ __forceinline__ u32x4 pack8(const float (&f)[8]) { u32x4 w; w.x = cvt_pk_bf16(f[0], f[1]); w.y = cvt_pk_bf16(f[2], f[3]); w.z = cvt_pk_bf16(f[4], f[5]); w.w = cvt_pk_bf16(f[6], f[7]); return w; }


__device__ __forceinline__ void phase_mod(const Params& p, LAS unsigned char* lds) {
    LAS float* sc = (LAS float*)lds;
    LAS float* red = sc + 9 * 128;
    float* MOD = (float*)(p.ws + WS_MOD);
    const int tid = threadIdx.x;
    for (int item = blockIdx.x; item < 768; item += gridDim.x) {
        const int cb = item % 48, kb = item / 48;
        __syncthreads();
        for (int i = tid; i < 9 * 128; i += 512) {
            const int r = i / 128, k = i % 128;
            const float v = r < 8 ? p.c[r * DM + kb * 128 + k] : p.c_ctx[kb * 128 + k];
            sc[r * 128 + k] = silu_f(v);
        }
        __syncthreads();
        const int col = cb * 256 + (tid & 255), kh = tid >> 8;
        float acc[9];
#pragma unroll
        for (int r = 0; r < 9; ++r) acc[r] = 0.f;
        const float* wp = p.w_mod + (size_t)(kb * 128 + kh * 64) * (NMOD * DM) + col;
#pragma unroll 8
        for (int k = 0; k < 64; ++k) {
            const float w = wp[(size_t)k * (NMOD * DM)];
#pragma unroll
            for (int r = 0; r < 9; ++r) acc[r] += sc[r * 128 + kh * 64 + k] * w;
        }
        if (kh == 1) {
#pragma unroll
            for (int r = 0; r < 9; ++r) red[(tid & 255) * 9 + r] = acc[r];
        }
        __syncthreads();
        if (kh == 0) {
            const float bias = kb == 0 ? p.b_mod[col] : 0.f;
#pragma unroll
            for (int r = 0; r < 9; ++r) atomicAdd(&MOD[r * (NMOD * DM) + col], acc[r] + red[tid * 9 + r] + bias);
        }
    }
    __syncthreads();
}
__device__ __forceinline__ void phase_postab(const Params& p) {
    float* pos = (float*)(p.ws + WS_POS);
    for (int i = blockIdx.x * 512 + threadIdx.x; i < 96 * 1024; i += gridDim.x * 512) {
        const int row = i / 1024, j = i % 1024, jj = j & 511;
        const float omega = 1.0f / powf(10000.0f, (float)jj / 512.0f);
        const float pv = row < 32 ? (float)row : (float)(row - 32);
        const float a = pv * omega;
        pos[i] = j < 512 ? sinf(a) : cosf(a);
    }
    float* rwt = (float*)(p.ws + WS_RWT);
    for (int i = blockIdx.x * 512 + threadIdx.x; i < 36 * DM; i += gridDim.x * 512) {
        const int k = i / 36, j = i % 36;
        rwt[j * DM + k] = j < 4 ? p.r1_w[k * 4 + j] : p.r2_w[k * 32 + (j - 4)];
    }
    bf16_t* rwh = (bf16_t*)(p.ws + WS_RWH);
    for (int i = blockIdx.x * 512 + threadIdx.x; i < 48 * DM; i += gridDim.x * 512) {
        const int j = i / DM, k = i % DM;
        const float w = j < 4 ? p.r1_w[k * 4 + j] : j < 36 ? p.r2_w[k * 32 + (j - 4)] : 0.f;
        const bf16_t hi = f2bf(w); const bf16_t lo = f2bf(w - bf2f(hi));
        rwh[i] = hi; rwh[48 * DM + i] = lo;
    }
    float* wgt = (float*)(p.ws + WS_WGT);
    for (int i = blockIdx.x * 512 + threadIdx.x; i < NGATE * DM; i += gridDim.x * 512) { const int k = i >> 4, g = i & 15; wgt[g * DM + k] = p.w_in[(size_t)k * DIN + 4096 + g]; }
}

#define GLDS16(gptr, lptr) __builtin_amdgcn_global_load_lds((const unsigned*)(gptr), (LAS unsigned*)(lptr), 16, 0, 0)
__device__ __forceinline__ void glds16_asm(const void* g, unsigned ldsaddr) {
    asm volatile("s_mov_b32 m0, %1\n\ts_nop 0\n\tglobal_load_lds_dwordx4 %0, off" :: "v"(g), "s"(ldsaddr) : "memory", "m0");
}
#define LDSADDR(lptr) ((unsigned)__builtin_amdgcn_readfirstlane((int)(unsigned)(__SIZE_TYPE__)(lptr)))
constexpr int HXB = 68 * 256;
__device__ __forceinline__ void hx_stage(const Params& p, LAS float* ldsf, int buf, int chunk, int rowb, int wid, int lane) {
    const float* MOD = (const float*)(p.ws + WS_MOD); const float* pos = (const float*)(p.ws + WS_POS); const float* wgt = (const float*)(p.ws + WS_WGT);
    LAS float* xb = ldsf + buf * HXB; LAS float* pb = xb + 24 * 256; LAS float* mb = xb + 48 * 256; LAS float* wb = xb + 52 * 256;
    const int co = chunk * 256 + lane * 4;
#pragma unroll
    for (int r = 0; r < 3; ++r) { const int row = rowb + wid * 3 + r; const bool isx = row < NTOK; const int ts = row % SEQ;
        glds16_asm((isx ? p.x + (size_t)row * DM : p.ctx + (size_t)(row - NTOK) * DM) + co, LDSADDR(xb + (wid * 3 + r) * 256));
        if (isx) glds16_asm((chunk < 4 ? pos + (ts >> 6) * 1024 : pos + 32 * 1024 + (ts & 63) * 1024 - 1024) + co, LDSADDR(pb + (wid * 3 + r) * 256)); }
    if (wid < 4) { const int row = (wid & 2) ? rowb + 23 : rowb; const int b = row < NTOK ? row / SEQ : 8;
        glds16_asm(MOD + (size_t)b * (NMOD * DM) + ((wid & 1) ? 0 : DM) + co, LDSADDR(mb + wid * 256)); }
    for (int j = wid; j < 16; j += 8) glds16_asm(wgt + (size_t)j * DM + co, LDSADDR(wb + j * 256));
}
__device__ __forceinline__ void phase_hx(const Params& p, LAS unsigned char* lds) {
    bf16_t* HX = (bf16_t*)(p.ws + WS_HX); unsigned char* HX8 = (unsigned char*)(p.ws + WS_HX8);
    float* G = (float*)(p.ws + WS_GATES);
    LAS float* ldsf = (LAS float*)lds;
    const int tid = threadIdx.x, lane = tid & 63, wid = __builtin_amdgcn_readfirstlane(tid >> 6);
    for (int bt = blockIdx.x; bt < NROWS / 24; bt += gridDim.x) {
        const int rowb = bt * 24, row0 = rowb + wid * 3;
        const int bfirst = rowb < NTOK ? rowb / SEQ : 8;
        bool isx[3]; int pset[3];
#pragma unroll
        for (int r = 0; r < 3; ++r) { const int row = row0 + r; isx[r] = row < NTOK; pset[r] = ((row < NTOK ? row / SEQ : 8) != bfirst) ? 2 : 0; }
        const int nst = __builtin_amdgcn_readfirstlane(3 + (isx[0] ? 1 : 0) + (isx[1] ? 1 : 0) + (isx[2] ? 1 : 0));
        float acc[3][NGATE];
#pragma unroll
        for (int r = 0; r < 3; ++r)
#pragma unroll
            for (int g = 0; g < NGATE; ++g) acc[r][g] = 0.f;
        asm volatile("s_waitcnt vmcnt(0) lgkmcnt(0)" ::: "memory"); __builtin_amdgcn_s_barrier();
        hx_stage(p, ldsf, 0, 0, rowb, wid, lane);
#pragma unroll 1
        for (int chunk = 0; chunk < 8; ++chunk) {
            if (chunk > 0 && nst == 6) asm volatile("s_waitcnt vmcnt(6) lgkmcnt(0)" ::: "memory"); else if (chunk > 0 && nst == 3) asm volatile("s_waitcnt vmcnt(3) lgkmcnt(0)" ::: "memory"); else asm volatile("s_waitcnt vmcnt(0) lgkmcnt(0)" ::: "memory");
            __builtin_amdgcn_s_barrier();
            if (chunk < 7) hx_stage(p, ldsf, (chunk + 1) & 1, chunk + 1, rowb, wid, lane);
            const LAS float* xb = ldsf + (chunk & 1) * HXB + lane * 4; const LAS float* pb = xb + 24 * 256; const LAS float* mb = xb + 48 * 256; const LAS float* wb = xb + 52 * 256;
            const int col = chunk * 256 + lane * 4;
            f32x4 hv[3];
#pragma unroll
            for (int r = 0; r < 3; ++r) { f32x4 v = *(const LAS f32x4*)(xb + (wid * 3 + r) * 256);
                if (isx[r]) v += *(const LAS f32x4*)(pb + (wid * 3 + r) * 256);
                hv[r] = v * (*(const LAS f32x4*)(mb + pset[r] * 256) + 1.0f) + *(const LAS f32x4*)(mb + (pset[r] + 1) * 256);
                u32x2 o; o.x = cvt_pk_bf16(hv[r][0], hv[r][1]); o.y = cvt_pk_bf16(hv[r][2], hv[r][3]);
                *(u32x2*)(HX + (size_t)(row0 + r) * DM + col) = o;
                if (isx[r]) *(unsigned*)(HX8 + (size_t)(row0 + r) * DM + col) = pack4_fp8(hv[r][0], hv[r][1], hv[r][2], hv[r][3]); }
#pragma unroll
            for (int g = 0; g < NGATE; ++g) { const f32x4 w = *(const LAS f32x4*)(wb + g * 256);
#pragma unroll
                for (int r = 0; r < 3; ++r) acc[r][g] += hv[r][0] * w[0] + hv[r][1] * w[1] + hv[r][2] * w[2] + hv[r][3] * w[3]; }
        }
        {
            float v24[24], v12[12], v6[6];
            const bool h5 = lane & 32, h4 = lane & 16, h3 = lane & 8, h2 = lane & 4;
#pragma unroll
            for (int f = 0; f < 24; ++f) { const float lo = acc[f / 16][f % 16], hi = acc[(f + 24) / 16][(f + 24) % 16]; v24[f] = (h5 ? hi : lo) + __shfl_xor(h5 ? lo : hi, 32, 64); }
#pragma unroll
            for (int f = 0; f < 12; ++f) v12[f] = (h4 ? v24[f + 12] : v24[f]) + __shfl_xor(h4 ? v24[f] : v24[f + 12], 16, 64);
#pragma unroll
            for (int f = 0; f < 6; ++f) v6[f] = (h3 ? v12[f + 6] : v12[f]) + __shfl_xor(h3 ? v12[f] : v12[f + 6], 8, 64);
            const int f0 = (h5 ? 24 : 0) + (h4 ? 12 : 0) + (h3 ? 6 : 0) + (h2 ? 3 : 0);
#pragma unroll
            for (int f = 0; f < 3; ++f) { float x = (h2 ? v6[f + 3] : v6[f]) + __shfl_xor(h2 ? v6[f] : v6[f + 3], 4, 64); x += __shfl_xor(x, 2, 64); x += __shfl_xor(x, 1, 64);
                if ((lane & 3) == 0) { const int ff = f0 + f, r = ff >> 4, g = ff & 15; float v = x + p.gate_bias[g]; if ((g >> 2) & 1) v = logsigmoid_f(v); G[(size_t)(row0 + r) * NGATE + g] = v; } }
        }
    }
    asm volatile("s_waitcnt vmcnt(0) lgkmcnt(0)" ::: "memory"); __builtin_amdgcn_s_barrier();
}

constexpr int L1_X = 0, L1_P = 16384, L1_W = 16384 + 4096, L1_BUF = L1_W + 2 * 24576, L1_RED = 2 * L1_BUF;
constexpr int L1_LG = L1_RED;
__device__ __forceinline__ void ln1_stage(const Params& p, LAS unsigned char* lds, int buf, int chunk, int tokb, int b, int wid, int lane) {
    const bf16_t* X1 = (const bf16_t*)(p.ws + WS_X1); const bf16_t* RW = (const bf16_t*)(p.ws + WS_RWH); const float* MOD = (const float*)(p.ws + WS_MOD);
    LAS unsigned char* base = lds + buf * L1_BUF;
#pragma unroll
    for (int r2 = 0; r2 < 2; ++r2) { const int row = wid * 4 + 2 * r2 + (lane >> 5); const int gc = (lane & 31) ^ (row & 31);
        GLDS16(X1 + (size_t)(tokb + row) * DM + chunk * 256 + gc * 8, base + L1_X + (wid * 4 + 2 * r2) * 512); }
#pragma unroll
    for (int q = 0; q < 6; ++q) { const int rr = (wid * 6 + q) * 2 + (lane >> 5); const int n = rr % 48; const int gc = (lane & 31) ^ (n & 31);
        GLDS16(RW + (size_t)rr * DM + chunk * 256 + gc * 8, base + L1_W + (wid * 6 + q) * 1024); }
    const int cf = chunk * 256 + lane * 4;
    if (wid == 4) GLDS16(p.ln1_w + cf, base + L1_P);
    if (wid == 5) GLDS16(p.ln1_b + cf, base + L1_P + 1024);
    if (wid == 6) GLDS16(MOD + (size_t)b * (NMOD * DM) + 4 * DM + cf, base + L1_P + 2048);
    if (wid == 7) GLDS16(MOD + (size_t)b * (NMOD * DM) + 3 * DM + cf, base + L1_P + 3072);
}
__device__ __forceinline__ void phase_ln1(const Params& p, LAS unsigned char* lds) {
    const float* ST = (const float*)(p.ws + WS_STATS);
    unsigned char* T = (unsigned char*)(p.ws + WS_T);
    unsigned* cnt = (unsigned*)(p.ws + WS_CTL) + CW_CNT;
    int* list = (int*)(p.ws + WS_LIST);
    float* RT = (float*)(p.ws + WS_RT);
    LAS float* ldsf = (LAS float*)lds;
    const int tid = threadIdx.x, lane = tid & 63, wid = __builtin_amdgcn_readfirstlane(tid >> 6), li_ = lane & 15, lg = lane >> 4;
    for (int rb = blockIdx.x; rb < NTOK / 32; rb += gridDim.x) {
        const int tokb = rb * 32, b = tokb / SEQ, row0 = tokb + wid * 4;
        float mean[2], rstd[2];
#pragma unroll
        for (int m = 0; m < 2; ++m) { const float s1 = ST[(size_t)(tokb + 16 * m + li_) * 2], s2 = ST[(size_t)(tokb + 16 * m + li_) * 2 + 1];
            mean[m] = s1 * (1.0f / DM); rstd[m] = rsqrtf(fmaxf(s2 * (1.0f / DM) - mean[m] * mean[m], 0.f) + LN_EPS); }
        f32x4 acc[2][3];
#pragma unroll
        for (int m = 0; m < 2; ++m)
#pragma unroll
            for (int n = 0; n < 3; ++n) acc[m][n] = (f32x4){0.f, 0.f, 0.f, 0.f};
        asm volatile("s_waitcnt vmcnt(0) lgkmcnt(0)" ::: "memory"); __builtin_amdgcn_s_barrier();
        ln1_stage(p, lds, 0, 0, tokb, b, wid, lane);
#pragma unroll 1
        for (int chunk = 0; chunk < 8; ++chunk) {
            asm volatile("s_waitcnt vmcnt(0) lgkmcnt(0)" ::: "memory"); __builtin_amdgcn_s_barrier();
            if (chunk < 7) ln1_stage(p, lds, (chunk + 1) & 1, chunk + 1, tokb, b, wid, lane);
            const LAS unsigned char* base = lds + (chunk & 1) * L1_BUF;
            const int kc = 4 * wid + lg;
            const LAS float* pp = (const LAS float*)(base + L1_P) + kc * 8;
            const f32x4 lw0 = *(const LAS f32x4*)(pp), lw1 = *(const LAS f32x4*)(pp + 4), lb0 = *(const LAS f32x4*)(pp + 256), lb1 = *(const LAS f32x4*)(pp + 260);
            const f32x4 sc0 = *(const LAS f32x4*)(pp + 512) + 1.0f, sc1 = *(const LAS f32x4*)(pp + 516) + 1.0f, sh0 = *(const LAS f32x4*)(pp + 768), sh1 = *(const LAS f32x4*)(pp + 772);
            bf16x8 ahi[2], alo[2];
#pragma unroll
            for (int m = 0; m < 2; ++m) { const int row = 16 * m + li_;
                const u32x4 xw = *(const LAS u32x4*)(base + L1_X + row * 512 + ((kc ^ (row & 31)) << 4));
                float x[8]; unpack2_h16(xw.x, x[0], x[1]); unpack2_h16(xw.y, x[2], x[3]); unpack2_h16(xw.z, x[4], x[5]); unpack2_h16(xw.w, x[6], x[7]);
                float t[8];
#pragma unroll
                for (int j = 0; j < 4; ++j) { t[j] = ((x[j] - mean[m]) * rstd[m] * lw0[j] + lb0[j]) * sc0[j] + sh0[j]; t[4 + j] = ((x[4 + j] - mean[m]) * rstd[m] * lw1[j] + lb1[j]) * sc1[j] + sh1[j]; }
                u32x2 tw; tw.x = pack4_fp8(t[0], t[1], t[2], t[3]); tw.y = pack4_fp8(t[4], t[5], t[6], t[7]);
                *(u32x2*)(T + (size_t)(tokb + row) * DM + chunk * 256 + kc * 8) = tw;
                u32x4 hw, lw_; float r_[8];
                hw.x = cvt_pk_bf16(t[0], t[1]); hw.y = cvt_pk_bf16(t[2], t[3]); hw.z = cvt_pk_bf16(t[4], t[5]); hw.w = cvt_pk_bf16(t[6], t[7]);
                unpack8(hw, r_);
#pragma unroll
                for (int j = 0; j < 8; ++j) r_[j] = t[j] - r_[j];
                lw_.x = cvt_pk_bf16(r_[0], r_[1]); lw_.y = cvt_pk_bf16(r_[2], r_[3]); lw_.z = cvt_pk_bf16(r_[4], r_[5]); lw_.w = cvt_pk_bf16(r_[6], r_[7]);
                ahi[m] = __builtin_bit_cast(bf16x8, hw); alo[m] = __builtin_bit_cast(bf16x8, lw_); }
#pragma unroll
            for (int n = 0; n < 3; ++n) { const int rown = 16 * n + li_;
                const bf16x8 bhi = *(const LAS bf16x8*)(base + L1_W + rown * 512 + ((kc ^ (rown & 31)) << 4));
                const bf16x8 blo = *(const LAS bf16x8*)(base + L1_W + 24576 + rown * 512 + ((kc ^ (rown & 31)) << 4));
#pragma unroll
                for (int m = 0; m < 2; ++m) {
                    acc[m][n] = __builtin_amdgcn_mfma_f32_16x16x32_bf16(ahi[m], bhi, acc[m][n], 0, 0, 0);
                    acc[m][n] = __builtin_amdgcn_mfma_f32_16x16x32_bf16(ahi[m], blo, acc[m][n], 0, 0, 0);
                    acc[m][n] = __builtin_amdgcn_mfma_f32_16x16x32_bf16(alo[m], bhi, acc[m][n], 0, 0, 0); } }
        }
        asm volatile("s_waitcnt vmcnt(0) lgkmcnt(0)" ::: "memory"); __builtin_amdgcn_s_barrier();
        {   LAS float* red = (LAS float*)lds + wid * (32 * 48);
#pragma unroll
            for (int m = 0; m < 2; ++m)
#pragma unroll
                for (int n = 0; n < 3; ++n)
#pragma unroll
                    for (int j = 0; j < 4; ++j) red[(16 * m + 4 * lg + j) * 48 + 16 * n + li_] = acc[m][n][j]; }
        asm volatile("s_waitcnt lgkmcnt(0)" ::: "memory"); __builtin_amdgcn_s_barrier();
        LAS float* lgt = (LAS float*)(lds + L1_LG);
        for (int i = tid; i < 32 * 36; i += 512) { const int tkn = i / 36, j = i % 36; float sum = 0.f;
#pragma unroll
            for (int w = 0; w < 8; ++w) sum += ((const LAS float*)lds)[w * (32 * 48) + tkn * 48 + j];
            lgt[i] = sum; }
        asm volatile("s_waitcnt lgkmcnt(0)" ::: "memory"); __builtin_amdgcn_s_barrier();
        LAS int* esel = (LAS int*)(lds + L1_LG + 32 * 36 * 4);
        if (lane < 4) {
            const int tok = row0 + lane;
            const LAS float* lg = lgt + (wid * 4 + lane) * 36;
            int grp = 0; float l1[4];
#pragma unroll
            for (int j = 0; j < 4; ++j) l1[j] = lg[j] + p.r1_b[j];
            float best = l1[0];
#pragma unroll
            for (int j = 1; j < 4; ++j) if (l1[j] > best) { best = l1[j]; grp = j; }
            float se = 0.f;
#pragma unroll
            for (int j = 0; j < 4; ++j) se += __expf(l1[j] - best);
            const float pg = 1.0f / se;
            float v0 = -3.0e38f, v1 = -3.0e38f; int i0 = 0, i1 = 0;
#pragma unroll
            for (int j = 0; j < 8; ++j) {
                const float l = lg[4 + grp * 8 + j] + p.r2_b[grp * 8 + j];
                if (l > v0) { v1 = v0; i1 = i0; v0 = l; i0 = j; } else if (l > v1) { v1 = l; i1 = j; }
            }
            const float ex = __expf(v1 - v0);
            RT[tok * 2 + 0] = pg / (1.0f + ex); RT[tok * 2 + 1] = pg * ex / (1.0f + ex);
            esel[(wid * 4 + lane) * 2 + 0] = grp * 8 + i0; esel[(wid * 4 + lane) * 2 + 1] = grp * 8 + i1;
        }
        asm volatile("s_waitcnt lgkmcnt(0)" ::: "memory"); __builtin_amdgcn_s_barrier();
        if (tid < 32) {
            int c = 0;
            for (int i = 0; i < 64; ++i) c += (esel[i] == tid) ? 1 : 0;
            esel[64 + tid] = c > 0 ? (int)atomicAdd(&cnt[tid], (unsigned)c) : 0;
        }
        asm volatile("s_waitcnt vmcnt(0) lgkmcnt(0)" ::: "memory"); __builtin_amdgcn_s_barrier();
        if (tid < 64) {
            const int e = esel[tid]; int lr = 0;
            for (int i = 0; i < tid; ++i) lr += (esel[i] == e) ? 1 : 0;
            list[(size_t)e * NTOK + esel[64 + e] + lr] = (rb * 32 + (tid >> 1)) * 2 + (tid & 1);
        }
    }
    asm volatile("s_waitcnt vmcnt(0) lgkmcnt(0)" ::: "memory"); __builtin_amdgcn_s_barrier();
}

struct FinRaw { u32x2 ya[4], yb[4]; u32x4 x[4]; u32x2 g, st; };
__device__ __forceinline__ void fin_request(const Params& p, int tok, int lane, FinRaw& r) {
    const bf16_t* X1 = (const bf16_t*)(p.ws + WS_X1); const unsigned char* Y2 = (const unsigned char*)(p.ws + WS_Y2);
    const float* RT = (const float*)(p.ws + WS_RT); const float* ST = (const float*)(p.ws + WS_STATS);
#pragma unroll
    for (int i = 0; i < 4; ++i) { const int col = i * 512 + lane * 8;
        const unsigned char* a0 = Y2 + (size_t)(tok * 2) * DM + col; const unsigned char* a1 = a0 + DM; const bf16_t* a2 = X1 + (size_t)tok * DM + col;
        asm volatile("global_load_dwordx2 %0, %1, off" : "=v"(r.ya[i]) : "v"(a0) : "memory");
        asm volatile("global_load_dwordx2 %0, %1, off" : "=v"(r.yb[i]) : "v"(a1) : "memory");
        asm volatile("global_load_dwordx4 %0, %1, off" : "=v"(r.x[i]) : "v"(a2) : "memory"); }
    { const float* a3 = RT + tok * 2; const float* a4 = ST + (size_t)tok * 2;
      asm volatile("global_load_dwordx2 %0, %1, off" : "=v"(r.g) : "v"(a3) : "memory");
      asm volatile("global_load_dwordx2 %0, %1, off" : "=v"(r.st) : "v"(a4) : "memory"); }
}
__device__ __forceinline__ void phase_final(const Params& p, LAS unsigned char* lds) {
    const float* MOD = (const float*)(p.ws + WS_MOD);
    const int tid = threadIdx.x, lane = tid & 63, wid = __builtin_amdgcn_readfirstlane(tid >> 6);
    LAS float* PRM = (LAS float*)lds;
    LAS float* GT = PRM + 4 * DM;
    asm volatile("s_waitcnt vmcnt(0) lgkmcnt(0)" ::: "memory"); __builtin_amdgcn_s_barrier();
    {   const int col = tid * 4; const int pidx = (((col >> 9) * 2 + ((col >> 2) & 1)) * 64 + ((col & 511) >> 3)) * 4;
        *(LAS f32x4*)(PRM + pidx) = *(const f32x4*)(p.ln1_w + col) * ALPHA; *(LAS f32x4*)(PRM + DM + pidx) = *(const f32x4*)(p.ln1_b + col) * ALPHA;
        *(LAS f32x4*)(PRM + 2 * DM + pidx) = *(const f32x4*)(p.ln2_w + col); *(LAS f32x4*)(PRM + 3 * DM + pidx) = *(const f32x4*)(p.ln2_b + col);
#pragma unroll
        for (int b = 0; b < NB; ++b) *(LAS f32x4*)(GT + b * DM + pidx) = *(const f32x4*)(MOD + (size_t)b * (NMOD * DM) + 5 * DM + col);
    }
    asm volatile("s_waitcnt vmcnt(0) lgkmcnt(0)" ::: "memory"); __builtin_amdgcn_s_barrier();
    const int stride = gridDim.x * 8;
    int tok = blockIdx.x * 8 + wid;
    if (tok >= NTOK) return;
    FinRaw r; fin_request(p, tok, lane, r);
    bool first = true;
#pragma unroll 1
    for (; tok < NTOK; tok += stride) {
        if (first) asm volatile("s_waitcnt vmcnt(0)" ::: "memory"); else asm volatile("s_waitcnt vmcnt(8)" ::: "memory");
        first = false;
        const LAS float* gt = GT + (tok / SEQ) * DM;
        const unsigned ug0 = r.g.x, ug1 = r.g.y, us1 = r.st.x, us2 = r.st.y;
        const float g0 = __uint_as_float(ug0) * 0.0625f, g1 = __uint_as_float(ug1) * 0.0625f;
        const float st1 = __uint_as_float(us1), st2 = __uint_as_float(us2);
        const float mean1 = st1 * (1.0f / DM), rstd1 = rsqrtf(fmaxf(st2 * (1.0f / DM) - mean1 * mean1, 0.f) + LN_EPS);
        float v[32]; float s = 0.f;
#pragma unroll
        for (int i = 0; i < 4; ++i) {
            float ya[8], yb[8]; unpack8_fp8(r.ya[i].x, r.ya[i].y, ya); unpack8_fp8(r.yb[i].x, r.yb[i].y, yb);
            float xr[8]; unpack2_h16(r.x[i].x, xr[0], xr[1]); unpack2_h16(r.x[i].y, xr[2], xr[3]); unpack2_h16(r.x[i].z, xr[4], xr[5]); unpack2_h16(r.x[i].w, xr[6], xr[7]);
            const int o0 = (i * 2 * 64 + lane) * 4, o1 = o0 + 256;
            const f32x4 xa = ((f32x4){xr[0], xr[1], xr[2], xr[3]} - mean1) * rstd1 * *(const LAS f32x4*)(PRM + o0) + *(const LAS f32x4*)(PRM + DM + o0);
            const f32x4 xb = ((f32x4){xr[4], xr[5], xr[6], xr[7]} - mean1) * rstd1 * *(const LAS f32x4*)(PRM + o1) + *(const LAS f32x4*)(PRM + DM + o1);
            const f32x4 ga = *(const LAS f32x4*)(gt + o0), gb = *(const LAS f32x4*)(gt + o1);
#pragma unroll
            for (int j = 0; j < 4; ++j) { v[i * 8 + j] = xa[j] + ga[j] * (g0 * ya[j] + g1 * yb[j]); v[i * 8 + 4 + j] = xb[j] + gb[j] * (g0 * ya[4 + j] + g1 * yb[4 + j]); }
#pragma unroll
            for (int j = 0; j < 8; ++j) s += v[i * 8 + j];
        }
        {   const int tn = tok + stride < NTOK ? tok + stride : tok;
            fin_request(p, tn, lane, r); }
        const float mu = wave_sum(s) * (1.0f / DM);
        float q = 0.f;
#pragma unroll
        for (int i = 0; i < 32; ++i) { const float dlt = v[i] - mu; q += dlt * dlt; }
        const float rstd = rsqrtf(wave_sum(q) * (1.0f / DM) + LN_EPS);
#pragma unroll
        for (int i = 0; i < 4; ++i) {
            const int col = i * 512 + lane * 8;
            const int o0 = (i * 2 * 64 + lane) * 4, o1 = o0 + 256;
            const f32x4 wa = *(const LAS f32x4*)(PRM + 2 * DM + o0), wb = *(const LAS f32x4*)(PRM + 2 * DM + o1), ba = *(const LAS f32x4*)(PRM + 3 * DM + o0), bb = *(const LAS f32x4*)(PRM + 3 * DM + o1);
            f32x4 oa, ob;
#pragma unroll
            for (int j = 0; j < 4; ++j) { oa[j] = (v[i * 8 + j] - mu) * rstd * wa[j] + ba[j]; ob[j] = (v[i * 8 + 4 + j] - mu) * rstd * wb[j] + bb[j]; }
            *(f32x4*)(p.out + (size_t)tok * DM + col) = oa; *(f32x4*)(p.out + (size_t)tok * DM + col + 4) = ob;
        }
    }
    asm volatile("s_waitcnt vmcnt(0)" ::: "memory");
}

__device__ __forceinline__ void conv_item_src(const Params& p, int item, const float*& src, int& ld, unsigned char*& dst, int& K, bool& f8) {
    f8 = false;
    if (item < 1536) {
        const int nt = item % 48, kt = item / 48; const int n0 = nt * 128, sc = n0 < 4096 ? n0 : n0 + NGATE;
        ld = DIN; K = DM; src = p.w_in + (size_t)(kt * 64) * DIN + sc;
        if (n0 < 3072 || n0 >= 4096) dst = (unsigned char*)(p.ws + WS_BTIN) + ((size_t)n0 * DM + kt * 64) * 2;
        else { dst = (unsigned char*)(p.ws + WS_BTIN) + (size_t)3072 * DM * 2 + (size_t)(n0 - 3072) * DM + kt * 64; f8 = true; }
        return;
    }
    item -= 1536;
    if (item < 512) {
        const int nt = item % 16, kt = item / 16;
        ld = DM; K = DM; src = p.w_out + (size_t)(kt * 64) * DM + nt * 128; dst = (unsigned char*)(p.ws + WS_BTOUT) + ((size_t)(nt * 128) * DM + kt * 64) * 2; return;
    }
    item -= 512;
    if (item < 16384) {
        const int kt = item & 31, pn = (item >> 5) & 7, which = (item >> 8) & 1, e = item >> 9;
        ld = DE; K = DM; src = (which ? p.w_up : p.w_gate) + (size_t)e * DM * DE + (size_t)(kt * 64) * DE + pn * 128;
        dst = (unsigned char*)(p.ws + WS_BTGU) + ((size_t)(e * 8 + pn) * 256 + which * 128) * DM + kt * 64; f8 = true; return;
    }
    item -= 16384;
    {
        const int kt = item & 15, nt = (item >> 4) & 15, e = item >> 8;
        ld = DM; K = DE; src = p.w_down + (size_t)e * DE * DM + (size_t)(kt * 64) * DM + nt * 128;
        dst = (unsigned char*)(p.ws + WS_BTDN) + ((size_t)e * DM + nt * 128) * DE + kt * 64; f8 = true;
    }
}
constexpr int CONV_ITEMS_ALL = 1536 + 512 + 16384 + 8192;
constexpr int CT_B1 = 10;
constexpr int CONV_TAIL = 128 * CT_B1;
__device__ __forceinline__ void phase_convert(const Params& p, LAS unsigned char* lds, const int first, const int CONV_ITEMS, const int start, const int stride) {
    LAS float* tile = (LAS float*)lds;
    const int tid = threadIdx.x;
    float4 r[4];
    int item = first + start;
    const float* src; int ld; unsigned char* dst; int K; bool f8;
    if (item < CONV_ITEMS) {
        conv_item_src(p, item, src, ld, dst, K, f8);
#pragma unroll
        for (int i = 0; i < 4; ++i) { const int idx = tid + 512 * i; r[i] = *(const float4*)(src + (size_t)(idx >> 5) * ld + (idx & 31) * 4); }
    }
    for (; item < CONV_ITEMS; item += stride) {
        __syncthreads();
#pragma unroll
        for (int i = 0; i < 4; ++i) { const int idx = tid + 512 * i; LAS float* t = tile + (idx >> 5) * 129 + (idx & 31) * 4; t[0] = r[i].x; t[1] = r[i].y; t[2] = r[i].z; t[3] = r[i].w; }
        unsigned char* cdst = dst; const int cK = K; const bool cf8 = f8;
        const int nitem = item + stride;
        if (nitem < CONV_ITEMS) {
            conv_item_src(p, nitem, src, ld, dst, K, f8);
#pragma unroll
            for (int i = 0; i < 4; ++i) { const int idx = tid + 512 * i; r[i] = *(const float4*)(src + (size_t)(idx >> 5) * ld + (idx & 31) * 4); }
        }
        __syncthreads();
#pragma unroll
        for (int i = 0; i < 2; ++i) {
            const int o = tid + 512 * i, kg = o & 7, n = o >> 3;
            const LAS float* t = tile + (kg * 8) * 129 + n;
            if (cf8) { u32x2 w;
                w.x = pack4_fp8(t[0 * 129] * F8_WMUL, t[1 * 129] * F8_WMUL, t[2 * 129] * F8_WMUL, t[3 * 129] * F8_WMUL);
                w.y = pack4_fp8(t[4 * 129] * F8_WMUL, t[5 * 129] * F8_WMUL, t[6 * 129] * F8_WMUL, t[7 * 129] * F8_WMUL);
                *(u32x2*)(cdst + (size_t)n * cK + kg * 8) = w;
            } else { u32x4 w;
                w.x = cvt_pk_bf16(t[0 * 129], t[1 * 129]); w.y = cvt_pk_bf16(t[2 * 129], t[3 * 129]);
                w.z = cvt_pk_bf16(t[4 * 129], t[5 * 129]); w.w = cvt_pk_bf16(t[6 * 129], t[7 * 129]);
                *(u32x4*)(cdst + ((size_t)n * cK + kg * 8) * 2) = w; }
        }
    }
    __syncthreads();
}

namespace pg8 {
constexpr int BM = 256, BK = 64, HALF = 128, HTB = HALF * BK * 2, STAGE_BYTES = 8 * HTB;
__device__ __forceinline__ int lds_byte(int r, int c) { const int st = (r >> 4) * 2 + (c >> 5), rr = r & 15, cc = c & 31, ob = rr * 64 + cc * 2; return st * 1024 + (ob ^ (((ob >> 9) & 1) << 5)); }
__device__ __forceinline__ void stage_rc(int b, int& R, int& C) { const int st = b / 1024, sb = b % 1024, swz = sb ^ (((sb >> 9) & 1) << 5); R = (st >> 1) * 16 + swz / 64; C = (st & 1) * 32 + (swz % 64) / 2; }
__device__ __forceinline__ int perm32(int rho) { const int n = rho >> 4, i = rho & 15; return 8 * (i >> 2) + 4 * n + (i & 3); }

struct Unit {
    const char* a;
    const char* b;
    const int* rows;
    int rows_lds;
    int nvalid;
    int pm, pn, e, aux;
};

template <bool PERM, bool F8, class Epi, class Sched>
__device__ __forceinline__ void gemm_phase(LAS unsigned char* lds, const int KB, const Sched& S, const Epi& E) {
    const int tid = threadIdx.x, wid = __builtin_amdgcn_readfirstlane(tid >> 6), lane = tid & 63, wr = wid >> 2, wc = wid & 3, fr = lane & 15, fq = lane >> 4;
    const int nt = KB / 128;
    unsigned vb0, vb1;
    { int Rr[2], Cc[2]; stage_rc(tid * 16, Rr[0], Cc[0]); stage_rc(tid * 16 + 8192, Rr[1], Cc[1]);
      const int Rb0 = PERM ? ((Rr[0] & ~31) + perm32(Rr[0] & 31)) : Rr[0], Rb1 = PERM ? ((Rr[1] & ~31) + perm32(Rr[1] & 31)) : Rr[1];
      vb0 = (unsigned)(Rb0 * KB + 2 * Cc[0]); vb1 = (unsigned)(Rb1 * KB + 2 * Cc[1]); }
    const size_t kstep = (size_t)(BK * 2);
    const size_t hstepB = (size_t)HALF * KB;
    const unsigned ldsw = (unsigned)wid * 1024u;
    const int aoff = lds_byte(wr * 64 + fr, fq * 8), boff = lds_byte(wc * 32 + fr, fq * 8);
#define PG8_SA(b, h) (((b) * 2 + (h)) * HTB)
#define PG8_SB(b, h) ((4 + (b) * 2 + (h)) * HTB)
#define PG8_STAGE2(bufoff, gbase, v0, v1) do { \
        __builtin_amdgcn_global_load_lds((const unsigned*)((const char*)(gbase) + (v0)), (LAS unsigned*)(lds + (bufoff) + ldsw), 16, 0, 0); \
        __builtin_amdgcn_global_load_lds((const unsigned*)((const char*)(gbase) + (v1)), (LAS unsigned*)(lds + (bufoff) + ldsw + 8192), 16, 0, 0); } while (0)
#define PG8_LD16(off) (*(const LAS i32x4*)(lds + (off)))
#define PG8_LDA(dst, b, h) do { if constexpr (F8) { _Pragma("unroll") for (int m = 0; m < 4; ++m) dst##8[m] = __builtin_shufflevector(PG8_LD16(PG8_SA(b, h) + aoff + m * 2048), PG8_LD16(PG8_SA(b, h) + aoff + m * 2048 + 1024), 0, 1, 2, 3, 4, 5, 6, 7); } \
        else { _Pragma("unroll") for (int m = 0; m < 4; ++m) _Pragma("unroll") for (int k = 0; k < 2; ++k) dst[m][k] = *(const LAS bf16x8*)(lds + PG8_SA(b, h) + aoff + m * 2048 + k * 1024); } } while (0)
#define PG8_LDB(dst, b, h) do { if constexpr (F8) { _Pragma("unroll") for (int n = 0; n < 2; ++n) dst##8[n] = __builtin_shufflevector(PG8_LD16(PG8_SB(b, h) + boff + n * 2048), PG8_LD16(PG8_SB(b, h) + boff + n * 2048 + 1024), 0, 1, 2, 3, 4, 5, 6, 7); } \
        else { _Pragma("unroll") for (int n = 0; n < 2; ++n) _Pragma("unroll") for (int k = 0; k < 2; ++k) dst[n][k] = *(const LAS bf16x8*)(lds + PG8_SB(b, h) + boff + n * 2048 + k * 1024); } } while (0)
#define PG8_MMA(ai, bj, At, Bt) do { __builtin_amdgcn_s_setprio(1); \
        if constexpr (F8) { _Pragma("unroll") for (int m = 0; m < 4; ++m) _Pragma("unroll") for (int n = 0; n < 2; ++n) \
            asm volatile("v_mfma_scale_f32_16x16x128_f8f6f4 %0, %1, %2, %0, %3, %4 op_sel_hi:[0,0,0]" : "+v"(acc[ai][bj][m][n]) : "v"(Bt##8[n]), "v"(At##8[m]), "v"(f8sw), "v"(f8sa)); } \
        else { _Pragma("unroll") for (int m = 0; m < 4; ++m) _Pragma("unroll") for (int n = 0; n < 2; ++n) _Pragma("unroll") for (int k = 0; k < 2; ++k) \
            acc[ai][bj][m][n] = __builtin_amdgcn_mfma_f32_16x16x32_bf16(Bt[n][k], At[m][k], acc[ai][bj][m][n], 0, 0, 0); } \
        __builtin_amdgcn_s_setprio(0); } while (0)
#define PG8_WAIT_V(n) asm volatile("s_waitcnt vmcnt(" #n ")" ::: "memory")
#define PG8_WAIT_L(n) asm volatile("s_waitcnt lgkmcnt(" #n ")" ::: "memory")
#define PG8_BAR __builtin_amdgcn_s_barrier()
#define PG8_SCHED __builtin_amdgcn_sched_barrier(0)
#define PG8_VOFF(u, v00, v01, v10, v11) do { int Rr[2], Cc[2]; int tq = tid; asm volatile("" : "+v"(tq)); stage_rc(tq * 16, Rr[0], Cc[0]); stage_rc(tq * 16 + 8192, Rr[1], Cc[1]); \
        if ((u).rows_lds >= 0) { const int nvm = (u).nvalid - 1; const LAS int* rl_ = (const LAS int*)(lds + (u).rows_lds); \
            const int r00 = Rr[0] < nvm ? Rr[0] : nvm, r01 = Rr[1] < nvm ? Rr[1] : nvm, r10 = (Rr[0] + 128) < nvm ? (Rr[0] + 128) : nvm, r11 = (Rr[1] + 128) < nvm ? (Rr[1] + 128) : nvm; \
            v00 = (unsigned)((rl_[r00] >> 1) * KB + 2 * Cc[0]); v01 = (unsigned)((rl_[r01] >> 1) * KB + 2 * Cc[1]); \
            v10 = (unsigned)((rl_[r10] >> 1) * KB + 2 * Cc[0]); v11 = (unsigned)((rl_[r11] >> 1) * KB + 2 * Cc[1]); \
        } else { v00 = (unsigned)(Rr[0] * KB + 2 * Cc[0]); v01 = (unsigned)(Rr[1] * KB + 2 * Cc[1]); v10 = (unsigned)((Rr[0] + 128) * KB + 2 * Cc[0]); v11 = (unsigned)((Rr[1] + 128) * KB + 2 * Cc[1]); } } while (0)
    Unit cur, nxt; int ui = 0;
    if (!S.next(0, cur)) return;
    f32x4 acc[2][2][4][2];
#pragma unroll
    for (int a = 0; a < 2; ++a)
#pragma unroll
        for (int b = 0; b < 2; ++b)
#pragma unroll
            for (int m = 0; m < 4; ++m)
#pragma unroll
                for (int n = 0; n < 2; ++n) acc[a][b][m][n] = (f32x4){0.f, 0.f, 0.f, 0.f};
    bf16x8 At[4][2], B0[2][2], B1[2][2]; i32x8 At8[4], B08[2], B18[2];
    const int f8sw = F8_SCALE_W, f8sa = F8_SCALE_A;
    unsigned vc00, vc01, vc10, vc11, vn00, vn01, vn10, vn11;
    PG8_VOFF(cur, vc00, vc01, vc10, vc11);
    const char* cA = cur.a; const char* cB = cur.b;
    PG8_STAGE2(PG8_SB(0, 0), cB, vb0, vb1); PG8_STAGE2(PG8_SA(0, 0), cA, vc00, vc01); PG8_STAGE2(PG8_SB(0, 1), cB + hstepB, vb0, vb1); PG8_STAGE2(PG8_SA(0, 1), cA, vc10, vc11);
    if (wr == 1) PG8_BAR;
    PG8_WAIT_V(4); PG8_BAR;
    PG8_STAGE2(PG8_SB(1, 0), cB + kstep, vb0, vb1); PG8_STAGE2(PG8_SA(1, 0), cA + kstep, vc00, vc01); PG8_STAGE2(PG8_SB(1, 1), cB + hstepB + kstep, vb0, vb1);
    PG8_WAIT_V(6); PG8_BAR;
    for (;;) {
        const bool has_next = S.next(ui + 1, nxt);
        const char* nA = has_next ? nxt.a : cA; const char* nB = has_next ? nxt.b : cB;
        if (has_next) { PG8_VOFF(nxt, vn00, vn01, vn10, vn11); } else { vn00 = vc00; vn01 = vc01; vn10 = vc10; vn11 = vc11; }
        for (int t = 0; t < nt; t += 2) {
            const bool last = (t == nt - 2);
            const char* a1 = cA + (size_t)(t + 1) * kstep;
            const char* a2 = last ? nA : cA + (size_t)(t + 2) * kstep; const char* b2 = last ? nB : cB + (size_t)(t + 2) * kstep;
            const char* a3 = a2 + kstep; const char* b3 = b2 + kstep;
            const unsigned w00 = last ? vn00 : vc00, w01 = last ? vn01 : vc01, w10 = last ? vn10 : vc10, w11 = last ? vn11 : vc11;
            PG8_LDB(B0, 0, 0); PG8_SCHED; PG8_LDA(At, 0, 0); PG8_STAGE2(PG8_SA(1, 1), a1, vc10, vc11);
            PG8_WAIT_L(8); PG8_BAR; PG8_WAIT_L(0); PG8_MMA(0, 0, At, B0); PG8_BAR; PG8_SCHED;
            PG8_LDB(B1, 0, 1); PG8_STAGE2(PG8_SB(0, 0), b2, vb0, vb1);
            PG8_BAR; PG8_WAIT_L(0); PG8_MMA(0, 1, At, B1); PG8_BAR;
            PG8_LDA(At, 0, 1); PG8_STAGE2(PG8_SA(0, 0), a2, w00, w01);
            PG8_BAR; PG8_WAIT_L(0); PG8_MMA(1, 0, At, B0); PG8_BAR; PG8_SCHED;
            PG8_STAGE2(PG8_SB(0, 1), b2 + hstepB, vb0, vb1);
            PG8_WAIT_V(6); PG8_BAR; PG8_MMA(1, 1, At, B1); PG8_BAR;
            PG8_LDB(B0, 1, 0); PG8_SCHED; PG8_LDA(At, 1, 0); PG8_STAGE2(PG8_SA(0, 1), a2, w10, w11);
            PG8_WAIT_L(8); PG8_BAR; PG8_WAIT_L(0); PG8_MMA(0, 0, At, B0); PG8_BAR; PG8_SCHED;
            PG8_LDB(B1, 1, 1); PG8_STAGE2(PG8_SB(1, 0), b3, vb0, vb1);
            PG8_BAR; PG8_WAIT_L(0); PG8_MMA(0, 1, At, B1); PG8_BAR;
            PG8_LDA(At, 1, 1); PG8_STAGE2(PG8_SA(1, 0), a3, w00, w01);
            PG8_BAR; PG8_WAIT_L(0); PG8_MMA(1, 0, At, B0); PG8_BAR; PG8_SCHED;
            PG8_STAGE2(PG8_SB(1, 1), b3 + hstepB, vb0, vb1);
            PG8_WAIT_V(6); PG8_BAR; PG8_MMA(1, 1, At, B1); PG8_BAR;
        }
        if constexpr (F8) asm volatile("s_nop 15\n\ts_nop 15" ::: "memory");
        E(acc, cur, wr, wc, fr, fq);
        if (!has_next) break;
#pragma unroll
        for (int a = 0; a < 2; ++a)
#pragma unroll
            for (int b = 0; b < 2; ++b)
#pragma unroll
                for (int m = 0; m < 4; ++m)
#pragma unroll
                    for (int n = 0; n < 2; ++n) acc[a][b][m][n] = (f32x4){0.f, 0.f, 0.f, 0.f};
        cur = nxt; cA = nA; cB = nB; vc00 = vn00; vc01 = vn01; vc10 = vn10; vc11 = vn11; ++ui;
    }
    PG8_WAIT_V(0);
    if (wr == 0) PG8_BAR;
    PG8_BAR;
#undef PG8_SA
#undef PG8_SB
#undef PG8_STAGE2
#undef PG8_LDA
#undef PG8_LDB
#undef PG8_LD16
#undef PG8_MMA
#undef PG8_WAIT_V
#undef PG8_WAIT_L
#undef PG8_BAR
#undef PG8_SCHED
#undef PG8_VOFF
}

__device__ __forceinline__ void static_tile(int L, int nM, int nN, int& pm, int& pn) {
    const int nwg = nM * nN; int wgid = L;
    { const int q = nwg / 8, r = nwg % 8, xcd = wgid % 8, off = wgid / 8; wgid = (xcd < r ? xcd * (q + 1) : r * (q + 1) + (xcd - r) * q) + off; }
    const int nig = 8 * nN, gid = wgid / nig, fm = gid * 8, gsz = (nM - fm) < 8 ? (nM - fm) : 8;
    pm = fm + ((wgid % nig) % gsz); pn = (wgid % nig) / gsz;
}
}

struct SchedIn {
    const Params* p;
    __device__ __forceinline__ bool next(int i, pg8::Unit& u) const {
        const long L = (long)i * gridDim.x + blockIdx.x;
        const char* HXb = (const char*)(p->ws + WS_HX); const char* BT = (const char*)(p->ws + WS_BTIN);
        u.rows = nullptr; u.rows_lds = -1; u.nvalid = 256; u.e = 0;
        if (L < 1280) { int j; pg8::static_tile((int)L, 64, 20, u.pm, j); u.pn = j < 12 ? j : j + 4; u.aux = 0; u.a = HXb + (size_t)u.pm * 256 * DM * 2; u.b = BT + (size_t)u.pn * 256 * DM * 2; return true; }
        if (L < 1344) { const int l = (int)L - 1280; u.pm = l >> 3; u.pn = l & 7; u.aux = 1; u.a = HXb + (size_t)(NTOK + u.pm * 256) * DM * 2; u.b = BT + (size_t)(4 + u.pn) * 256 * DM * 2; return true; }
        return false;
    }
};
struct SchedIn8 {
    const Params* p;
    __device__ __forceinline__ bool next(int i, pg8::Unit& u) const {
        int U;
        if (gridDim.x == 256) { const int c = blockIdx.x;
            if (c < 64) return false; else if (c < 192) { if (i >= 1) return false; U = c - 64; } else { if (i >= 2) return false; U = 128 + (c - 192) * 2 + i; }
        } else { const long L = (long)i * gridDim.x + blockIdx.x; if (L >= 256) return false; U = (int)L; }
        u.rows = nullptr; u.rows_lds = -1; u.nvalid = 256; u.e = 0; u.aux = 0; u.pm = U >> 2; u.pn = 12 + (U & 3);
        u.a = (const char*)(p->ws + WS_HX8) + (size_t)u.pm * 256 * DM; u.b = (const char*)(p->ws + WS_BTIN) + (size_t)3072 * DM * 2 + (size_t)(u.pn - 12) * 256 * DM; return true;
    }
};
struct EpiIn {
    const Params* p;
    __device__ __forceinline__ void operator()(const f32x4 (&acc)[2][2][4][2], const pg8::Unit& u, int wr, int wc, int fr, int fq) const {
        bf16_t* O; int ldc; bool act = false;
        if (u.aux == 0) { O = (bf16_t*)(p->ws + WS_P); ldc = PW; act = u.pn >= 16; } else { O = (bf16_t*)(p->ws + WS_PC); ldc = 2048; }
        const int row0 = u.pm * 256 + wr * 64 + fr, col0 = u.pn * 256 + wc * 32 + 8 * fq;
#pragma unroll
        for (int ai = 0; ai < 2; ++ai)
#pragma unroll
            for (int m = 0; m < 4; ++m) { bf16_t* rowp = O + (size_t)(row0 + ai * 128 + m * 16) * ldc + col0;
#pragma unroll
                for (int bj = 0; bj < 2; ++bj) { f32x4 v0 = acc[ai][bj][m][0], v1 = acc[ai][bj][m][1];
                    if (act) {
#pragma unroll
                        for (int j = 0; j < 4; ++j) { v0[j] = gelu_tanh_f(v0[j]); v1[j] = gelu_tanh_f(v1[j]); } }
                    u32x4 w; w.x = cvt_pk_bf16(v0[0], v0[1]); w.y = cvt_pk_bf16(v0[2], v0[3]); w.z = cvt_pk_bf16(v1[0], v1[1]); w.w = cvt_pk_bf16(v1[2], v1[3]);
                    *(u32x4*)(rowp + bj * 128) = w; } }
    }
};
struct SchedOut {
    const Params* p;
    __device__ __forceinline__ bool next(int i, pg8::Unit& u) const {
        const long L = (long)i * gridDim.x + blockIdx.x; if (L >= 512) return false;
        pg8::static_tile((int)L, 64, 8, u.pm, u.pn); u.rows = nullptr; u.rows_lds = -1; u.nvalid = 256; u.e = 0; u.aux = 0;
        u.a = (const char*)(p->ws + WS_YCAT) + (size_t)u.pm * 256 * DM * 2; u.b = (const char*)(p->ws + WS_BTOUT) + (size_t)u.pn * 256 * DM * 2; return true;
    }
};
struct EpiOut {
    const Params* p;
    __device__ __forceinline__ void operator()(const f32x4 (&acc)[2][2][4][2], const pg8::Unit& u, int wr, int wc, int fr, int fq) const {
        bf16_t* X1 = (bf16_t*)(p->ws + WS_X1); const float* pos = (const float*)(p->ws + WS_POS); const float* MOD = (const float*)(p->ws + WS_MOD); float* ST = (float*)(p->ws + WS_STATS);
        const int row0 = u.pm * 256 + wr * 64 + fr, col0 = u.pn * 256 + wc * 32 + 4 * fq;
        const int b = (u.pm * 256) / SEQ;
        f32x4 g1[2][2];
#pragma unroll
        for (int bj = 0; bj < 2; ++bj)
#pragma unroll
            for (int n = 0; n < 2; ++n) g1[bj][n] = *(const f32x4*)(MOD + (size_t)b * (NMOD * DM) + 2 * DM + col0 + bj * 128 + n * 16);
#pragma unroll
        for (int ai = 0; ai < 2; ++ai)
#pragma unroll
            for (int mp = 0; mp < 2; ++mp) {
                f32x4 xv[2][2][2], pv[2][2][2];
#pragma unroll
                for (int mm = 0; mm < 2; ++mm) { const int row = row0 + ai * 128 + (mp * 2 + mm) * 16; const int ts = row % SEQ, rr = ts >> 6, cc = ts & 63;
#pragma unroll
                    for (int bj = 0; bj < 2; ++bj)
#pragma unroll
                        for (int n = 0; n < 2; ++n) { const int col = col0 + bj * 128 + n * 16;
                            xv[mm][bj][n] = *(const f32x4*)(p->x + (size_t)row * DM + col);
                            pv[mm][bj][n] = *(const f32x4*)(col < 1024 ? pos + rr * 1024 + col : pos + 32 * 1024 + cc * 1024 + (col - 1024)); } }
#pragma unroll
                for (int mm = 0; mm < 2; ++mm) { const int m = mp * 2 + mm; const int row = row0 + ai * 128 + m * 16;
                    float s1 = 0.f, s2 = 0.f;
#pragma unroll
                    for (int bj = 0; bj < 2; ++bj)
#pragma unroll
                        for (int n = 0; n < 2; ++n) { const int col = col0 + bj * 128 + n * 16;
                            const f32x4 v = (xv[mm][bj][n] + pv[mm][bj][n]) * ALPHA + g1[bj][n] * acc[ai][bj][m][n];
                            { u32x2 o; o.x = pack2_h16(v[0], v[1]); o.y = pack2_h16(v[2], v[3]); *(u32x2*)(X1 + (size_t)row * DM + col) = o; }
                            s1 += (v[0] + v[1]) + (v[2] + v[3]); s2 += (v[0] * v[0] + v[1] * v[1]) + (v[2] * v[2] + v[3] * v[3]); }
                    s1 += __shfl_xor(s1, 16, 64); s2 += __shfl_xor(s2, 16, 64); s1 += __shfl_xor(s1, 32, 64); s2 += __shfl_xor(s2, 32, 64);
                    if (fq == 0) { atomicAdd(ST + (size_t)row * 2, s1); atomicAdd(ST + (size_t)row * 2 + 1, s2); } }
            }
    }
};
__device__ __forceinline__ bool moe_unit(int i, const LAS int* tab, int& P, int& nt) {
    const int G = gridDim.x, c = blockIdx.x;
    const int wgid = (G % 8 == 0) ? (c % 8) * (G / 8) + c / 8 : c;
    const long L = (long)i * G + wgid; P = (int)(L >> 3); nt = (int)(L & 7);
    return P < tab[160 * 4];
}
__device__ __forceinline__ void moe_build_table(const Params& p, LAS int* tab) {
    if (threadIdx.x == 0) {
        const unsigned* cnt = (const unsigned*)(p.ws + WS_CTL) + CW_CNT;
        int np = 0, off = 0;
        for (int e = 0; e < NE; ++e) { const int c = (int)cnt[e]; const int nmt = (c + 255) >> 8;
            for (int mt = 0; mt < nmt; ++mt) { tab[np * 4 + 0] = e; tab[np * 4 + 1] = mt; tab[np * 4 + 2] = off + mt * 256; tab[np * 4 + 3] = (c - mt * 256) < 256 ? (c - mt * 256) : 256; ++np; }
            off += nmt * 256; }
        tab[160 * 4] = np;
    }
    __syncthreads();
    LAS int* rl = (LAS int*)((LAS unsigned char*)tab - LDS_TAB + LDS_ROWS);
    for (int i = 0; i < 8; ++i) { int P, nt; if (!moe_unit(i, tab, P, nt)) break;
        const int e = tab[P * 4], mt = tab[P * 4 + 1];
        if (threadIdx.x < 256) rl[i * 256 + threadIdx.x] = ((const int*)(p.ws + WS_LIST))[(size_t)e * NTOK + mt * 256 + threadIdx.x]; }
    __syncthreads();
}
struct SchedMoe1 {
    const Params* p; const LAS int* tab;
    __device__ __forceinline__ bool next(int i, pg8::Unit& u) const {
        int P, nt; if (!moe_unit(i, tab, P, nt)) return false;
        const int e = tab[P * 4], mt = tab[P * 4 + 1];
        u.e = e; u.pm = P; u.pn = nt; u.aux = tab[P * 4 + 2]; u.nvalid = tab[P * 4 + 3];
        u.rows = nullptr; u.rows_lds = LDS_ROWS + i * 1024;
        u.a = (const char*)(p->ws + WS_T); u.b = (const char*)(p->ws + WS_BTGU) + (size_t)(e * 8 + nt) * 256 * DM; return true;
    }
};
struct EpiMoe1 {
    const Params* p;
    __device__ __forceinline__ void operator()(const f32x4 (&acc)[2][2][4][2], const pg8::Unit& u, int wr, int wc, int fr, int fq) const {
        unsigned char* H = (unsigned char*)(p->ws + WS_H);
        const int row0 = u.aux + wr * 64 + fr, col0 = u.pn * 128 + wc * 32 + 8 * fq;
#pragma unroll
        for (int ai = 0; ai < 2; ++ai)
#pragma unroll
            for (int m = 0; m < 4; ++m) { unsigned char* rowp = H + (size_t)(row0 + ai * 128 + m * 16) * DE + col0;
                float h[8];
#pragma unroll
                for (int n = 0; n < 2; ++n)
#pragma unroll
                    for (int j = 0; j < 4; ++j) h[n * 4 + j] = silu_f(acc[ai][0][m][n][j]) * acc[ai][1][m][n][j];
                u32x2 w; w.x = pack4_fp8(h[0], h[1], h[2], h[3]); w.y = pack4_fp8(h[4], h[5], h[6], h[7]);
                *(u32x2*)rowp = w; }
    }
};
struct SchedMoe2 {
    const Params* p; const LAS int* tab;
    __device__ __forceinline__ bool next(int i, pg8::Unit& u) const {
        int P, nt; if (!moe_unit(i, tab, P, nt)) return false;
        const int e = tab[P * 4], mt = tab[P * 4 + 1];
        u.e = LDS_ROWS + i * 1024; u.pm = P; u.pn = nt; u.aux = mt; u.nvalid = tab[P * 4 + 3]; u.rows = nullptr; u.rows_lds = -1;
        u.a = (const char*)(p->ws + WS_H) + (size_t)tab[P * 4 + 2] * DE; u.b = (const char*)(p->ws + WS_BTDN) + ((size_t)e * DM + nt * 256) * DE; return true;
    }
};
struct EpiMoe2 {
    const Params* p; LAS unsigned char* lds;
    __device__ __forceinline__ void operator()(const f32x4 (&acc)[2][2][4][2], const pg8::Unit& u, int wr, int wc, int fr, int fq) const {
        unsigned char* Y2 = (unsigned char*)(p->ws + WS_Y2);
        const LAS int* list = (const LAS int*)(lds + u.e);
        const int r0 = wr * 64 + fr, col0 = u.pn * 256 + wc * 32 + 8 * fq;
        int ents[2][4];
#pragma unroll
        for (int ai = 0; ai < 2; ++ai)
#pragma unroll
            for (int m = 0; m < 4; ++m) { const int r = r0 + ai * 128 + m * 16; ents[ai][m] = r < u.nvalid ? list[r] : 0; }
#pragma unroll
        for (int ai = 0; ai < 2; ++ai)
#pragma unroll
            for (int m = 0; m < 4; ++m) { const int r = r0 + ai * 128 + m * 16;
                if (r < u.nvalid) { const int ent = ents[ai][m]; unsigned char* rowp = Y2 + (size_t)ent * DM + col0;
#pragma unroll
                    for (int bj = 0; bj < 2; ++bj) { const f32x4 v0 = acc[ai][bj][m][0] * 16.0f, v1 = acc[ai][bj][m][1] * 16.0f;
                        u32x2 w; w.x = pack4_fp8(v0[0], v0[1], v0[2], v0[3]); w.y = pack4_fp8(v1[0], v1[1], v1[2], v1[3]);
                        *(u32x2*)(rowp + bj * 128) = w; } } }
    }
};

typedef short s16x4 __attribute__((ext_vector_type(4)));
__device__ __forceinline__ s16x4 tr16(const LAS unsigned char* p) { return __builtin_bit_cast(s16x4, __builtin_amdgcn_ds_read_tr16_b64_v4i16((LAS s16x4*)p)); }
__device__ __forceinline__ bf16x8 tr_frag(const LAS unsigned char* tile, int pitchB, int k0, int c0, int lane) {
    const int g = lane >> 4, i = lane & 15;
    const LAS unsigned char* a = tile + (k0 + 8 * g + (i >> 2)) * pitchB + (c0 + 4 * (i & 3)) * 2;
    const s16x4 lo = tr16(a), hi = tr16(a + 4 * pitchB);
    return (bf16x8){lo[0], lo[1], lo[2], lo[3], hi[0], hi[1], hi[2], hi[3]};
}
__device__ __forceinline__ bf16x8 row_frag(const LAS unsigned char* tile, int pitchB, int r0, int k0, int lane) {
    return *(const LAS bf16x8*)(tile + (r0 + (lane & 15)) * pitchB + (k0 + 8 * (lane >> 4)) * 2);
}
#define DPPF(old_, src_, ctrl_, rmask_) __int_as_float(__builtin_amdgcn_update_dpp(__float_as_int(old_), __float_as_int(src_), (ctrl_), (rmask_), 0xf, false))
__device__ __forceinline__ float row16_sum(float v) {
    v += DPPF(0.f, v, 0x128, 0xf); v += DPPF(0.f, v, 0x124, 0xf); v += DPPF(0.f, v, 0x122, 0xf); v += DPPF(0.f, v, 0x121, 0xf); return v;
}
__device__ __forceinline__ float wscan_sum(float v, int) {
    v += DPPF(0.f, v, 0x111, 0xf); v += DPPF(0.f, v, 0x112, 0xf); v += DPPF(0.f, v, 0x114, 0xf); v += DPPF(0.f, v, 0x118, 0xf);
    v += DPPF(0.f, v, 0x142, 0xa); v += DPPF(0.f, v, 0x143, 0xc); return v;
}
__device__ __forceinline__ float wscan_max(float v, int) {
    const float ninf = -3.0e38f;
    v = fmaxf(v, DPPF(ninf, v, 0x111, 0xf)); v = fmaxf(v, DPPF(ninf, v, 0x112, 0xf)); v = fmaxf(v, DPPF(ninf, v, 0x114, 0xf)); v = fmaxf(v, DPPF(ninf, v, 0x118, 0xf));
    v = fmaxf(v, DPPF(ninf, v, 0x142, 0xa)); v = fmaxf(v, DPPF(ninf, v, 0x143, 0xc)); return v;
}
__device__ __forceinline__ float wave_max(float v) {
#pragma unroll
    for (int o = 32; o > 0; o >>= 1) v = fmaxf(v, __shfl_xor(v, o, 64));
    return v;
}
__device__ __forceinline__ void conv8x8_load(const bf16_t* src, size_t pitch, int tfirst, int len, u32x4 (&raw)[10]) {
#pragma unroll
    for (int i = 0; i < 10; ++i) { const int ts = tfirst - 1 + i; raw[i] = (ts >= 0 && ts < len) ? *(const u32x4*)(src + (size_t)ts * pitch) : (u32x4){0u, 0u, 0u, 0u}; }
}
__device__ __forceinline__ void conv8x8_compute(const u32x4 (&raw)[10], const float* cw, const float* cb, int ch, float scale, LAS unsigned char* dst, int dpitchB) {
    float w0[8], w1[8], w2[8], bb[8];
#pragma unroll
    for (int j = 0; j < 8; ++j) { w0[j] = cw[ch + j]; w1[j] = cw[2048 + ch + j]; w2[j] = cw[4096 + ch + j]; bb[j] = cb[ch + j]; }
    float a[8], b[8], c[8];
    unpack8(raw[0], a); unpack8(raw[1], b);
#pragma unroll
    for (int r = 0; r < 8; ++r) {
        unpack8(raw[r + 2], c);
        float o[8];
#pragma unroll
        for (int j = 0; j < 8; ++j) o[j] = silu_f(bb[j] + w0[j] * a[j] + w1[j] * b[j] + w2[j] * c[j]) * scale;
        *(LAS u32x4*)(dst + r * dpitchB) = pack8(o);
#pragma unroll
        for (int j = 0; j < 8; ++j) { a[j] = b[j]; b[j] = c[j]; }
    }
}
__device__ __forceinline__ void conv8x8(const bf16_t* src, size_t pitch, int tfirst, int len, const float* cw, const float* cb, int ch, float scale, LAS unsigned char* dst, int dpitchB) {
    u32x4 raw[10]; conv8x8_load(src, pitch, tfirst, len, raw); conv8x8_compute(raw, cw, cb, ch, scale, dst, dpitchB);
}

constexpr int SC_V0 = 0, SC_V1 = 65536, SC_K = 131072, SC_VEC = SC_K + 18432;
struct ScanSrc { const bf16_t* src; size_t pitch; int kcol, vcol, len, t0, c; const float* grow; bool isx; };
__device__ __forceinline__ ScanSrc scan_src(const Params& p, int step, int b, int h, int dir, int es) {
    ScanSrc q; q.isx = step >= 2;
    q.c = q.isx ? (dir ? 17 - step : step - 2) : (dir ? 1 - step : step);
    q.src = q.isx ? (const bf16_t*)(p.ws + WS_P) + (size_t)(b * SEQ) * PW : (const bf16_t*)(p.ws + WS_PC) + (size_t)(b * CTXL) * 2048;
    q.pitch = q.isx ? PW : 2048;
    q.kcol = (q.isx ? 1024 : 0) + h * HD + es * 64; q.vcol = (q.isx ? 2048 : 1024) + h * HD; q.len = q.isx ? SEQ : CTXL; q.t0 = q.c * CHK;
    q.grow = (const float*)(p.ws + WS_GATES) + (size_t)(q.isx ? b * SEQ + q.t0 : NTOK + b * CTXL + q.t0) * NGATE + dir * 8 + h;
    return q;
}
__device__ __forceinline__ void scan_vdma(const ScanSrc& q, LAS unsigned char* vb, int wid, int lane) {
    const unsigned base = __builtin_amdgcn_readfirstlane((unsigned)(__SIZE_TYPE__)(vb + 8 * wid * 1024));
#pragma unroll
    for (int i = 0; i < 8; ++i) { const int row = 2 * (8 * wid + i) + (lane >> 5); const int gc = (lane & 31) ^ (row & 7);
        glds16_asm(q.src + (size_t)(q.t0 + row) * q.pitch + q.vcol + gc * 8, base + i * 1024); }
}
__device__ __forceinline__ bf16x8 tr_frag_swz(const LAS unsigned char* tile, int k0, int c0, int lane) {
    const int g = lane >> 4, i = lane & 15, r = i >> 2, col = c0 + 4 * (i & 3);
    const int row = k0 + 8 * g + r;
    const LAS unsigned char* a0 = tile + row * 512 + (((col >> 3) ^ r) << 4) + ((col & 4) << 1);
    const LAS unsigned char* a1 = tile + (row + 4) * 512 + (((col >> 3) ^ (r + 4)) << 4) + ((col & 4) << 1);
    const s16x4 lo = tr16(a0), hi = tr16(a1);
    return (bf16x8){lo[0], lo[1], lo[2], lo[3], hi[0], hi[1], hi[2], hi[3]};
}
__device__ __forceinline__ void conv4x8_load(const bf16_t* src, size_t pitch, int tfirst, int len, u32x4 (&raw)[6]) {
#pragma unroll
    for (int i = 0; i < 6; ++i) { const int ts = tfirst - 1 + i; raw[i] = (ts >= 0 && ts < len) ? *(const u32x4*)(src + (size_t)ts * pitch) : (u32x4){0u, 0u, 0u, 0u}; }
}
__device__ __forceinline__ void conv4x8_load_async(const bf16_t* src, size_t pitch, int tfirst, int len, u32x4 (&raw)[6]) {
#pragma unroll
    for (int i = 0; i < 6; ++i) { const int ts = tfirst - 1 + i; const bf16_t* a = src + (size_t)ts * pitch;
        raw[i] = (u32x4){0u, 0u, 0u, 0u};
        if (ts >= 0 && ts < len) asm volatile("global_load_dwordx4 %0, %1, off" : "+v"(raw[i]) : "v"(a) : "memory"); }
}
__device__ __forceinline__ void conv4x8_compute(const u32x4 (&raw)[6], const float (&w0)[8], const float (&w1)[8], const float (&w2)[8], const float (&bb)[8], const LAS float* wrow, LAS unsigned char* dst, int dpitchB) {
    float a[8], b[8], c[8];
    unpack8(raw[0], a); unpack8(raw[1], b);
#pragma unroll
    for (int r = 0; r < 4; ++r) {
        unpack8(raw[r + 2], c);
        const float sc = 0.0625f * wrow[r];
        float o[8];
#pragma unroll
        for (int j = 0; j < 8; ++j) o[j] = silu_f(bb[j] + w0[j] * a[j] + w1[j] * b[j] + w2[j] * c[j]) * sc;
        const u32x4 pk = pack8(o);
        *(LAS u32x2*)(dst + r * dpitchB) = (u32x2){pk.x, pk.y}; *(LAS u32x2*)(dst + r * dpitchB + 32) = (u32x2){pk.z, pk.w};
#pragma unroll
        for (int j = 0; j < 8; ++j) { a[j] = b[j]; b[j] = c[j]; }
    }
}
__device__ __forceinline__ void phase_scan(const Params& p, LAS unsigned char* lds) {
    const int tid = threadIdx.x, lane = tid & 63, wid = __builtin_amdgcn_readfirstlane(tid >> 6), wm = wid >> 1, wn = wid & 1;
    LAS float* wtab = (LAS float*)(lds + SC_VEC);
    LAS float* sbl = wtab + 18 * 128;
    bf16_t* CST = (bf16_t*)(p.ws + WS_CST); float* NST = (float*)(p.ws + WS_NST); float* MST = (float*)(p.ws + WS_MST);
    const int cg = tid & 7, rb = (tid >> 3) & 31;
    const bf16x8 ones = (bf16x8){0x3f80, 0x3f80, 0x3f80, 0x3f80, 0x3f80, 0x3f80, 0x3f80, 0x3f80};
    for (int unit0 = blockIdx.x; unit0 < 256; unit0 += gridDim.x) {
        const int es = (unit0 >> 3) & 3, combo = (unit0 >> 5) * 8 + (unit0 & 7);
        const int dir = combo & 1, h = (combo >> 1) & 3, b = combo >> 3;
        const int sidx = (b * 4 + h) * 2 + dir;
        const int s0 = dir ? 127 - lane : lane, s1 = dir ? 63 - lane : 64 + lane;
        asm volatile("s_waitcnt vmcnt(0) lgkmcnt(0)" ::: "memory"); __builtin_amdgcn_s_barrier();
        LAS float* taps = sbl + 160;
        if (tid < 64) { const int ch = 1024 + h * HD + es * 64 + tid;
            taps[tid] = p.conv_w[ch]; taps[64 + tid] = p.conv_w[2048 + ch]; taps[128 + tid] = p.conv_w[4096 + ch]; taps[192 + tid] = p.conv_b[ch]; }
        u32x4 kraw[6], krb[6];
#pragma unroll
        for (int i = 0; i < 6; ++i) krb[i] = (u32x4){0u, 0u, 0u, 0u};
        {   const ScanSrc q = scan_src(p, 0, b, h, dir, es);
            scan_vdma(q, lds + SC_V0, wid, lane);
            if (tid < 256) conv4x8_load_async(q.src + q.kcol + cg * 8, q.pitch, q.t0 + rb * 4, q.len, kraw); }
        for (int st = wid; st < 18; st += 8) {
            const ScanSrc q = scan_src(p, st, b, h, dir, es);
            const float li0 = q.grow[(size_t)s0 * NGATE], lf0 = q.grow[(size_t)s0 * NGATE + 4], li1 = q.grow[(size_t)s1 * NGATE], lf1 = q.grow[(size_t)s1 * NGATE + 4];
            const float b0 = wscan_sum(lf0, lane); const float tot0 = __shfl(b0, 63, 64); const float b1 = wscan_sum(lf1, lane) + tot0; const float blast = __shfl(b1, 63, 64);
            const float a0 = blast - b0 + li0, a1 = blast - b1 + li1;
            const float mloc = wave_max(fmaxf(a0, a1));
            wtab[st * 128 + s0] = a0; wtab[st * 128 + s1] = a1;
            if (lane == 0) { sbl[st] = blast; sbl[32 + st] = mloc; }
        }
        asm volatile("s_waitcnt lgkmcnt(0)" ::: "memory"); __builtin_amdgcn_s_barrier();
        if (tid == 0) { float m = 0.f;
            for (int st = 0; st < 18; ++st) { const float bl = sbl[st], ml = sbl[32 + st]; const float mn = fmaxf(bl + m, ml); sbl[64 + st] = __expf(bl + m - mn); sbl[96 + st] = m; sbl[128 + st] = mn; m = mn; } }
        asm volatile("s_waitcnt lgkmcnt(0)" ::: "memory"); __builtin_amdgcn_s_barrier();
        for (int i = tid; i < 18 * 128; i += 512) wtab[i] = __expf(wtab[i] - sbl[128 + (i >> 7)]);
        f32x4 acc[2][4], accn[2];
#pragma unroll
        for (int n = 0; n < 2; ++n) { accn[n] = (f32x4){0.f, 0.f, 0.f, 0.f};
#pragma unroll
            for (int m = 0; m < 4; ++m) acc[n][m] = (f32x4){0.f, 0.f, 0.f, 0.f}; }
#define SCAN_STEP(step, KCUR, KNXT) do { \
            const ScanSrc q = scan_src(p, (step), b, h, dir, es); \
            if ((step) >= 3) asm volatile("s_waitcnt vmcnt(4) lgkmcnt(0)" ::: "memory"); else asm volatile("s_waitcnt vmcnt(0) lgkmcnt(0)" ::: "memory");     \
            __builtin_amdgcn_s_barrier();      \
            if (q.isx) { \
                if (wm == 0 && (lane & 15) == 0) { _Pragma("unroll") for (int n = 0; n < 2; ++n) *(f32x4*)(NST + ((size_t)sidx * 16 + q.c) * 256 + es * 64 + 32 * wn + 8 * (lane >> 4) + 4 * n) = accn[n]; } \
                if (es == 0 && tid == 0) MST[sidx * 16 + q.c] = sbl[96 + (step)]; \
            } \
            if ((step) < 17) { const ScanSrc qn = scan_src(p, (step) + 1, b, h, dir, es); scan_vdma(qn, lds + (((step) + 1) & 1 ? SC_V1 : SC_V0), wid, lane); }     \
            if ((step) < 17 && tid < 256) { const ScanSrc qn = scan_src(p, (step) + 1, b, h, dir, es); conv4x8_load_async(qn.src + qn.kcol + cg * 8, qn.pitch, qn.t0 + rb * 4, qn.len, KNXT); }     \
            asm volatile("" ::: "memory"); \
            if (q.isx) {                                                          \
                bf16_t* cdst = CST + ((size_t)sidx * 16 + q.c) * 65536 + es * 64 + 32 * wn + 8 * (lane >> 4); \
                _Pragma("unroll") for (int m = 0; m < 4; ++m) { u32x4 o; o.x = cvt_pk_bf16(acc[0][m][0], acc[0][m][1]); o.y = cvt_pk_bf16(acc[0][m][2], acc[0][m][3]); o.z = cvt_pk_bf16(acc[1][m][0], acc[1][m][1]); o.w = cvt_pk_bf16(acc[1][m][2], acc[1][m][3]); \
                        *(u32x4*)(cdst + (size_t)(64 * wm + 16 * m + (lane & 15)) * 256) = o; } \
            } \
            if (tid < 256) { float cw0[8], cw1[8], cw2[8], cbb[8]; \
                _Pragma("unroll") for (int hh = 0; hh < 2; ++hh) { const f32x4 t0 = *(const LAS f32x4*)(taps + cg * 8 + hh * 4), t1 = *(const LAS f32x4*)(taps + 64 + cg * 8 + hh * 4), t2 = *(const LAS f32x4*)(taps + 128 + cg * 8 + hh * 4), t3 = *(const LAS f32x4*)(taps + 192 + cg * 8 + hh * 4); \
                    _Pragma("unroll") for (int j = 0; j < 4; ++j) { cw0[hh * 4 + j] = t0[j]; cw1[hh * 4 + j] = t1[j]; cw2[hh * 4 + j] = t2[j]; cbb[hh * 4 + j] = t3[j]; } } \
                conv4x8_compute(KCUR, cw0, cw1, cw2, cbb, wtab + (step) * 128 + rb * 4, lds + SC_K + (rb * 4) * 144 + (cg >> 2) * 64 + (cg & 3) * 8, 144); } \
            asm volatile("s_waitcnt lgkmcnt(0)" ::: "memory"); __builtin_amdgcn_s_barrier();                 \
            const LAS unsigned char* vt = lds + (((step) & 1) ? SC_V1 : SC_V0); \
            const float so = sbl[64 + (step)]; \
            _Pragma("unroll") for (int n = 0; n < 2; ++n) { accn[n] *= so; _Pragma("unroll") for (int m = 0; m < 4; ++m) acc[n][m] *= so; } \
            _Pragma("unroll") for (int ks = 0; ks < 4; ++ks) { \
                bf16x8 af[4], bfr[2]; \
                _Pragma("unroll") for (int m = 0; m < 4; ++m) af[m] = tr_frag_swz(vt, ks * 32, 64 * wm + 16 * m, lane); \
                _Pragma("unroll") for (int n = 0; n < 2; ++n) bfr[n] = tr_frag(lds + SC_K, 144, ks * 32, 32 * wn + 16 * n, lane); \
                _Pragma("unroll") for (int n = 0; n < 2; ++n) { accn[n] = __builtin_amdgcn_mfma_f32_16x16x32_bf16(bfr[n], ones, accn[n], 0, 0, 0); \
                    _Pragma("unroll") for (int m = 0; m < 4; ++m) acc[n][m] = __builtin_amdgcn_mfma_f32_16x16x32_bf16(bfr[n], af[m], acc[n][m], 0, 0, 0); } \
            } } while (0)
#pragma unroll 1
        for (int step = 0; step < 18; step += 2) { SCAN_STEP(step, kraw, krb); SCAN_STEP(step + 1, krb, kraw); }
#undef SCAN_STEP
    }
    asm volatile("s_waitcnt vmcnt(0) lgkmcnt(0)" ::: "memory"); __builtin_amdgcn_s_barrier();
}

constexpr int MX_Q = 0, MX_K = 67584, MX_P = 100352, MX_VEC = 135168;
enum { V_GF = 0, V_GB = 128, V_MF = 256, V_MB = 384, V_SIF = 512, V_SIB = 640, V_EMF = 768, V_EMB = 896, V_RF = 1024, V_RB = 1152, V_AF = 1280, V_AB = 1408, V_DQF = 1536, V_DQB = 1664,
       V_NF = 1792, V_NB = 2048, V_RSF = 2304, V_RSB = 2816, V_END = 3328 };
__device__ __forceinline__ void mix_unit(const Params& p, LAS unsigned char* lds, int unit) {
    const int tid = threadIdx.x, lane = tid & 63, wid = __builtin_amdgcn_readfirstlane(tid >> 6), wm = wid >> 2, wn = wid & 3, lg = lane >> 4, li_ = lane & 15;
    LAS float* vec = (LAS float*)(lds + MX_VEC);
    const int c = unit & 15, h = (unit >> 4) & 3, b = unit >> 6;
    const bf16_t* P = (const bf16_t*)(p.ws + WS_P); const float* G = (const float*)(p.ws + WS_GATES);
    const bf16_t* CST = (const bf16_t*)(p.ws + WS_CST); const float* NST = (const float*)(p.ws + WS_NST); const float* MST = (const float*)(p.ws + WS_MST);
    const int sf = (b * 4 + h) * 2, sb = sf + 1;
    const int t0 = c * CHK; const size_t tok0 = (size_t)b * SEQ + t0;
    const bf16_t* srcb = P + (size_t)(b * SEQ) * PW;
    __syncthreads();
    float gq[5] = {0.f, 0.f, 0.f, 0.f, 0.f}, nfq = 0.f, nbq = 0.f;
    if (wid < 2) { const int dir = wid; const float* grow = G + tok0 * NGATE + dir * 8 + h; const int s0 = dir ? 127 - lane : lane, s1 = dir ? 63 - lane : 64 + lane;
        gq[0] = grow[(size_t)s0 * NGATE]; gq[1] = grow[(size_t)s0 * NGATE + 4]; gq[2] = grow[(size_t)s1 * NGATE]; gq[3] = grow[(size_t)s1 * NGATE + 4]; gq[4] = MST[(dir ? sb : sf) * 16 + c]; }
    if (tid < 256) { nfq = NST[((size_t)sf * 16 + c) * 256 + tid]; nbq = NST[((size_t)sb * 16 + c) * 256 + tid]; }
    { const int cg = tid & 31, rb = tid >> 5;
      u32x4 qraw[10], kraw[10];
      conv8x8_load(srcb + h * HD + cg * 8, PW, t0 + rb * 8, SEQ, qraw); conv8x8_load(srcb + 1024 + h * HD + cg * 8, PW, t0 + rb * 8, SEQ, kraw);
      conv8x8_compute(qraw, p.conv_w, p.conv_b, h * HD + cg * 8, 1.0f, lds + MX_Q + (rb * 8) * 528 + cg * 16, 528);
      conv8x8_compute(kraw, p.conv_w, p.conv_b, 1024 + h * HD + cg * 8, 0.0625f, lds + MX_K + (rb * 8) * 528 + cg * 16, 528); }
    if (tid < 256) { vec[V_NF + tid] = nfq; vec[V_NB + tid] = nbq; }
    if (wid < 2) {
        const int dir = wid;
        const int s0 = dir ? 127 - lane : lane, s1 = dir ? 63 - lane : 64 + lane;
        const float min_ = gq[4], li0 = gq[0], lf0 = gq[1], li1 = gq[2], lf1 = gq[3];
        const float b0 = wscan_sum(lf0, lane); const float tot0 = __shfl(b0, 63, 64); const float b1 = wscan_sum(lf1, lane) + tot0;
        const float g0 = li0 - b0, g1 = li1 - b1;
        const float cm0 = wscan_max(g0, lane); const float tm0 = __shfl(cm0, 63, 64); const float cm1 = fmaxf(wscan_max(g1, lane), tm0);
        const float M0 = fmaxf(min_, cm0), M1 = fmaxf(min_, cm1);
        const int o = dir * 128;
        vec[V_GF + o + s0] = g0; vec[V_GF + o + s1] = g1; vec[V_MF + o + s0] = M0; vec[V_MF + o + s1] = M1;
        vec[V_SIF + o + s0] = __expf(min_ - M0); vec[V_SIF + o + s1] = __expf(min_ - M1);
        vec[V_EMF + o + s0] = __expf(-b0 - M0); vec[V_EMF + o + s1] = __expf(-b1 - M1);
    }
    __syncthreads();
    f32x4 sacc[4][2];
#pragma unroll
    for (int m = 0; m < 4; ++m)
#pragma unroll
        for (int n = 0; n < 2; ++n) sacc[m][n] = (f32x4){0.f, 0.f, 0.f, 0.f};
#pragma unroll 2
    for (int ks = 0; ks < 8; ++ks) {
        bf16x8 af[4], bfr[2];
#pragma unroll
        for (int m = 0; m < 4; ++m) af[m] = row_frag(lds + MX_Q, 528, 64 * wm + 16 * m, ks * 32, lane);
#pragma unroll
        for (int n = 0; n < 2; ++n) bfr[n] = row_frag(lds + MX_K, 528, 32 * wn + 16 * n, ks * 32, lane);
#pragma unroll
        for (int m = 0; m < 4; ++m)
#pragma unroll
            for (int n = 0; n < 2; ++n) sacc[m][n] = __builtin_amdgcn_mfma_f32_16x16x32_bf16(af[m], bfr[n], sacc[m][n], 0, 0, 0);
    }
    {
        const int t = tid >> 2, part = tid & 3; float df = 0.f, db = 0.f;
#pragma unroll 4
        for (int i = 0; i < 8; ++i) { float f[8]; unpack8(*(const LAS u32x4*)(lds + MX_Q + t * 528 + (part * 64 + i * 8) * 2), f);
#pragma unroll
            for (int j = 0; j < 8; ++j) { df += f[j] * vec[V_NF + part * 64 + i * 8 + j]; db += f[j] * vec[V_NB + part * 64 + i * 8 + j]; } }
        df += __shfl_xor(df, 1, 64); df += __shfl_xor(df, 2, 64); db += __shfl_xor(db, 1, 64); db += __shfl_xor(db, 2, 64);
        if (part == 0) { vec[V_DQF + t] = df; vec[V_DQB + t] = db; }
    }
    f32x4 pf[4][2], pb[4][2];
    {
        float gf[2], gb[2];
#pragma unroll
        for (int n = 0; n < 2; ++n) { const int s_ = 32 * wn + 16 * n + li_; gf[n] = vec[V_GF + s_]; gb[n] = vec[V_GB + s_]; }
#pragma unroll
        for (int m = 0; m < 4; ++m)
#pragma unroll
            for (int j = 0; j < 4; ++j) {
                const int t = 64 * wm + 16 * m + 4 * lg + j; const float Mf = vec[V_MF + t], Mb = vec[V_MB + t];
                float rsf = 0.f, rsb = 0.f;
#pragma unroll
                for (int n = 0; n < 2; ++n) { const int s_ = 32 * wn + 16 * n + li_;
                    const float ef = (s_ <= t) ? __expf(fminf(gf[n] - Mf, 0.f)) : 0.f, eb = (s_ >= t) ? __expf(fminf(gb[n] - Mb, 0.f)) : 0.f;
                    const float sv = sacc[m][n][j]; pf[m][n][j] = sv * ef; pb[m][n][j] = sv * eb; rsf += pf[m][n][j]; rsb += pb[m][n][j]; }
                rsf = row16_sum(rsf); rsb = row16_sum(rsb);
                if (li_ == 0) { vec[V_RSF + t * 4 + wn] = rsf; vec[V_RSB + t * 4 + wn] = rsb; }
            }
    }
    __syncthreads();
    if (tid < 128) { const int t = tid;
        const float denf = vec[V_RSF + t * 4] + vec[V_RSF + t * 4 + 1] + vec[V_RSF + t * 4 + 2] + vec[V_RSF + t * 4 + 3] + vec[V_SIF + t] * vec[V_DQF + t];
        const float denb = vec[V_RSB + t * 4] + vec[V_RSB + t * 4 + 1] + vec[V_RSB + t * 4 + 2] + vec[V_RSB + t * 4 + 3] + vec[V_SIB + t] * vec[V_DQB + t];
        const float rf = 1.0f / fmaxf(fabsf(denf), vec[V_EMF + t]), rb = 1.0f / fmaxf(fabsf(denb), vec[V_EMB + t]);
        vec[V_RF + t] = rf; vec[V_RB + t] = rb; vec[V_AF + t] = rf * vec[V_SIF + t]; vec[V_AB + t] = rb * vec[V_SIB + t]; }
    __syncthreads();
#pragma unroll
    for (int m = 0; m < 4; ++m)
#pragma unroll
        for (int j = 0; j < 4; ++j) { const int t = 64 * wm + 16 * m + 4 * lg + j; const float rf = vec[V_RF + t], rb = vec[V_RB + t];
#pragma unroll
            for (int n = 0; n < 2; ++n) *(LAS bf16_t*)(lds + MX_P + t * 272 + (32 * wn + 16 * n + li_) * 2) = f2bf(rf * pf[m][n][j] + rb * pb[m][n][j]); }
    f32x4 acc[4][4];
    {
        const bf16_t* cqf = CST + ((size_t)sf * 16 + c) * 65536 + (size_t)(64 * wn + li_) * 256 + 8 * lg;
        const bf16_t* cqb = CST + ((size_t)sb * 16 + c) * 65536 + (size_t)(64 * wn + li_) * 256 + 8 * lg;
        bf16x8 bq0[4], bq1[4];
#pragma unroll
        for (int n = 0; n < 4; ++n) bq0[n] = *(const bf16x8*)(cqf + (size_t)(16 * n) * 256);
#pragma unroll 1
        for (int dirq = 0; dirq < 2; ++dirq) {
            f32x4 accx[4][4];
#pragma unroll
            for (int m = 0; m < 4; ++m)
#pragma unroll
                for (int n = 0; n < 4; ++n) accx[m][n] = (f32x4){0.f, 0.f, 0.f, 0.f};
            const bf16_t* cx = dirq ? cqb : cqf;
#pragma unroll 1
            for (int ks = 0; ks < 8; ks += 2) {
#pragma unroll
                for (int n = 0; n < 4; ++n) bq1[n] = *(const bf16x8*)(cx + (size_t)(16 * n) * 256 + (ks + 1) * 32);
                {   bf16x8 af[4];
#pragma unroll
                    for (int m = 0; m < 4; ++m) af[m] = row_frag(lds + MX_Q, 528, 64 * wm + 16 * m, ks * 32, lane);
#pragma unroll
                    for (int m = 0; m < 4; ++m)
#pragma unroll
                        for (int n = 0; n < 4; ++n) accx[m][n] = __builtin_amdgcn_mfma_f32_16x16x32_bf16(af[m], bq0[n], accx[m][n], 0, 0, 0); }
                {   const bf16_t* nx = ks < 6 ? cx + (ks + 2) * 32 : cqb;
#pragma unroll
                    for (int n = 0; n < 4; ++n) bq0[n] = *(const bf16x8*)(nx + (size_t)(16 * n) * 256); }
                {   bf16x8 af[4];
#pragma unroll
                    for (int m = 0; m < 4; ++m) af[m] = row_frag(lds + MX_Q, 528, 64 * wm + 16 * m, (ks + 1) * 32, lane);
#pragma unroll
                    for (int m = 0; m < 4; ++m)
#pragma unroll
                        for (int n = 0; n < 4; ++n) accx[m][n] = __builtin_amdgcn_mfma_f32_16x16x32_bf16(af[m], bq1[n], accx[m][n], 0, 0, 0); }
            }
#pragma unroll
            for (int m = 0; m < 4; ++m)
#pragma unroll
                for (int j = 0; j < 4; ++j) { const int t = 64 * wm + 16 * m + 4 * lg + j; const float a_x = vec[(dirq ? V_AB : V_AF) + t];
#pragma unroll
                    for (int n = 0; n < 4; ++n) acc[m][n][j] = dirq ? acc[m][n][j] + a_x * accx[m][n][j] : a_x * accx[m][n][j]; }
        }
    }
    u32x4 vreg[8];
#pragma unroll
    for (int i = 0; i < 8; ++i) { const int piece = tid + 512 * i; vreg[i] = *(const u32x4*)(srcb + (size_t)(t0 + (piece >> 5)) * PW + 2048 + h * HD + (piece & 31) * 8); }
    __syncthreads();
#pragma unroll
    for (int i = 0; i < 8; ++i) { const int piece = tid + 512 * i, row = piece >> 5; *(LAS u32x4*)(lds + MX_Q + row * 528 + (piece & 31) * 16) = vreg[i]; }
    __syncthreads();
#pragma unroll
    for (int ks = 0; ks < 4; ++ks) {
        bf16x8 af[4], bfr[4];
#pragma unroll
        for (int m = 0; m < 4; ++m) af[m] = row_frag(lds + MX_P, 272, 64 * wm + 16 * m, ks * 32, lane);
#pragma unroll
        for (int n = 0; n < 4; ++n) bfr[n] = tr_frag(lds + MX_Q, 528, ks * 32, 64 * wn + 16 * n, lane);
#pragma unroll
        for (int m = 0; m < 4; ++m)
#pragma unroll
            for (int n = 0; n < 4; ++n) acc[m][n] = __builtin_amdgcn_mfma_f32_16x16x32_bf16(af[m], bfr[n], acc[m][n], 0, 0, 0);
    }
    u32x4 oraw[8];
#pragma unroll
    for (int i = 0; i < 8; ++i) { const int piece = tid + 512 * i; oraw[i] = *(const u32x4*)(P + (tok0 + (piece >> 5)) * PW + 3072 + h * HD + (piece & 31) * 8); }
#pragma unroll
    for (int m = 0; m < 4; ++m)
#pragma unroll
        for (int j = 0; j < 4; ++j) { const float sm = row16_sum(acc[m][0][j] + acc[m][1][j] + acc[m][2][j] + acc[m][3][j]);
            if (li_ == 0) vec[V_RSF + (64 * wm + 16 * m + 4 * lg + j) * 4 + wn] = sm; }
    __syncthreads();
    float mu[4][4];
#pragma unroll
    for (int m = 0; m < 4; ++m)
#pragma unroll
        for (int j = 0; j < 4; ++j) { const int t = 64 * wm + 16 * m + 4 * lg + j;
            mu[m][j] = (vec[V_RSF + t * 4] + vec[V_RSF + t * 4 + 1] + vec[V_RSF + t * 4 + 2] + vec[V_RSF + t * 4 + 3]) * (1.0f / 256.0f);
            float sq = 0.f;
#pragma unroll
            for (int n = 0; n < 4; ++n) { const float dl = acc[m][n][j] - mu[m][j]; sq += dl * dl; }
            sq = row16_sum(sq);
            if (li_ == 0) vec[V_RSB + t * 4 + wn] = sq; }
    __syncthreads();
#pragma unroll
    for (int m = 0; m < 4; ++m)
#pragma unroll
        for (int j = 0; j < 4; ++j) { const int t = 64 * wm + 16 * m + 4 * lg + j;
            const float rstd = rsqrtf((vec[V_RSB + t * 4] + vec[V_RSB + t * 4 + 1] + vec[V_RSB + t * 4 + 2] + vec[V_RSB + t * 4 + 3]) * (1.0f / 256.0f) + LN_EPS);
#pragma unroll
            for (int n = 0; n < 4; ++n) *(LAS float*)(lds + (t * 260 + 64 * wn + 16 * n + li_) * 4) = (acc[m][n][j] - mu[m][j]) * rstd; }
    __syncthreads();
    bf16_t* Y = (bf16_t*)(p.ws + WS_YCAT);
#pragma unroll
    for (int i = 0; i < 8; ++i) { const int piece = tid + 512 * i, row = piece >> 5, dg = piece & 31; const int col = h * HD + dg * 8;
        float o[8]; unpack8(oraw[i], o);
        const f32x4 h0 = *(const LAS f32x4*)(lds + (row * 260 + dg * 8) * 4), h1 = *(const LAS f32x4*)(lds + (row * 260 + dg * 8 + 4) * 4);
        const f32x4 w0 = *(const f32x4*)(p.mlstm_norm_w + col), w1 = *(const f32x4*)(p.mlstm_norm_w + col + 4);
        float y[8];
#pragma unroll
        for (int j = 0; j < 4; ++j) { y[j] = h0[j] * w0[j] * sigmoid_f(o[j]); y[4 + j] = h1[j] * w1[j] * sigmoid_f(o[4 + j]); }
        *(u32x4*)(Y + (tok0 + row) * DM + col) = pack8(y); }
}

constexpr int CM_W = 0, CM_V = 34816;
__device__ __forceinline__ void cmlp_unit(const Params& p, LAS unsigned char* lds, int unit) {
    const int tid = threadIdx.x, lane = tid & 63, wid = __builtin_amdgcn_readfirstlane(tid >> 6), wm = wid >> 2, wn = wid & 3, lg = lane >> 4, li_ = lane & 15;
    const int g = unit & 3, bc = unit >> 2;
    const size_t tok0 = (size_t)bc * CHK;
    const bf16_t* P = (const bf16_t*)(p.ws + WS_P);
    __syncthreads();
#pragma unroll
    for (int i = 0; i < 8; ++i) { const int idx = tid + 512 * i, row = idx >> 5, c4 = idx & 31;
        const float4 w = *(const float4*)(p.w_s + ((size_t)g * CHK + row) * CHK + c4 * 4);
        u32x2 o; o.x = cvt_pk_bf16(w.x, w.y); o.y = cvt_pk_bf16(w.z, w.w);
        *(LAS u32x2*)(lds + CM_W + row * 272 + c4 * 8) = o; }
#pragma unroll 2
    for (int i = 0; i < 8; ++i) { const int piece = tid + 512 * i, row = piece >> 5, dg = piece & 31;
        float f[8]; unpack8(*(const u32x4*)(P + (tok0 + row) * PW + 5120 + g * 256 + dg * 8), f);
        float sm = 0.f;
#pragma unroll
        for (int j = 0; j < 8; ++j) sm += f[j];
        sm = row16_sum(sm); sm += __shfl_xor(sm, 16, 64);
        const float mu = sm * (1.0f / 256.0f); float sq = 0.f;
#pragma unroll
        for (int j = 0; j < 8; ++j) { f[j] -= mu; sq += f[j] * f[j]; }
        sq = row16_sum(sq); sq += __shfl_xor(sq, 16, 64);
        const float rstd = rsqrtf(sq * (1.0f / 256.0f) + LN_EPS);
#pragma unroll
        for (int j = 0; j < 8; ++j) f[j] = f[j] * rstd * p.cmlp_norm_w[g * 256 + dg * 8 + j];
        *(LAS u32x4*)(lds + CM_V + row * 528 + dg * 16) = pack8(f); }
    __syncthreads();
    f32x4 acc[4][4];
#pragma unroll
    for (int m = 0; m < 4; ++m)
#pragma unroll
        for (int n = 0; n < 4; ++n) acc[m][n] = (f32x4){0.f, 0.f, 0.f, 0.f};
#pragma unroll
    for (int ks = 0; ks < 4; ++ks) {
        bf16x8 af[4], bfr[4];
#pragma unroll
        for (int m = 0; m < 4; ++m) af[m] = row_frag(lds + CM_W, 272, 64 * wm + 16 * m, ks * 32, lane);
#pragma unroll
        for (int n = 0; n < 4; ++n) bfr[n] = tr_frag(lds + CM_V, 528, ks * 32, 64 * wn + 16 * n, lane);
#pragma unroll
        for (int m = 0; m < 4; ++m)
#pragma unroll
            for (int n = 0; n < 4; ++n) acc[m][n] = __builtin_amdgcn_mfma_f32_16x16x32_bf16(af[m], bfr[n], acc[m][n], 0, 0, 0);
    }
    __syncthreads();
#pragma unroll
    for (int m = 0; m < 4; ++m)
#pragma unroll
        for (int j = 0; j < 4; ++j) { const int pp = 64 * wm + 16 * m + 4 * lg + j; const float bs = p.b_s[g * CHK + pp];
#pragma unroll
            for (int n = 0; n < 4; ++n) *(LAS float*)(lds + (pp * 260 + 64 * wn + 16 * n + li_) * 4) = acc[m][n][j] + bs; }
    __syncthreads();
    bf16_t* Y = (bf16_t*)(p.ws + WS_YCAT);
#pragma unroll 2
    for (int i = 0; i < 8; ++i) { const int piece = tid + 512 * i, row = piece >> 5, dg = piece & 31;
        float u[8]; unpack8(*(const u32x4*)(P + (tok0 + row) * PW + 4096 + g * 256 + dg * 8), u);
        const f32x4 s0 = *(const LAS f32x4*)(lds + (row * 260 + dg * 8) * 4), s1 = *(const LAS f32x4*)(lds + (row * 260 + dg * 8 + 4) * 4);
        float y[8];
#pragma unroll
        for (int j = 0; j < 4; ++j) { y[j] = u[j] * s0[j]; y[4 + j] = u[4 + j] * s1[j]; }
        *(u32x4*)(Y + (tok0 + row) * DM + 1024 + g * 256 + dg * 8) = pack8(y); }
}
__device__ __forceinline__ void phase_mix(const Params& p, LAS unsigned char* lds) {
#pragma unroll 1
    for (int u = blockIdx.x; u < 512; u += gridDim.x) mix_unit(p, lds, u);
#pragma unroll 1
    for (int u = blockIdx.x; u < 512; u += gridDim.x) cmlp_unit(p, lds, u);
    __syncthreads();
}

#define XB_TMO      128
#define XB_XCNT(j)  (256  + 64 * (j))
#define XB_XSUB(j)  (1280 + 64 * (j))
#define XB_XGEN(j)  (2304 + 64 * (j))
#define XB_TOP      3328
#define XB_TOPGEN   3392
#define XCD_BAR_WORDS 3456
#define XB_SPIN_CAP (1u << 18)

__device__ __forceinline__ unsigned xb_ld(unsigned* p)              { return __hip_atomic_load(p, __ATOMIC_RELAXED, __HIP_MEMORY_SCOPE_AGENT); }
__device__ __forceinline__ unsigned xb_add(unsigned* p, unsigned v) { return __hip_atomic_fetch_add(p, v, __ATOMIC_RELAXED, __HIP_MEMORY_SCOPE_AGENT); }
__device__ __forceinline__ unsigned xb_xcc_id() { return (unsigned)__builtin_amdgcn_s_getreg((3 << 11) | 20) & 0xFu; }
#define XB_SPIN(cond, bar) do { unsigned _sp = 0; while (cond) { __builtin_amdgcn_s_sleep(1); \
    if ((++_sp & 255u) == 0u) { if (xb_ld(&(bar)[XB_TMO])) break; if (_sp > XB_SPIN_CAP) { atomicAdd(&(bar)[XB_TMO], 1u); break; } } } } while (0)

struct XcdBarrier {
    unsigned* bar; unsigned x;
    volatile LAS unsigned* st;
};
__device__ __forceinline__ XcdBarrier xcd_barrier_post(unsigned* bar, volatile LAS unsigned* st) {
    XcdBarrier b; b.bar = bar; b.x = xb_xcc_id(); b.st = st;
    if (threadIdx.x == 0) (void)xb_add(&bar[XB_XCNT(b.x)], 1u);
    return b;
}
__device__ __forceinline__ void xcd_barrier_complete(unsigned* bar, unsigned x, unsigned& nloc, unsigned& nx) {
    const unsigned G = gridDim.x * gridDim.y * gridDim.z;
    unsigned sum, cnt, mine, sp = 0u;
    for (;;) {
        sum = 0u; cnt = 0u; mine = 0u;
#pragma unroll
        for (unsigned j = 0; j < 16; ++j) { const unsigned c = xb_ld(&bar[XB_XCNT(j)]); sum += c; cnt += (c > 0u) ? 1u : 0u; mine = (j == x) ? c : mine; }
        if (sum == G) break;
        __builtin_amdgcn_s_sleep(1);
        if ((++sp & 255u) == 0u) { if (xb_ld(&bar[XB_TMO])) break; if (sp > XB_SPIN_CAP) { atomicAdd(&bar[XB_TMO], 1u); break; } }
    }
    nloc = mine > 0u ? mine : 1u; nx = cnt > 0u ? cnt : 1u;
}
__device__ __forceinline__ void xcd_barrier(const XcdBarrier& b) {
    asm volatile("s_waitcnt vmcnt(0)" ::: "memory");
    __syncthreads();
    if (threadIdx.x == 0) {
        unsigned* bar = b.bar;
        __builtin_amdgcn_s_waitcnt(0);
        unsigned nloc = b.st[0], nx = b.st[1];
        if (nloc == 0u) { xcd_barrier_complete(bar, b.x, nloc, nx); b.st[0] = nloc; b.st[1] = nx; }
        const unsigned old = xb_add(&bar[XB_XSUB(b.x)], 1u);
        const unsigned gen = old / nloc;
        if (old + 1u == (gen + 1u) * nloc) {
            __builtin_amdgcn_fence(__ATOMIC_RELEASE, "agent");
            asm volatile("s_waitcnt vmcnt(0)" ::: "memory");
            const unsigned og = xb_add(&bar[XB_TOP], 1u);
            const unsigned tg = og / nx;
            if (og + 1u == (tg + 1u) * nx) xb_add(&bar[XB_TOPGEN], 1u);
            else XB_SPIN(xb_ld(&bar[XB_TOPGEN]) == tg, bar);
            __builtin_amdgcn_fence(__ATOMIC_ACQUIRE, "agent");
            xb_add(&bar[XB_XGEN(b.x)], 1u);
            asm volatile("s_waitcnt vmcnt(0)" ::: "memory");
        } else {
            XB_SPIN(xb_ld(&bar[XB_XGEN(b.x)]) == gen, bar);
            __builtin_amdgcn_fence(__ATOMIC_ACQUIRE, "agent");
            asm volatile("s_waitcnt vmcnt(0)" ::: "memory");
        }
    }
    __syncthreads();
}

enum { PH_PREP = 0, PH_HX = 1, PH_INPROJ = 2, PH_SCAN = 3, PH_MIX = 4, PH_OUTPROJ = 5, PH_LN1 = 6, PH_MOE1 = 7, PH_MOE2 = 8, PH_FINAL = 9, PH_END = 10 };
#ifndef DUP_PHASE
#define DUP_PHASE (-1)
#endif
constexpr int CW_BAR = 256;
__global__ void __launch_bounds__(512, 2) fwd(Params p, int lo, int hi) {
    extern __shared__ __attribute__((aligned(16))) unsigned char shm[];
    LAS unsigned char* lds = (LAS unsigned char*)shm;
    if (threadIdx.x < 4) ((LAS unsigned*)(lds + LDS_MISC))[threadIdx.x] = 0u;
    __syncthreads();
    XcdBarrier bar; bar.bar = (unsigned*)(p.ws + WS_CTL) + CW_BAR; bar.x = 0; bar.st = (volatile LAS unsigned*)(lds + LDS_MISC);
    if (hi - lo > 1) bar = xcd_barrier_post((unsigned*)(p.ws + WS_CTL) + CW_BAR, (volatile LAS unsigned*)(lds + LDS_MISC));
#define IN(k) (lo <= (k) && (k) < hi)
#define SEAM(k) do { if (IN(k) && IN((k) + 1)) xcd_barrier(bar); } while (0)
#define PHASE(k, ...) do { if (IN(k)) { __VA_ARGS__; if (DUP_PHASE == (k)) { xcd_barrier(bar); __VA_ARGS__; } } SEAM(k); } while (0)
    PHASE(PH_PREP, { phase_mod(p, lds); phase_postab(p); phase_convert(p, lds, 0, gridDim.x == 256 ? CONV_ITEMS_ALL - CONV_TAIL : CONV_ITEMS_ALL, blockIdx.x, gridDim.x); });
    PHASE(PH_HX, phase_hx(p, lds));
    PHASE(PH_INPROJ, { { SchedIn S{&p}; EpiIn E{&p}; pg8::gemm_phase<true, false>(lds, DM * 2, S, E); }
        { SchedIn8 S{&p}; EpiIn E{&p}; pg8::gemm_phase<true, true>(lds, DM, S, E); }
        if (gridDim.x == 256 && blockIdx.x >= 64 && blockIdx.x < 192) {
            const int f = CONV_ITEMS_ALL - CONV_TAIL + ((int)blockIdx.x - 64) * CT_B1; phase_convert(p, lds, f, f + CT_B1, 0, 1); } });
    PHASE(PH_SCAN, phase_scan(p, lds));
    PHASE(PH_MIX, phase_mix(p, lds));
    PHASE(PH_OUTPROJ, { SchedOut S{&p}; EpiOut E{&p}; pg8::gemm_phase<false, false>(lds, DM * 2, S, E); });
    PHASE(PH_LN1, phase_ln1(p, lds));
    PHASE(PH_MOE1, { LAS int* tab = (LAS int*)(lds + LDS_TAB); moe_build_table(p, tab); SchedMoe1 S{&p, tab}; EpiMoe1 E{&p}; pg8::gemm_phase<true, true>(lds, DM, S, E); });
    PHASE(PH_MOE2, { LAS int* tab = (LAS int*)(lds + LDS_TAB); moe_build_table(p, tab); SchedMoe2 S{&p, tab}; EpiMoe2 E{&p, lds}; pg8::gemm_phase<true, true>(lds, DE, S, E); });
    PHASE(PH_FINAL, phase_final(p, lds));
#undef PHASE
#undef IN
#undef SEAM
}

#ifndef MK_N_LAUNCHES
#define MK_N_LAUNCHES 1
#endif
extern "C" void kernel_launch(void* const* d_in, const int* in_sizes, int n_in, void* d_out, int out_size, void* d_ws, size_t ws_size, hipStream_t stream) {
    static int grid = 0;
    if (grid == 0) {
        if (n_in != 26 || out_size != NTOK * DM || ws_size < WS_END) { fprintf(stderr, "kernel_launch: unexpected shapes: n_in %d out %d ws %zu (need %zu)\n", n_in, out_size, ws_size, (size_t)WS_END); grid = -1; return; }
        int dev = 0, cus = 0, per_cu = 0;
        if (hipGetDevice(&dev) != hipSuccess || hipDeviceGetAttribute(&cus, hipDeviceAttributeMultiprocessorCount, dev) != hipSuccess) { grid = -1; return; }
        if (hipFuncSetAttribute((const void*)fwd, hipFuncAttributeMaxDynamicSharedMemorySize, LDS_TOTAL) != hipSuccess) { fprintf(stderr, "kernel_launch: hipFuncSetAttribute failed\n"); grid = -1; return; }
        if (hipOccupancyMaxActiveBlocksPerMultiprocessor(&per_cu, (const void*)fwd, 512, LDS_TOTAL) != hipSuccess || per_cu < 1) { fprintf(stderr, "kernel_launch: occupancy query says %d\n", per_cu); }
        (void)hipGetLastError();
        grid = cus;
    }
    if (grid < 0) return;
    Params p{};
    const float* const* in = (const float* const*)d_in;
    p.x = in[0]; p.c = in[1]; p.ctx = in[2]; p.c_ctx = in[3]; p.w_mod = in[4]; p.b_mod = in[5]; p.w_in = in[6]; p.conv_w = in[7]; p.conv_b = in[8]; p.gate_bias = in[9];
    p.mlstm_norm_w = in[10]; p.cmlp_norm_w = in[11]; p.w_s = in[12]; p.b_s = in[13]; p.w_out = in[14]; p.ln1_w = in[15]; p.ln1_b = in[16];
    p.r1_w = in[17]; p.r1_b = in[18]; p.r2_w = in[19]; p.r2_b = in[20]; p.w_gate = in[21]; p.w_up = in[22]; p.w_down = in[23]; p.ln2_w = in[24]; p.ln2_b = in[25];
    p.out = (float*)d_out; p.ws = (unsigned char*)d_ws;
    (void)hipMemsetAsync(p.ws, 0, WS_ZERO_END, stream);
#if MK_N_LAUNCHES == 1
    fwd<<<grid, 512, LDS_TOTAL, stream>>>(p, 0, PH_END);
#else
    for (int ph = 0; ph < PH_END; ++ph) fwd<<<grid, 512, LDS_TOTAL, stream>>>(p, ph, ph + 1);
#endif
}
```

```cpp
#include <hip/hip_runtime.h>
#include <cstdio>
#include <cstdint>

typedef unsigned short bf16_t;

constexpr int DM = 2048, NB = 8, SEQ = 2048, CTXL = 256;
constexpr int NTOK = NB * SEQ;
constexpr int NCTX = NB * CTXL;
constexpr int NROWS = NTOK + NCTX;
constexpr int DIN = 6160, DML = 1024, NH = 4, HD = 256, CHK = 128;
constexpr int NGATE = 16;
constexpr int PW = 6144;
constexpr int NE = 32, DE = 1024;
constexpr int NMOD = 6;
constexpr float ALPHA = 1.189207115002721f;
constexpr float LN_EPS = 1e-6f;
constexpr int HCAP = 40960;

constexpr size_t al256(size_t x) { return (x + 255) & ~(size_t)255; }
constexpr size_t WS_CTL   = 0;
constexpr size_t CTL_BYTES = 65536;
constexpr size_t WS_MOD   = WS_CTL + CTL_BYTES;
constexpr size_t MOD_BYTES = al256((size_t)9 * NMOD * DM * 4);
constexpr size_t WS_STATS = WS_MOD + MOD_BYTES;
constexpr size_t WS_ZERO_END = WS_STATS + al256((size_t)NTOK * 2 * 4);
constexpr size_t WS_POS   = WS_ZERO_END;
constexpr size_t WS_HX    = WS_POS + al256((size_t)96 * 1024 * 4);
constexpr size_t WS_GATES = WS_HX + al256((size_t)NROWS * DM * 2);
constexpr size_t WS_P     = WS_GATES + al256((size_t)NROWS * NGATE * 4);
constexpr size_t WS_PC    = WS_P + al256((size_t)NTOK * PW * 2);
constexpr size_t WS_YCAT  = WS_PC + al256((size_t)NCTX * 2048 * 2);
constexpr size_t WS_T     = WS_YCAT;
constexpr size_t WS_X1    = WS_YCAT + al256((size_t)NTOK * DM * 2);
constexpr size_t WS_LIST  = WS_X1 + al256((size_t)NTOK * DM * 4);
constexpr size_t WS_RT    = WS_LIST + al256((size_t)NE * NTOK * 4);
constexpr size_t WS_H     = WS_P;
constexpr size_t WS_Y2    = WS_RT + al256((size_t)NTOK * 2 * 4);
constexpr size_t WS_HDIR  = WS_Y2;
constexpr size_t WS_BTIN  = WS_Y2 + al256((size_t)NTOK * 2 * DM * 2);
constexpr size_t WS_BTOUT = WS_BTIN + al256((size_t)PW * DM * 2);
constexpr size_t WS_BTGU  = WS_BTOUT + al256((size_t)DM * DM * 2);
constexpr size_t WS_BTDN  = WS_BTGU + al256((size_t)NE * 2 * DE * DM * 2);
constexpr size_t WS_NST   = WS_BTDN + al256((size_t)NE * DM * DE * 2);
constexpr size_t WS_MST   = WS_NST + al256((size_t)64 * 16 * 256 * 4);
constexpr size_t WS_CST   = WS_Y2;
constexpr size_t WS_RWT   = WS_MST + al256((size_t)64 * 16 * 4);
constexpr size_t WS_RWH   = WS_RWT + al256((size_t)36 * DM * 4);
constexpr size_t WS_HX8   = WS_RWH + al256((size_t)2 * 48 * DM * 2);
constexpr size_t WS_WGT   = WS_HX8 + al256((size_t)NTOK * DM);
constexpr size_t WS_END   = WS_WGT + al256((size_t)NGATE * DM * 4);

constexpr int CW_CNT = 0;

struct Params {
    const float *x, *c, *ctx, *c_ctx, *w_mod, *b_mod, *w_in, *conv_w, *conv_b, *gate_bias, *mlstm_norm_w, *cmlp_norm_w, *w_s, *b_s, *w_out,
                *ln1_w, *ln1_b, *r1_w, *r1_b, *r2_w, *r2_b, *w_gate, *w_up, *w_down, *ln2_w, *ln2_b;
    float* out;
    unsigned char* ws;
};

__device__ __forceinline__ bf16_t f2bf(float f) { return __builtin_bit_cast(bf16_t, (__bf16)f); }
__device__ __forceinline__ float bf2f(bf16_t b) { return __uint_as_float(((unsigned)b) << 16); }
__device__ __forceinline__ float silu_f(float x) { return x * __builtin_amdgcn_rcpf(1.0f + __expf(-x)); }
__device__ __forceinline__ float sigmoid_f(float x) { return __builtin_amdgcn_rcpf(1.0f + __expf(-x)); }
__device__ __forceinline__ float logsigmoid_f(float x) { return fminf(x, 0.0f) - log1pf(__expf(-fabsf(x))); }
__device__ __forceinline__ float gelu_tanh_f(float x) {
    const float z = 0.7978845608028654f * (x + 0.044715f * x * x * x);
    const float e = __expf(2.0f * z);
    const float th = 1.0f - 2.0f * __builtin_amdgcn_rcpf(e + 1.0f);
    return 0.5f * x * (1.0f + th);
}
__device__ __forceinline__ float wave_sum(float v) {
#pragma unroll
    for (int o = 32; o > 0; o >>= 1) v += __shfl_xor(v, o, 64);
    return v;
}
__device__ __forceinline__ float pos_val(const float* pos, int tok_in_seq, int col) {
    const int r = tok_in_seq >> 6, cc = tok_in_seq & 63;
    return col < 1024 ? pos[r * 1024 + col] : pos[32 * 1024 + cc * 1024 + (col - 1024)];
}

#define LAS __attribute__((address_space(3)))
typedef short bf16x8 __attribute__((ext_vector_type(8)));
typedef float f32x4 __attribute__((ext_vector_type(4)));
typedef unsigned u32x4 __attribute__((ext_vector_type(4)));
constexpr int LDS_STAGE = 131072;
constexpr int LDS_TOTAL = 163840;
constexpr int LDS_ROWS  = 131072;
constexpr int LDS_TAB   = 150528;
constexpr int LDS_MISC  = 163840 - 256;

typedef int i32x4 __attribute__((ext_vector_type(4)));
typedef int i32x8 __attribute__((ext_vector_type(8)));
__device__ __forceinline__ i32x8 cat8(const bf16x8 lo, const bf16x8 hi) { return __builtin_shufflevector(__builtin_bit_cast(i32x4, lo), __builtin_bit_cast(i32x4, hi), 0, 1, 2, 3, 4, 5, 6, 7); }
constexpr int F8_SCALE_W = 0x79797979;
constexpr int F8_SCALE_A = 0x7f7f7f7f;
constexpr float F8_WMUL = 64.0f;
__device__ __forceinline__ unsigned pack4_fp8(float a, float b, float c, float d) { int w = 0; w = __builtin_amdgcn_cvt_pk_fp8_f32(a, b, w, false); w = __builtin_amdgcn_cvt_pk_fp8_f32(c, d, w, true); return (unsigned)w; }
typedef float f32x2_t __attribute__((ext_vector_type(2)));
__device__ __forceinline__ void unpack8_fp8(const unsigned lo, const unsigned hi, float (&f)[8]) {
    const f32x2_t a = __builtin_amdgcn_cvt_pk_f32_fp8((int)lo, false), b = __builtin_amdgcn_cvt_pk_f32_fp8((int)lo, true), c = __builtin_amdgcn_cvt_pk_f32_fp8((int)hi, false), d = __builtin_amdgcn_cvt_pk_f32_fp8((int)hi, true);
    f[0] = a[0]; f[1] = a[1]; f[2] = b[0]; f[3] = b[1]; f[4] = c[0]; f[5] = c[1]; f[6] = d[0]; f[7] = d[1];
}
typedef _Float16 h16x2 __attribute__((ext_vector_type(2)));
__device__ __forceinline__ unsigned pack2_h16(float a, float b) { h16x2 h; h.x = (_Float16)a; h.y = (_Float16)b; return __builtin_bit_cast(unsigned, h); }
__device__ __forceinline__ void unpack2_h16(unsigned w, float& a, float& b) { const h16x2 h = __builtin_bit_cast(h16x2, w); a = (float)h.x; b = (float)h.y; }
typedef unsigned u32x2 __attribute__((ext_vector_type(2)));
typedef __bf16 bf16x2_t __attribute__((ext_vector_type(2)));
typedef float f32x2v_t __attribute__((ext_vector_type(2)));
__device__ __forceinline__ unsigned cvt_pk_bf16(float lo, float hi) { const f32x2v_t v = {lo, hi}; return __builtin_bit_cast(unsigned, __builtin_convertvector(v, bf16x2_t)); }
__device__ __forceinline__ void unpack8(const u32x4 v, float (&f)[8]) {
    f[0] = __uint_as_float(v.x << 16); f[1] = __uint_as_float(v.x & 0xffff0000u); f[2] = __uint_as_float(v.y << 16); f[3] = __uint_as_float(v.y & 0xffff0000u);
    f[4] = __uint_as_float(v.z << 16); f[5] = __uint_as_float(v.z & 0xffff0000u); f[6] = __uint_as_float(v.w << 16); f[7] = __uint_as_float(v.w & 0xffff0000u);
}
__device__ __forceinline__ u32x4 pack8(const float (&f)[8]) { u32x4 w; w.x = cvt_pk_bf16(f[0], f[1]); w.y = cvt_pk_bf16(f[2], f[3]); w.z = cvt_pk_bf16(f[4], f[5]); w.w = cvt_pk_bf16(f[6], f[7]); return w; }


__device__ __forceinline__ void phase_mod(const Params& p, LAS unsigned char* lds) {
    LAS float* sc = (LAS float*)lds;
    LAS float* red = sc + 9 * 128;
    float* MOD = (float*)(p.ws + WS_MOD);
    const int tid = threadIdx.x;
    for (int item = blockIdx.x; item < 768; item += gridDim.x) {
        const int cb = item % 48, kb = item / 48;
        __syncthreads();
        for (int i = tid; i < 9 * 128; i += 512) {
            const int r = i / 128, k = i % 128;
            const float v = r < 8 ? p.c[r * DM + kb * 128 + k] : p.c_ctx[kb * 128 + k];
            sc[r * 128 + k] = silu_f(v);
        }
        __syncthreads();
        const int col = cb * 256 + (tid & 255), kh = tid >> 8;
        float acc[9];
#pragma unroll
        for (int r = 0; r < 9; ++r) acc[r] = 0.f;
        const float* wp = p.w_mod + (size_t)(kb * 128 + kh * 64) * (NMOD * DM) + col;
#pragma unroll 8
        for (int k = 0; k < 64; ++k) {
            const float w = wp[(size_t)k * (NMOD * DM)];
#pragma unroll
            for (int r = 0; r < 9; ++r) acc[r] += sc[r * 128 + kh * 64 + k] * w;
        }
        if (kh == 1) {
#pragma unroll
            for (int r = 0; r < 9; ++r) red[(tid & 255) * 9 + r] = acc[r];
        }
        __syncthreads();
        if (kh == 0) {
            const float bias = kb == 0 ? p.b_mod[col] : 0.f;
#pragma unroll
            for (int r = 0; r < 9; ++r) atomicAdd(&MOD[r * (NMOD * DM) + col], acc[r] + red[tid * 9 + r] + bias);
        }
    }
    __syncthreads();
}
__device__ __forceinline__ void phase_postab(const Params& p) {
    float* pos = (float*)(p.ws + WS_POS);
    for (int i = blockIdx.x * 512 + threadIdx.x; i < 96 * 1024; i += gridDim.x * 512) {
        const int row = i / 1024, j = i % 1024, jj = j & 511;
        const float omega = 1.0f / powf(10000.0f, (float)jj / 512.0f);
        const float pv = row < 32 ? (float)row : (float)(row - 32);
        const float a = pv * omega;
        pos[i] = j < 512 ? sinf(a) : cosf(a);
    }
    float* rwt = (float*)(p.ws + WS_RWT);
    for (int i = blockIdx.x * 512 + threadIdx.x; i < 36 * DM; i += gridDim.x * 512) {
        const int k = i / 36, j = i % 36;
        rwt[j * DM + k] = j < 4 ? p.r1_w[k * 4 + j] : p.r2_w[k * 32 + (j - 4)];
    }
    bf16_t* rwh = (bf16_t*)(p.ws + WS_RWH);
    for (int i = blockIdx.x * 512 + threadIdx.x; i < 48 * DM; i += gridDim.x * 512) {
        const int j = i / DM, k = i % DM;
        const float w = j < 4 ? p.r1_w[k * 4 + j] : j < 36 ? p.r2_w[k * 32 + (j - 4)] : 0.f;
        const bf16_t hi = f2bf(w); const bf16_t lo = f2bf(w - bf2f(hi));
        rwh[i] = hi; rwh[48 * DM + i] = lo;
    }
    float* wgt = (float*)(p.ws + WS_WGT);
    for (int i = blockIdx.x * 512 + threadIdx.x; i < NGATE * DM; i += gridDim.x * 512) { const int k = i >> 4, g = i & 15; wgt[g * DM + k] = p.w_in[(size_t)k * DIN + 4096 + g]; }
}

#define GLDS16(gptr, lptr) __builtin_amdgcn_global_load_lds((const unsigned*)(gptr), (LAS unsigned*)(lptr), 16, 0, 0)
constexpr int HXB = 68 * 256;
__device__ __forceinline__ void hx_stage(const Params& p, LAS float* ldsf, int buf, int chunk, int rowb, int wid, int lane) {
    const float* MOD = (const float*)(p.ws + WS_MOD); const float* pos = (const float*)(p.ws + WS_POS); const float* wgt = (const float*)(p.ws + WS_WGT);
    LAS float* xb = ldsf + buf * HXB; LAS float* pb = xb + 24 * 256; LAS float* mb = xb + 48 * 256; LAS float* wb = xb + 52 * 256;
    const int co = chunk * 256 + lane * 4;
#pragma unroll
    for (int r = 0; r < 3; ++r) { const int row = rowb + wid * 3 + r; const bool isx = row < NTOK; const int ts = row % SEQ;
        GLDS16((isx ? p.x + (size_t)row * DM : p.ctx + (size_t)(row - NTOK) * DM) + co, xb + (wid * 3 + r) * 256);
        if (isx) GLDS16((chunk < 4 ? pos + (ts >> 6) * 1024 : pos + 32 * 1024 + (ts & 63) * 1024 - 1024) + co, pb + (wid * 3 + r) * 256); }
    if (wid < 4) { const int row = (wid & 2) ? rowb + 23 : rowb; const int b = row < NTOK ? row / SEQ : 8;
        GLDS16(MOD + (size_t)b * (NMOD * DM) + ((wid & 1) ? 0 : DM) + co, mb + wid * 256); }
    for (int j = wid; j < 16; j += 8) GLDS16(wgt + (size_t)j * DM + co, wb + j * 256);
}
__device__ __forceinline__ void phase_hx(const Params& p, LAS unsigned char* lds) {
    bf16_t* HX = (bf16_t*)(p.ws + WS_HX); unsigned char* HX8 = (unsigned char*)(p.ws + WS_HX8);
    float* G = (float*)(p.ws + WS_GATES);
    LAS float* ldsf = (LAS float*)lds;
    const int tid = threadIdx.x, lane = tid & 63, wid = __builtin_amdgcn_readfirstlane(tid >> 6);
    for (int bt = blockIdx.x; bt < NROWS / 24; bt += gridDim.x) {
        const int rowb = bt * 24, row0 = rowb + wid * 3;
        const int bfirst = rowb < NTOK ? rowb / SEQ : 8;
        bool isx[3]; int pset[3];
#pragma unroll
        for (int r = 0; r < 3; ++r) { const int row = row0 + r; isx[r] = row < NTOK; pset[r] = ((row < NTOK ? row / SEQ : 8) != bfirst) ? 2 : 0; }
        float acc[3][NGATE];
#pragma unroll
        for (int r = 0; r < 3; ++r)
#pragma unroll
            for (int g = 0; g < NGATE; ++g) acc[r][g] = 0.f;
        asm volatile("s_waitcnt vmcnt(0) lgkmcnt(0)" ::: "memory"); __builtin_amdgcn_s_barrier();
        hx_stage(p, ldsf, 0, 0, rowb, wid, lane);
#pragma unroll 1
        for (int chunk = 0; chunk < 8; ++chunk) {
            asm volatile("s_waitcnt vmcnt(0) lgkmcnt(0)" ::: "memory"); __builtin_amdgcn_s_barrier();
            if (chunk < 7) hx_stage(p, ldsf, (chunk + 1) & 1, chunk + 1, rowb, wid, lane);
            const LAS float* xb = ldsf + (chunk & 1) * HXB + lane * 4; const LAS float* pb = xb + 24 * 256; const LAS float* mb = xb + 48 * 256; const LAS float* wb = xb + 52 * 256;
            const int col = chunk * 256 + lane * 4;
            f32x4 hv[3];
#pragma unroll
            for (int r = 0; r < 3; ++r) { f32x4 v = *(const LAS f32x4*)(xb + (wid * 3 + r) * 256);
                if (isx[r]) v += *(const LAS f32x4*)(pb + (wid * 3 + r) * 256);
                hv[r] = v * (*(const LAS f32x4*)(mb + pset[r] * 256) + 1.0f) + *(const LAS f32x4*)(mb + (pset[r] + 1) * 256);
                u32x2 o; o.x = cvt_pk_bf16(hv[r][0], hv[r][1]); o.y = cvt_pk_bf16(hv[r][2], hv[r][3]);
                *(u32x2*)(HX + (size_t)(row0 + r) * DM + col) = o;
                if (isx[r]) *(unsigned*)(HX8 + (size_t)(row0 + r) * DM + col) = pack4_fp8(hv[r][0], hv[r][1], hv[r][2], hv[r][3]); }
#pragma unroll
            for (int g = 0; g < NGATE; ++g) { const f32x4 w = *(const LAS f32x4*)(wb + g * 256);
#pragma unroll
                for (int r = 0; r < 3; ++r) acc[r][g] += hv[r][0] * w[0] + hv[r][1] * w[1] + hv[r][2] * w[2] + hv[r][3] * w[3]; }
        }
        {
            float v24[24], v12[12], v6[6];
            const bool h5 = lane & 32, h4 = lane & 16, h3 = lane & 8, h2 = lane & 4;
#pragma unroll
            for (int f = 0; f < 24; ++f) { const float lo = acc[f / 16][f % 16], hi = acc[(f + 24) / 16][(f + 24) % 16]; v24[f] = (h5 ? hi : lo) + __shfl_xor(h5 ? lo : hi, 32, 64); }
#pragma unroll
            for (int f = 0; f < 12; ++f) v12[f] = (h4 ? v24[f + 12] : v24[f]) + __shfl_xor(h4 ? v24[f] : v24[f + 12], 16, 64);
#pragma unroll
            for (int f = 0; f < 6; ++f) v6[f] = (h3 ? v12[f + 6] : v12[f]) + __shfl_xor(h3 ? v12[f] : v12[f + 6], 8, 64);
            const int f0 = (h5 ? 24 : 0) + (h4 ? 12 : 0) + (h3 ? 6 : 0) + (h2 ? 3 : 0);
#pragma unroll
            for (int f = 0; f < 3; ++f) { float x = (h2 ? v6[f + 3] : v6[f]) + __shfl_xor(h2 ? v6[f] : v6[f + 3], 4, 64); x += __shfl_xor(x, 2, 64); x += __shfl_xor(x, 1, 64);
                if ((lane & 3) == 0) { const int ff = f0 + f, r = ff >> 4, g = ff & 15; float v = x + p.gate_bias[g]; if ((g >> 2) & 1) v = logsigmoid_f(v); G[(size_t)(row0 + r) * NGATE + g] = v; } }
        }
    }
    asm volatile("s_waitcnt vmcnt(0) lgkmcnt(0)" ::: "memory"); __builtin_amdgcn_s_barrier();
}

constexpr int L1_X = 0, L1_P = 16384, L1_W = 16384 + 4096, L1_BUF = L1_W + 2 * 24576, L1_RED = 2 * L1_BUF;
constexpr int L1_LG = L1_RED;
__device__ __forceinline__ void ln1_stage(const Params& p, LAS unsigned char* lds, int buf, int chunk, int tokb, int b, int wid, int lane) {
    const bf16_t* X1 = (const bf16_t*)(p.ws + WS_X1); const bf16_t* RW = (const bf16_t*)(p.ws + WS_RWH); const float* MOD = (const float*)(p.ws + WS_MOD);
    LAS unsigned char* base = lds + buf * L1_BUF;
#pragma unroll
    for (int r2 = 0; r2 < 2; ++r2) { const int row = wid * 4 + 2 * r2 + (lane >> 5); const int gc = (lane & 31) ^ (row & 31);
        GLDS16(X1 + (size_t)(tokb + row) * DM + chunk * 256 + gc * 8, base + L1_X + (wid * 4 + 2 * r2) * 512); }
#pragma unroll
    for (int q = 0; q < 6; ++q) { const int rr = (wid * 6 + q) * 2 + (lane >> 5); const int n = rr % 48; const int gc = (lane & 31) ^ (n & 31);
        GLDS16(RW + (size_t)rr * DM + chunk * 256 + gc * 8, base + L1_W + (wid * 6 + q) * 1024); }
    const int cf = chunk * 256 + lane * 4;
    if (wid == 4) GLDS16(p.ln1_w + cf, base + L1_P);
    if (wid == 5) GLDS16(p.ln1_b + cf, base + L1_P + 1024);
    if (wid == 6) GLDS16(MOD + (size_t)b * (NMOD * DM) + 4 * DM + cf, base + L1_P + 2048);
    if (wid == 7) GLDS16(MOD + (size_t)b * (NMOD * DM) + 3 * DM + cf, base + L1_P + 3072);
}
__device__ __forceinline__ void phase_ln1(const Params& p, LAS unsigned char* lds) {
    const float* ST = (const float*)(p.ws + WS_STATS);
    unsigned char* T = (unsigned char*)(p.ws + WS_T);
    unsigned* cnt = (unsigned*)(p.ws + WS_CTL) + CW_CNT;
    int* list = (int*)(p.ws + WS_LIST);
    float* RT = (float*)(p.ws + WS_RT);
    LAS float* ldsf = (LAS float*)lds;
    const int tid = threadIdx.x, lane = tid & 63, wid = __builtin_amdgcn_readfirstlane(tid >> 6), li_ = lane & 15, lg = lane >> 4;
    for (int rb = blockIdx.x; rb < NTOK / 32; rb += gridDim.x) {
        const int tokb = rb * 32, b = tokb / SEQ, row0 = tokb + wid * 4;
        float mean[2], rstd[2];
#pragma unroll
        for (int m = 0; m < 2; ++m) { const float s1 = ST[(size_t)(tokb + 16 * m + li_) * 2], s2 = ST[(size_t)(tokb + 16 * m + li_) * 2 + 1];
            mean[m] = s1 * (1.0f / DM); rstd[m] = rsqrtf(fmaxf(s2 * (1.0f / DM) - mean[m] * mean[m], 0.f) + LN_EPS); }
        f32x4 acc[2][3];
#pragma unroll
        for (int m = 0; m < 2; ++m)
#pragma unroll
            for (int n = 0; n < 3; ++n) acc[m][n] = (f32x4){0.f, 0.f, 0.f, 0.f};
        asm volatile("s_waitcnt vmcnt(0) lgkmcnt(0)" ::: "memory"); __builtin_amdgcn_s_barrier();
        ln1_stage(p, lds, 0, 0, tokb, b, wid, lane);
#pragma unroll 1
        for (int chunk = 0; chunk < 8; ++chunk) {
            asm volatile("s_waitcnt vmcnt(0) lgkmcnt(0)" ::: "memory"); __builtin_amdgcn_s_barrier();
            if (chunk < 7) ln1_stage(p, lds, (chunk + 1) & 1, chunk + 1, tokb, b, wid, lane);
            const LAS unsigned char* base = lds + (chunk & 1) * L1_BUF;
            const int kc = 4 * wid + lg;
            const LAS float* pp = (const LAS float*)(base + L1_P) + kc * 8;
            const f32x4 lw0 = *(const LAS f32x4*)(pp), lw1 = *(const LAS f32x4*)(pp + 4), lb0 = *(const LAS f32x4*)(pp + 256), lb1 = *(const LAS f32x4*)(pp + 260);
            const f32x4 sc0 = *(const LAS f32x4*)(pp + 512) + 1.0f, sc1 = *(const LAS f32x4*)(pp + 516) + 1.0f, sh0 = *(const LAS f32x4*)(pp + 768), sh1 = *(const LAS f32x4*)(pp + 772);
            bf16x8 ahi[2], alo[2];
#pragma unroll
            for (int m = 0; m < 2; ++m) { const int row = 16 * m + li_;
                const u32x4 xw = *(const LAS u32x4*)(base + L1_X + row * 512 + ((kc ^ (row & 31)) << 4));
                float x[8]; unpack2_h16(xw.x, x[0], x[1]); unpack2_h16(xw.y, x[2], x[3]); unpack2_h16(xw.z, x[4], x[5]); unpack2_h16(xw.w, x[6], x[7]);
                float t[8];
#pragma unroll
                for (int j = 0; j < 4; ++j) { t[j] = ((x[j] - mean[m]) * rstd[m] * lw0[j] + lb0[j]) * sc0[j] + sh0[j]; t[4 + j] = ((x[4 + j] - mean[m]) * rstd[m] * lw1[j] + lb1[j]) * sc1[j] + sh1[j]; }
                u32x2 tw; tw.x = pack4_fp8(t[0], t[1], t[2], t[3]); tw.y = pack4_fp8(t[4], t[5], t[6], t[7]);
                *(u32x2*)(T + (size_t)(tokb + row) * DM + chunk * 256 + kc * 8) = tw;
                u32x4 hw, lw_; float r_[8];
                hw.x = cvt_pk_bf16(t[0], t[1]); hw.y = cvt_pk_bf16(t[2], t[3]); hw.z = cvt_pk_bf16(t[4], t[5]); hw.w = cvt_pk_bf16(t[6], t[7]);
                unpack8(hw, r_);
#pragma unroll
                for (int j = 0; j < 8; ++j) r_[j] = t[j] - r_[j];
                lw_.x = cvt_pk_bf16(r_[0], r_[1]); lw_.y = cvt_pk_bf16(r_[2], r_[3]); lw_.z = cvt_pk_bf16(r_[4], r_[5]); lw_.w = cvt_pk_bf16(r_[6], r_[7]);
                ahi[m] = __builtin_bit_cast(bf16x8, hw); alo[m] = __builtin_bit_cast(bf16x8, lw_); }
#pragma unroll
            for (int n = 0; n < 3; ++n) { const int rown = 16 * n + li_;
                const bf16x8 bhi = *(const LAS bf16x8*)(base + L1_W + rown * 512 + ((kc ^ (rown & 31)) << 4));
                const bf16x8 blo = *(const LAS bf16x8*)(base + L1_W + 24576 + rown * 512 + ((kc ^ (rown & 31)) << 4));
#pragma unroll
                for (int m = 0; m < 2; ++m) {
                    acc[m][n] = __builtin_amdgcn_mfma_f32_16x16x32_bf16(ahi[m], bhi, acc[m][n], 0, 0, 0);
                    acc[m][n] = __builtin_amdgcn_mfma_f32_16x16x32_bf16(ahi[m], blo, acc[m][n], 0, 0, 0);
                    acc[m][n] = __builtin_amdgcn_mfma_f32_16x16x32_bf16(alo[m], bhi, acc[m][n], 0, 0, 0); } }
        }
        asm volatile("s_waitcnt vmcnt(0) lgkmcnt(0)" ::: "memory"); __builtin_amdgcn_s_barrier();
        {   LAS float* red = (LAS float*)lds + wid * (32 * 48);
#pragma unroll
            for (int m = 0; m < 2; ++m)
#pragma unroll
                for (int n = 0; n < 3; ++n)
#pragma unroll
                    for (int j = 0; j < 4; ++j) red[(16 * m + 4 * lg + j) * 48 + 16 * n + li_] = acc[m][n][j]; }
        asm volatile("s_waitcnt lgkmcnt(0)" ::: "memory"); __builtin_amdgcn_s_barrier();
        LAS float* lgt = (LAS float*)(lds + L1_LG);
        for (int i = tid; i < 32 * 36; i += 512) { const int tkn = i / 36, j = i % 36; float sum = 0.f;
#pragma unroll
            for (int w = 0; w < 8; ++w) sum += ((const LAS float*)lds)[w * (32 * 48) + tkn * 48 + j];
            lgt[i] = sum; }
        asm volatile("s_waitcnt lgkmcnt(0)" ::: "memory"); __builtin_amdgcn_s_barrier();
        LAS int* esel = (LAS int*)(lds + L1_LG + 32 * 36 * 4);
        if (lane < 4) {
            const int tok = row0 + lane;
            const LAS float* lg = lgt + (wid * 4 + lane) * 36;
            int grp = 0; float l1[4];
#pragma unroll
            for (int j = 0; j < 4; ++j) l1[j] = lg[j] + p.r1_b[j];
            float best = l1[0];
#pragma unroll
            for (int j = 1; j < 4; ++j) if (l1[j] > best) { best = l1[j]; grp = j; }
            float se = 0.f;
#pragma unroll
            for (int j = 0; j < 4; ++j) se += __expf(l1[j] - best);
            const float pg = 1.0f / se;
            float v0 = -3.0e38f, v1 = -3.0e38f; int i0 = 0, i1 = 0;
#pragma unroll
            for (int j = 0; j < 8; ++j) {
                const float l = lg[4 + grp * 8 + j] + p.r2_b[grp * 8 + j];
                if (l > v0) { v1 = v0; i1 = i0; v0 = l; i0 = j; } else if (l > v1) { v1 = l; i1 = j; }
            }
            const float ex = __expf(v1 - v0);
            RT[tok * 2 + 0] = pg / (1.0f + ex); RT[tok * 2 + 1] = pg * ex / (1.0f + ex);
            esel[(wid * 4 + lane) * 2 + 0] = grp * 8 + i0; esel[(wid * 4 + lane) * 2 + 1] = grp * 8 + i1;
        }
        asm volatile("s_waitcnt lgkmcnt(0)" ::: "memory"); __builtin_amdgcn_s_barrier();
        if (tid < 32) {
            int c = 0;
            for (int i = 0; i < 64; ++i) c += (esel[i] == tid) ? 1 : 0;
            esel[64 + tid] = c > 0 ? (int)atomicAdd(&cnt[tid], (unsigned)c) : 0;
        }
        asm volatile("s_waitcnt vmcnt(0) lgkmcnt(0)" ::: "memory"); __builtin_amdgcn_s_barrier();
        if (tid < 64) {
            const int e = esel[tid]; int lr = 0;
            for (int i = 0; i < tid; ++i) lr += (esel[i] == e) ? 1 : 0;
            list[(size_t)e * NTOK + esel[64 + e] + lr] = (rb * 32 + (tid >> 1)) * 2 + (tid & 1);
        }
    }
    asm volatile("s_waitcnt vmcnt(0) lgkmcnt(0)" ::: "memory"); __builtin_amdgcn_s_barrier();
}

struct FinRaw { u32x2 ya[4], yb[4]; u32x4 x[4]; u32x2 g, st; };
__device__ __forceinline__ void fin_request(const Params& p, int tok, int lane, FinRaw& r) {
    const bf16_t* X1 = (const bf16_t*)(p.ws + WS_X1); const unsigned char* Y2 = (const unsigned char*)(p.ws + WS_Y2);
    const float* RT = (const float*)(p.ws + WS_RT); const float* ST = (const float*)(p.ws + WS_STATS);
#pragma unroll
    for (int i = 0; i < 4; ++i) { const int col = i * 512 + lane * 8;
        const unsigned char* a0 = Y2 + (size_t)(tok * 2) * DM + col; const unsigned char* a1 = a0 + DM; const bf16_t* a2 = X1 + (size_t)tok * DM + col;
        asm volatile("global_load_dwordx2 %0, %1, off" : "=v"(r.ya[i]) : "v"(a0) : "memory");
        asm volatile("global_load_dwordx2 %0, %1, off" : "=v"(r.yb[i]) : "v"(a1) : "memory");
        asm volatile("global_load_dwordx4 %0, %1, off" : "=v"(r.x[i]) : "v"(a2) : "memory"); }
    { const float* a3 = RT + tok * 2; const float* a4 = ST + (size_t)tok * 2;
      asm volatile("global_load_dwordx2 %0, %1, off" : "=v"(r.g) : "v"(a3) : "memory");
      asm volatile("global_load_dwordx2 %0, %1, off" : "=v"(r.st) : "v"(a4) : "memory"); }
}
__device__ __forceinline__ void phase_final(const Params& p, LAS unsigned char* lds) {
    const float* MOD = (const float*)(p.ws + WS_MOD);
    const int tid = threadIdx.x, lane = tid & 63, wid = __builtin_amdgcn_readfirstlane(tid >> 6);
    LAS float* PRM = (LAS float*)lds;
    LAS float* GT = PRM + 4 * DM;
    asm volatile("s_waitcnt vmcnt(0) lgkmcnt(0)" ::: "memory"); __builtin_amdgcn_s_barrier();
    {   const int col = tid * 4; const int pidx = (((col >> 9) * 2 + ((col >> 2) & 1)) * 64 + ((col & 511) >> 3)) * 4;
        *(LAS f32x4*)(PRM + pidx) = *(const f32x4*)(p.ln1_w + col) * ALPHA; *(LAS f32x4*)(PRM + DM + pidx) = *(const f32x4*)(p.ln1_b + col) * ALPHA;
        *(LAS f32x4*)(PRM + 2 * DM + pidx) = *(const f32x4*)(p.ln2_w + col); *(LAS f32x4*)(PRM + 3 * DM + pidx) = *(const f32x4*)(p.ln2_b + col);
#pragma unroll
        for (int b = 0; b < NB; ++b) *(LAS f32x4*)(GT + b * DM + pidx) = *(const f32x4*)(MOD + (size_t)b * (NMOD * DM) + 5 * DM + col);
    }
    asm volatile("s_waitcnt vmcnt(0) lgkmcnt(0)" ::: "memory"); __builtin_amdgcn_s_barrier();
    const int stride = gridDim.x * 8;
    int tok = blockIdx.x * 8 + wid;
    if (tok >= NTOK) return;
    FinRaw r; fin_request(p, tok, lane, r);
    bool first = true;
#pragma unroll 1
    for (; tok < NTOK; tok += stride) {
        if (first) asm volatile("s_waitcnt vmcnt(0)" ::: "memory"); else asm volatile("s_waitcnt vmcnt(8)" ::: "memory");
        first = false;
        const LAS float* gt = GT + (tok / SEQ) * DM;
        const unsigned ug0 = r.g.x, ug1 = r.g.y, us1 = r.st.x, us2 = r.st.y;
        const float g0 = __uint_as_float(ug0) * 0.0625f, g1 = __uint_as_float(ug1) * 0.0625f;
        const float st1 = __uint_as_float(us1), st2 = __uint_as_float(us2);
        const float mean1 = st1 * (1.0f / DM), rstd1 = rsqrtf(fmaxf(st2 * (1.0f / DM) - mean1 * mean1, 0.f) + LN_EPS);
        float v[32]; float s = 0.f;
#pragma unroll
        for (int i = 0; i < 4; ++i) {
            float ya[8], yb[8]; unpack8_fp8(r.ya[i].x, r.ya[i].y, ya); unpack8_fp8(r.yb[i].x, r.yb[i].y, yb);
            float xr[8]; unpack2_h16(r.x[i].x, xr[0], xr[1]); unpack2_h16(r.x[i].y, xr[2], xr[3]); unpack2_h16(r.x[i].z, xr[4], xr[5]); unpack2_h16(r.x[i].w, xr[6], xr[7]);
            const int o0 = (i * 2 * 64 + lane) * 4, o1 = o0 + 256;
            const f32x4 xa = ((f32x4){xr[0], xr[1], xr[2], xr[3]} - mean1) * rstd1 * *(const LAS f32x4*)(PRM + o0) + *(const LAS f32x4*)(PRM + DM + o0);
            const f32x4 xb = ((f32x4){xr[4], xr[5], xr[6], xr[7]} - mean1) * rstd1 * *(const LAS f32x4*)(PRM + o1) + *(const LAS f32x4*)(PRM + DM + o1);
            const f32x4 ga = *(const LAS f32x4*)(gt + o0), gb = *(const LAS f32x4*)(gt + o1);
#pragma unroll
            for (int j = 0; j < 4; ++j) { v[i * 8 + j] = xa[j] + ga[j] * (g0 * ya[j] + g1 * yb[j]); v[i * 8 + 4 + j] = xb[j] + gb[j] * (g0 * ya[4 + j] + g1 * yb[4 + j]); }
#pragma unroll
            for (int j = 0; j < 8; ++j) s += v[i * 8 + j];
        }
        {   const int tn = tok + stride < NTOK ? tok + stride : tok;
            fin_request(p, tn, lane, r); }
        const float mu = wave_sum(s) * (1.0f / DM);
        float q = 0.f;
#pragma unroll
        for (int i = 0; i < 32; ++i) { const float dlt = v[i] - mu; q += dlt * dlt; }
        const float rstd = rsqrtf(wave_sum(q) * (1.0f / DM) + LN_EPS);
#pragma unroll
        for (int i = 0; i < 4; ++i) {
            const int col = i * 512 + lane * 8;
            const int o0 = (i * 2 * 64 + lane) * 4, o1 = o0 + 256;
            const f32x4 wa = *(const LAS f32x4*)(PRM + 2 * DM + o0), wb = *(const LAS f32x4*)(PRM + 2 * DM + o1), ba = *(const LAS f32x4*)(PRM + 3 * DM + o0), bb = *(const LAS f32x4*)(PRM + 3 * DM + o1);
            f32x4 oa, ob;
#pragma unroll
            for (int j = 0; j < 4; ++j) { oa[j] = (v[i * 8 + j] - mu) * rstd * wa[j] + ba[j]; ob[j] = (v[i * 8 + 4 + j] - mu) * rstd * wb[j] + bb[j]; }
            *(f32x4*)(p.out + (size_t)tok * DM + col) = oa; *(f32x4*)(p.out + (size_t)tok * DM + col + 4) = ob;
        }
    }
    asm volatile("s_waitcnt vmcnt(0)" ::: "memory");
}

__device__ __forceinline__ void conv_item_src(const Params& p, int item, const float*& src, int& ld, unsigned char*& dst, int& K, bool& f8) {
    f8 = false;
    if (item < 1536) {
        const int nt = item % 48, kt = item / 48; const int n0 = nt * 128, sc = n0 < 4096 ? n0 : n0 + NGATE;
        ld = DIN; K = DM; src = p.w_in + (size_t)(kt * 64) * DIN + sc;
        if (n0 >= 3072 && n0 < 4096) { dst = (unsigned char*)(p.ws + WS_BTIN) + (size_t)3072 * DM * 2 + (size_t)(n0 - 3072) * DM + kt * 64; f8 = true; }
        else if (n0 >= 5120) { dst = (unsigned char*)(p.ws + WS_BTIN) + (size_t)5120 * DM * 2 + (size_t)(n0 - 5120) * DM + kt * 64; f8 = true; }
        else dst = (unsigned char*)(p.ws + WS_BTIN) + ((size_t)n0 * DM + kt * 64) * 2;
        return;
    }
    item -= 1536;
    if (item < 512) {
        const int nt = item % 16, kt = item / 16;
        ld = DM; K = DM; src = p.w_out + (size_t)(kt * 64) * DM + nt * 128; dst = (unsigned char*)(p.ws + WS_BTOUT) + ((size_t)(nt * 128) * DM + kt * 64) * 2; return;
    }
    item -= 512;
    if (item < 16384) {
        const int kt = item & 31, pn = (item >> 5) & 7, which = (item >> 8) & 1, e = item >> 9;
        ld = DE; K = DM; src = (which ? p.w_up : p.w_gate) + (size_t)e * DM * DE + (size_t)(kt * 64) * DE + pn * 128;
        dst = (unsigned char*)(p.ws + WS_BTGU) + ((size_t)(e * 8 + pn) * 256 + which * 128) * DM + kt * 64; f8 = true; return;
    }
    item -= 16384;
    {
        const int kt = item & 15, nt = (item >> 4) & 15, e = item >> 8;
        ld = DM; K = DE; src = p.w_down + (size_t)e * DE * DM + (size_t)(kt * 64) * DM + nt * 128;
        dst = (unsigned char*)(p.ws + WS_BTDN) + ((size_t)e * DM + nt * 128) * DE + kt * 64; f8 = true;
    }
}
constexpr int CONV_ITEMS_ALL = 1536 + 512 + 16384 + 8192;
constexpr int CT_B1 = 18;
constexpr int CONV_TAIL = 128 * CT_B1;
__device__ __forceinline__ void phase_convert(const Params& p, LAS unsigned char* lds, const int first, const int CONV_ITEMS, const int start, const int stride) {
    LAS float* tile = (LAS float*)lds;
    const int tid = threadIdx.x;
    float4 r[4];
    int item = first + start;
    const float* src; int ld; unsigned char* dst; int K; bool f8;
    if (item < CONV_ITEMS) {
        conv_item_src(p, item, src, ld, dst, K, f8);
#pragma unroll
        for (int i = 0; i < 4; ++i) { const int idx = tid + 512 * i; r[i] = *(const float4*)(src + (size_t)(idx >> 5) * ld + (idx & 31) * 4); }
    }
    for (; item < CONV_ITEMS; item += stride) {
        __syncthreads();
#pragma unroll
        for (int i = 0; i < 4; ++i) { const int idx = tid + 512 * i; LAS float* t = tile + (idx >> 5) * 129 + (idx & 31) * 4; t[0] = r[i].x; t[1] = r[i].y; t[2] = r[i].z; t[3] = r[i].w; }
        unsigned char* cdst = dst; const int cK = K; const bool cf8 = f8;
        const int nitem = item + stride;
        if (nitem < CONV_ITEMS) {
            conv_item_src(p, nitem, src, ld, dst, K, f8);
#pragma unroll
            for (int i = 0; i < 4; ++i) { const int idx = tid + 512 * i; r[i] = *(const float4*)(src + (size_t)(idx >> 5) * ld + (idx & 31) * 4); }
        }
        __syncthreads();
#pragma unroll
        for (int i = 0; i < 2; ++i) {
            const int o = tid + 512 * i, kg = o & 7, n = o >> 3;
            const LAS float* t = tile + (kg * 8) * 129 + n;
            if (cf8) { u32x2 w;
                w.x = pack4_fp8(t[0 * 129] * F8_WMUL, t[1 * 129] * F8_WMUL, t[2 * 129] * F8_WMUL, t[3 * 129] * F8_WMUL);
                w.y = pack4_fp8(t[4 * 129] * F8_WMUL, t[5 * 129] * F8_WMUL, t[6 * 129] * F8_WMUL, t[7 * 129] * F8_WMUL);
                *(u32x2*)(cdst + (size_t)n * cK + kg * 8) = w;
            } else { u32x4 w;
                w.x = cvt_pk_bf16(t[0 * 129], t[1 * 129]); w.y = cvt_pk_bf16(t[2 * 129], t[3 * 129]);
                w.z = cvt_pk_bf16(t[4 * 129], t[5 * 129]); w.w = cvt_pk_bf16(t[6 * 129], t[7 * 129]);
                *(u32x4*)(cdst + ((size_t)n * cK + kg * 8) * 2) = w; }
        }
    }
    __syncthreads();
}

namespace pg8 {
constexpr int BM = 256, BK = 64, HALF = 128, HTB = HALF * BK * 2, STAGE_BYTES = 8 * HTB;
__device__ __forceinline__ int lds_byte(int r, int c) { const int st = (r >> 4) * 2 + (c >> 5), rr = r & 15, cc = c & 31, ob = rr * 64 + cc * 2; return st * 1024 + (ob ^ (((ob >> 9) & 1) << 5)); }
__device__ __forceinline__ void stage_rc(int b, int& R, int& C) { const int st = b / 1024, sb = b % 1024, swz = sb ^ (((sb >> 9) & 1) << 5); R = (st >> 1) * 16 + swz / 64; C = (st & 1) * 32 + (swz % 64) / 2; }
__device__ __forceinline__ int perm32(int rho) { const int n = rho >> 4, i = rho & 15; return 8 * (i >> 2) + 4 * n + (i & 3); }

struct Unit {
    const char* a;
    const char* b;
    const int* rows;
    int rows_lds;
    int nvalid;
    int pm, pn, e, aux;
};

template <bool PERM, bool F8, class Epi, class Sched>
__device__ __forceinline__ void gemm_phase(LAS unsigned char* lds, const int KB, const Sched& S, const Epi& E) {
    const int tid = threadIdx.x, wid = __builtin_amdgcn_readfirstlane(tid >> 6), lane = tid & 63, wr = wid >> 2, wc = wid & 3, fr = lane & 15, fq = lane >> 4;
    const int nt = KB / 128;
    unsigned vb0, vb1;
    { int Rr[2], Cc[2]; stage_rc(tid * 16, Rr[0], Cc[0]); stage_rc(tid * 16 + 8192, Rr[1], Cc[1]);
      const int Rb0 = PERM ? ((Rr[0] & ~31) + perm32(Rr[0] & 31)) : Rr[0], Rb1 = PERM ? ((Rr[1] & ~31) + perm32(Rr[1] & 31)) : Rr[1];
      vb0 = (unsigned)(Rb0 * KB + 2 * Cc[0]); vb1 = (unsigned)(Rb1 * KB + 2 * Cc[1]); }
    const size_t kstep = (size_t)(BK * 2);
    const size_t hstepB = (size_t)HALF * KB;
    const unsigned ldsw = (unsigned)wid * 1024u;
    const int aoff = lds_byte(wr * 64 + fr, fq * 8), boff = lds_byte(wc * 32 + fr, fq * 8);
#define PG8_SA(b, h) (((b) * 2 + (h)) * HTB)
#define PG8_SB(b, h) ((4 + (b) * 2 + (h)) * HTB)
#define PG8_STAGE2(bufoff, gbase, v0, v1) do { \
        __builtin_amdgcn_global_load_lds((const unsigned*)((const char*)(gbase) + (v0)), (LAS unsigned*)(lds + (bufoff) + ldsw), 16, 0, 0); \
        __builtin_amdgcn_global_load_lds((const unsigned*)((const char*)(gbase) + (v1)), (LAS unsigned*)(lds + (bufoff) + ldsw + 8192), 16, 0, 0); } while (0)
#define PG8_LD16(off) (*(const LAS i32x4*)(lds + (off)))
#define PG8_LDA(dst, b, h) do { if constexpr (F8) { _Pragma("unroll") for (int m = 0; m < 4; ++m) dst##8[m] = __builtin_shufflevector(PG8_LD16(PG8_SA(b, h) + aoff + m * 2048), PG8_LD16(PG8_SA(b, h) + aoff + m * 2048 + 1024), 0, 1, 2, 3, 4, 5, 6, 7); } \
        else { _Pragma("unroll") for (int m = 0; m < 4; ++m) _Pragma("unroll") for (int k = 0; k < 2; ++k) dst[m][k] = *(const LAS bf16x8*)(lds + PG8_SA(b, h) + aoff + m * 2048 + k * 1024); } } while (0)
#define PG8_LDB(dst, b, h) do { if constexpr (F8) { _Pragma("unroll") for (int n = 0; n < 2; ++n) dst##8[n] = __builtin_shufflevector(PG8_LD16(PG8_SB(b, h) + boff + n * 2048), PG8_LD16(PG8_SB(b, h) + boff + n * 2048 + 1024), 0, 1, 2, 3, 4, 5, 6, 7); } \
        else { _Pragma("unroll") for (int n = 0; n < 2; ++n) _Pragma("unroll") for (int k = 0; k < 2; ++k) dst[n][k] = *(const LAS bf16x8*)(lds + PG8_SB(b, h) + boff + n * 2048 + k * 1024); } } while (0)
#define PG8_MMA(ai, bj, At, Bt) do { __builtin_amdgcn_s_setprio(1); \
        if constexpr (F8) { _Pragma("unroll") for (int m = 0; m < 4; ++m) _Pragma("unroll") for (int n = 0; n < 2; ++n) \
            asm volatile("v_mfma_scale_f32_16x16x128_f8f6f4 %0, %1, %2, %0, %3, %4 op_sel_hi:[0,0,0]" : "+v"(acc[ai][bj][m][n]) : "v"(Bt##8[n]), "v"(At##8[m]), "v"(f8sw), "v"(f8sa)); } \
        else { _Pragma("unroll") for (int m = 0; m < 4; ++m) _Pragma("unroll") for (int n = 0; n < 2; ++n) _Pragma("unroll") for (int k = 0; k < 2; ++k) \
            acc[ai][bj][m][n] = __builtin_amdgcn_mfma_f32_16x16x32_bf16(Bt[n][k], At[m][k], acc[ai][bj][m][n], 0, 0, 0); } \
        __builtin_amdgcn_s_setprio(0); } while (0)
#define PG8_WAIT_V(n) asm volatile("s_waitcnt vmcnt(" #n ")" ::: "memory")
#define PG8_WAIT_L(n) asm volatile("s_waitcnt lgkmcnt(" #n ")" ::: "memory")
#define PG8_BAR __builtin_amdgcn_s_barrier()
#define PG8_SCHED __builtin_amdgcn_sched_barrier(0)
#define PG8_VOFF(u, v00, v01, v10, v11) do { int Rr[2], Cc[2]; int tq = tid; asm volatile("" : "+v"(tq)); stage_rc(tq * 16, Rr[0], Cc[0]); stage_rc(tq * 16 + 8192, Rr[1], Cc[1]); \
        if ((u).rows_lds >= 0) { const int nvm = (u).nvalid - 1; const LAS int* rl_ = (const LAS int*)(lds + (u).rows_lds); \
            const int r00 = Rr[0] < nvm ? Rr[0] : nvm, r01 = Rr[1] < nvm ? Rr[1] : nvm, r10 = (Rr[0] + 128) < nvm ? (Rr[0] + 128) : nvm, r11 = (Rr[1] + 128) < nvm ? (Rr[1] + 128) : nvm; \
            v00 = (unsigned)((rl_[r00] >> 1) * KB + 2 * Cc[0]); v01 = (unsigned)((rl_[r01] >> 1) * KB + 2 * Cc[1]); \
            v10 = (unsigned)((rl_[r10] >> 1) * KB + 2 * Cc[0]); v11 = (unsigned)((rl_[r11] >> 1) * KB + 2 * Cc[1]); \
        } else { v00 = (unsigned)(Rr[0] * KB + 2 * Cc[0]); v01 = (unsigned)(Rr[1] * KB + 2 * Cc[1]); v10 = (unsigned)((Rr[0] + 128) * KB + 2 * Cc[0]); v11 = (unsigned)((Rr[1] + 128) * KB + 2 * Cc[1]); } } while (0)
    Unit cur, nxt; int ui = 0;
    if (!S.next(0, cur)) return;
    f32x4 acc[2][2][4][2];
#pragma unroll
    for (int a = 0; a < 2; ++a)
#pragma unroll
        for (int b = 0; b < 2; ++b)
#pragma unroll
            for (int m = 0; m < 4; ++m)
#pragma unroll
                for (int n = 0; n < 2; ++n) acc[a][b][m][n] = (f32x4){0.f, 0.f, 0.f, 0.f};
    bf16x8 At[4][2], B0[2][2], B1[2][2]; i32x8 At8[4], B08[2], B18[2];
    const int f8sw = F8_SCALE_W, f8sa = F8_SCALE_A;
    unsigned vc00, vc01, vc10, vc11, vn00, vn01, vn10, vn11;
    PG8_VOFF(cur, vc00, vc01, vc10, vc11);
    const char* cA = cur.a; const char* cB = cur.b;
    PG8_STAGE2(PG8_SB(0, 0), cB, vb0, vb1); PG8_STAGE2(PG8_SA(0, 0), cA, vc00, vc01); PG8_STAGE2(PG8_SB(0, 1), cB + hstepB, vb0, vb1); PG8_STAGE2(PG8_SA(0, 1), cA, vc10, vc11);
    if (wr == 1) PG8_BAR;
    PG8_WAIT_V(4); PG8_BAR;
    PG8_STAGE2(PG8_SB(1, 0), cB + kstep, vb0, vb1); PG8_STAGE2(PG8_SA(1, 0), cA + kstep, vc00, vc01); PG8_STAGE2(PG8_SB(1, 1), cB + hstepB + kstep, vb0, vb1);
    PG8_WAIT_V(6); PG8_BAR;
    for (;;) {
        const bool has_next = S.next(ui + 1, nxt);
        const char* nA = has_next ? nxt.a : cA; const char* nB = has_next ? nxt.b : cB;
        if (has_next) { PG8_VOFF(nxt, vn00, vn01, vn10, vn11); } else { vn00 = vc00; vn01 = vc01; vn10 = vc10; vn11 = vc11; }
        for (int t = 0; t < nt; t += 2) {
            const bool last = (t == nt - 2);
            const char* a1 = cA + (size_t)(t + 1) * kstep;
            const char* a2 = last ? nA : cA + (size_t)(t + 2) * kstep; const char* b2 = last ? nB : cB + (size_t)(t + 2) * kstep;
            const char* a3 = a2 + kstep; const char* b3 = b2 + kstep;
            const unsigned w00 = last ? vn00 : vc00, w01 = last ? vn01 : vc01, w10 = last ? vn10 : vc10, w11 = last ? vn11 : vc11;
            PG8_LDB(B0, 0, 0); PG8_SCHED; PG8_LDA(At, 0, 0); PG8_STAGE2(PG8_SA(1, 1), a1, vc10, vc11);
            PG8_WAIT_L(8); PG8_BAR; PG8_WAIT_L(0); PG8_MMA(0, 0, At, B0); PG8_BAR; PG8_SCHED;
            PG8_LDB(B1, 0, 1); PG8_STAGE2(PG8_SB(0, 0), b2, vb0, vb1);
            PG8_BAR; PG8_WAIT_L(0); PG8_MMA(0, 1, At, B1); PG8_BAR;
            PG8_LDA(At, 0, 1); PG8_STAGE2(PG8_SA(0, 0), a2, w00, w01);
            PG8_BAR; PG8_WAIT_L(0); PG8_MMA(1, 0, At, B0); PG8_BAR; PG8_SCHED;
            PG8_STAGE2(PG8_SB(0, 1), b2 + hstepB, vb0, vb1);
            PG8_WAIT_V(6); PG8_BAR; PG8_MMA(1, 1, At, B1); PG8_BAR;
            PG8_LDB(B0, 1, 0); PG8_SCHED; PG8_LDA(At, 1, 0); PG8_STAGE2(PG8_SA(0, 1), a2, w10, w11);
            PG8_WAIT_L(8); PG8_BAR; PG8_WAIT_L(0); PG8_MMA(0, 0, At, B0); PG8_BAR; PG8_SCHED;
            PG8_LDB(B1, 1, 1); PG8_STAGE2(PG8_SB(1, 0), b3, vb0, vb1);
            PG8_BAR; PG8_WAIT_L(0); PG8_MMA(0, 1, At, B1); PG8_BAR;
            PG8_LDA(At, 1, 1); PG8_STAGE2(PG8_SA(1, 0), a3, w00, w01);
            PG8_BAR; PG8_WAIT_L(0); PG8_MMA(1, 0, At, B0); PG8_BAR; PG8_SCHED;
            PG8_STAGE2(PG8_SB(1, 1), b3 + hstepB, vb0, vb1);
            PG8_WAIT_V(6); PG8_BAR; PG8_MMA(1, 1, At, B1); PG8_BAR;
        }
        if constexpr (F8) asm volatile("s_nop 15\n\ts_nop 15" ::: "memory");
        E(acc, cur, wr, wc, fr, fq);
        if (!has_next) break;
#pragma unroll
        for (int a = 0; a < 2; ++a)
#pragma unroll
            for (int b = 0; b < 2; ++b)
#pragma unroll
                for (int m = 0; m < 4; ++m)
#pragma unroll
                    for (int n = 0; n < 2; ++n) acc[a][b][m][n] = (f32x4){0.f, 0.f, 0.f, 0.f};
        cur = nxt; cA = nA; cB = nB; vc00 = vn00; vc01 = vn01; vc10 = vn10; vc11 = vn11; ++ui;
    }
    PG8_WAIT_V(0);
    if (wr == 0) PG8_BAR;
    PG8_BAR;
#undef PG8_SA
#undef PG8_SB
#undef PG8_STAGE2
#undef PG8_LDA
#undef PG8_LDB
#undef PG8_LD16
#undef PG8_MMA
#undef PG8_WAIT_V
#undef PG8_WAIT_L
#undef PG8_BAR
#undef PG8_SCHED
#undef PG8_VOFF
}

__device__ __forceinline__ void static_tile(int L, int nM, int nN, int& pm, int& pn) {
    const int nwg = nM * nN; int wgid = L;
    { const int q = nwg / 8, r = nwg % 8, xcd = wgid % 8, off = wgid / 8; wgid = (xcd < r ? xcd * (q + 1) : r * (q + 1) + (xcd - r) * q) + off; }
    const int nig = 8 * nN, gid = wgid / nig, fm = gid * 8, gsz = (nM - fm) < 8 ? (nM - fm) : 8;
    pm = fm + ((wgid % nig) % gsz); pn = (wgid % nig) / gsz;
}
}

struct SchedIn {
    const Params* p;
    __device__ __forceinline__ bool next(int i, pg8::Unit& u) const {
        const long L = (long)i * gridDim.x + blockIdx.x;
        const char* HXb = (const char*)(p->ws + WS_HX); const char* BT = (const char*)(p->ws + WS_BTIN);
        u.rows = nullptr; u.rows_lds = -1; u.nvalid = 256; u.e = 0;
        if (L < 1024) { int j; pg8::static_tile((int)L, 64, 16, u.pm, j); u.pn = j < 12 ? j : j + 4; u.aux = 0; u.a = HXb + (size_t)u.pm * 256 * DM * 2; u.b = BT + (size_t)u.pn * 256 * DM * 2; return true; }
        if (L < 1088) { const int l = (int)L - 1024; u.pm = l >> 3; u.pn = l & 7; u.aux = 1; u.a = HXb + (size_t)(NTOK + u.pm * 256) * DM * 2; u.b = BT + (size_t)(4 + u.pn) * 256 * DM * 2; return true; }
        return false;
    }
};
struct SchedIn8 {
    const Params* p;
    __device__ __forceinline__ bool next(int i, pg8::Unit& u) const {
        int U;
        if (gridDim.x == 256) { const int c = blockIdx.x;
            if (c < 64) { if (i >= 1) return false; U = c; } else if (c < 192) { if (i >= 2) return false; U = 64 + (c - 64) * 2 + i; } else { if (i >= 3) return false; U = 320 + (c - 192) * 3 + i; }
        } else { const long L = (long)i * gridDim.x + blockIdx.x; if (L >= 512) return false; U = (int)L; }
        const int idx = U & 7;
        u.rows = nullptr; u.rows_lds = -1; u.nvalid = 256; u.e = 0; u.aux = 0; u.pm = U >> 3; u.pn = idx < 4 ? 12 + idx : 16 + idx;
        u.a = (const char*)(p->ws + WS_HX8) + (size_t)u.pm * 256 * DM;
        u.b = (const char*)(p->ws + WS_BTIN) + (idx < 4 ? (size_t)3072 * DM * 2 + (size_t)idx * 256 * DM : (size_t)5120 * DM * 2 + (size_t)(idx - 4) * 256 * DM); return true;
    }
};
struct EpiIn {
    const Params* p;
    __device__ __forceinline__ void operator()(const f32x4 (&acc)[2][2][4][2], const pg8::Unit& u, int wr, int wc, int fr, int fq) const {
        bf16_t* O; int ldc; bool act = false;
        if (u.aux == 0) { O = (bf16_t*)(p->ws + WS_P); ldc = PW; act = u.pn >= 16; } else { O = (bf16_t*)(p->ws + WS_PC); ldc = 2048; }
        const int row0 = u.pm * 256 + wr * 64 + fr, col0 = u.pn * 256 + wc * 32 + 8 * fq;
#pragma unroll
        for (int ai = 0; ai < 2; ++ai)
#pragma unroll
            for (int m = 0; m < 4; ++m) { bf16_t* rowp = O + (size_t)(row0 + ai * 128 + m * 16) * ldc + col0;
#pragma unroll
                for (int bj = 0; bj < 2; ++bj) { f32x4 v0 = acc[ai][bj][m][0], v1 = acc[ai][bj][m][1];
                    if (act) {
#pragma unroll
                        for (int j = 0; j < 4; ++j) { v0[j] = gelu_tanh_f(v0[j]); v1[j] = gelu_tanh_f(v1[j]); } }
                    u32x4 w; w.x = cvt_pk_bf16(v0[0], v0[1]); w.y = cvt_pk_bf16(v0[2], v0[3]); w.z = cvt_pk_bf16(v1[0], v1[1]); w.w = cvt_pk_bf16(v1[2], v1[3]);
                    *(u32x4*)(rowp + bj * 128) = w; } }
    }
};
struct SchedOut {
    const Params* p;
    __device__ __forceinline__ bool next(int i, pg8::Unit& u) const {
        const long L = (long)i * gridDim.x + blockIdx.x; if (L >= 512) return false;
        pg8::static_tile((int)L, 64, 8, u.pm, u.pn); u.rows = nullptr; u.rows_lds = -1; u.nvalid = 256; u.e = 0; u.aux = 0;
        u.a = (const char*)(p->ws + WS_YCAT) + (size_t)u.pm * 256 * DM * 2; u.b = (const char*)(p->ws + WS_BTOUT) + (size_t)u.pn * 256 * DM * 2; return true;
    }
};
struct EpiOut {
    const Params* p;
    __device__ __forceinline__ void operator()(const f32x4 (&acc)[2][2][4][2], const pg8::Unit& u, int wr, int wc, int fr, int fq) const {
        bf16_t* X1 = (bf16_t*)(p->ws + WS_X1); const float* pos = (const float*)(p->ws + WS_POS); const float* MOD = (const float*)(p->ws + WS_MOD); float* ST = (float*)(p->ws + WS_STATS);
        const int row0 = u.pm * 256 + wr * 64 + fr, col0 = u.pn * 256 + wc * 32 + 4 * fq;
        const int b = (u.pm * 256) / SEQ;
        f32x4 g1[2][2];
#pragma unroll
        for (int bj = 0; bj < 2; ++bj)
#pragma unroll
            for (int n = 0; n < 2; ++n) g1[bj][n] = *(const f32x4*)(MOD + (size_t)b * (NMOD * DM) + 2 * DM + col0 + bj * 128 + n * 16);
#pragma unroll
        for (int ai = 0; ai < 2; ++ai)
#pragma unroll
            for (int mp = 0; mp < 2; ++mp) {
                f32x4 xv[2][2][2], pv[2][2][2];
#pragma unroll
                for (int mm = 0; mm < 2; ++mm) { const int row = row0 + ai * 128 + (mp * 2 + mm) * 16; const int ts = row % SEQ, rr = ts >> 6, cc = ts & 63;
#pragma unroll
                    for (int bj = 0; bj < 2; ++bj)
#pragma unroll
                        for (int n = 0; n < 2; ++n) { const int col = col0 + bj * 128 + n * 16;
                            xv[mm][bj][n] = *(const f32x4*)(p->x + (size_t)row * DM + col);
                            pv[mm][bj][n] = *(const f32x4*)(col < 1024 ? pos + rr * 1024 + col : pos + 32 * 1024 + cc * 1024 + (col - 1024)); } }
#pragma unroll
                for (int mm = 0; mm < 2; ++mm) { const int m = mp * 2 + mm; const int row = row0 + ai * 128 + m * 16;
                    float s1 = 0.f, s2 = 0.f;
#pragma unroll
                    for (int bj = 0; bj < 2; ++bj)
#pragma unroll
                        for (int n = 0; n < 2; ++n) { const int col = col0 + bj * 128 + n * 16;
                            const f32x4 v = (xv[mm][bj][n] + pv[mm][bj][n]) * ALPHA + g1[bj][n] * acc[ai][bj][m][n];
                            { u32x2 o; o.x = pack2_h16(v[0], v[1]); o.y = pack2_h16(v[2], v[3]); *(u32x2*)(X1 + (size_t)row * DM + col) = o; }
                            s1 += (v[0] + v[1]) + (v[2] + v[3]); s2 += (v[0] * v[0] + v[1] * v[1]) + (v[2] * v[2] + v[3] * v[3]); }
                    s1 += __shfl_xor(s1, 16, 64); s2 += __shfl_xor(s2, 16, 64); s1 += __shfl_xor(s1, 32, 64); s2 += __shfl_xor(s2, 32, 64);
                    if (fq == 0) { atomicAdd(ST + (size_t)row * 2, s1); atomicAdd(ST + (size_t)row * 2 + 1, s2); } }
            }
    }
};
__device__ __forceinline__ bool moe_unit(int i, const LAS int* tab, int& P, int& nt) {
    const int G = gridDim.x, c = blockIdx.x;
    const int wgid = (G % 8 == 0) ? (c % 8) * (G / 8) + c / 8 : c;
    const long L = (long)i * G + wgid; P = (int)(L >> 3); nt = (int)(L & 7);
    return P < tab[160 * 4];
}
__device__ __forceinline__ void moe_build_table(const Params& p, LAS int* tab) {
    if (threadIdx.x == 0) {
        const unsigned* cnt = (const unsigned*)(p.ws + WS_CTL) + CW_CNT;
        int np = 0, off = 0;
        for (int e = 0; e < NE; ++e) { const int c = (int)cnt[e]; const int nmt = (c + 255) >> 8;
            for (int mt = 0; mt < nmt; ++mt) { tab[np * 4 + 0] = e; tab[np * 4 + 1] = mt; tab[np * 4 + 2] = off + mt * 256; tab[np * 4 + 3] = (c - mt * 256) < 256 ? (c - mt * 256) : 256; ++np; }
            off += nmt * 256; }
        tab[160 * 4] = np;
    }
    __syncthreads();
    LAS int* rl = (LAS int*)((LAS unsigned char*)tab - LDS_TAB + LDS_ROWS);
    for (int i = 0; i < 8; ++i) { int P, nt; if (!moe_unit(i, tab, P, nt)) break;
        const int e = tab[P * 4], mt = tab[P * 4 + 1];
        if (threadIdx.x < 256) rl[i * 256 + threadIdx.x] = ((const int*)(p.ws + WS_LIST))[(size_t)e * NTOK + mt * 256 + threadIdx.x]; }
    __syncthreads();
}
struct SchedMoe1 {
    const Params* p; const LAS int* tab;
    __device__ __forceinline__ bool next(int i, pg8::Unit& u) const {
        int P, nt; if (!moe_unit(i, tab, P, nt)) return false;
        const int e = tab[P * 4], mt = tab[P * 4 + 1];
        u.e = e; u.pm = P; u.pn = nt; u.aux = tab[P * 4 + 2]; u.nvalid = tab[P * 4 + 3];
        u.rows = nullptr; u.rows_lds = LDS_ROWS + i * 1024;
        u.a = (const char*)(p->ws + WS_T); u.b = (const char*)(p->ws + WS_BTGU) + (size_t)(e * 8 + nt) * 256 * DM; return true;
    }
};
struct EpiMoe1 {
    const Params* p;
    __device__ __forceinline__ void operator()(const f32x4 (&acc)[2][2][4][2], const pg8::Unit& u, int wr, int wc, int fr, int fq) const {
        unsigned char* H = (unsigned char*)(p->ws + WS_H);
        const int row0 = u.aux + wr * 64 + fr, col0 = u.pn * 128 + wc * 32 + 8 * fq;
#pragma unroll
        for (int ai = 0; ai < 2; ++ai)
#pragma unroll
            for (int m = 0; m < 4; ++m) { unsigned char* rowp = H + (size_t)(row0 + ai * 128 + m * 16) * DE + col0;
                float h[8];
#pragma unroll
                for (int n = 0; n < 2; ++n)
#pragma unroll
                    for (int j = 0; j < 4; ++j) h[n * 4 + j] = silu_f(acc[ai][0][m][n][j]) * acc[ai][1][m][n][j];
                u32x2 w; w.x = pack4_fp8(h[0], h[1], h[2], h[3]); w.y = pack4_fp8(h[4], h[5], h[6], h[7]);
                *(u32x2*)rowp = w; }
    }
};
struct SchedMoe2 {
    const Params* p; const LAS int* tab;
    __device__ __forceinline__ bool next(int i, pg8::Unit& u) const {
        int P, nt; if (!moe_unit(i, tab, P, nt)) return false;
        const int e = tab[P * 4], mt = tab[P * 4 + 1];
        u.e = LDS_ROWS + i * 1024; u.pm = P; u.pn = nt; u.aux = mt; u.nvalid = tab[P * 4 + 3]; u.rows = nullptr; u.rows_lds = -1;
        u.a = (const char*)(p->ws + WS_H) + (size_t)tab[P * 4 + 2] * DE; u.b = (const char*)(p->ws + WS_BTDN) + ((size_t)e * DM + nt * 256) * DE; return true;
    }
};
struct EpiMoe2 {
    const Params* p; LAS unsigned char* lds;
    __device__ __forceinline__ void operator()(const f32x4 (&acc)[2][2][4][2], const pg8::Unit& u, int wr, int wc, int fr, int fq) const {
        unsigned char* Y2 = (unsigned char*)(p->ws + WS_Y2);
        const LAS int* list = (const LAS int*)(lds + u.e);
        const int r0 = wr * 64 + fr, col0 = u.pn * 256 + wc * 32 + 8 * fq;
        int ents[2][4];
#pragma unroll
        for (int ai = 0; ai < 2; ++ai)
#pragma unroll
            for (int m = 0; m < 4; ++m) { const int r = r0 + ai * 128 + m * 16; ents[ai][m] = r < u.nvalid ? list[r] : 0; }
#pragma unroll
        for (int ai = 0; ai < 2; ++ai)
#pragma unroll
            for (int m = 0; m < 4; ++m) { const int r = r0 + ai * 128 + m * 16;
                if (r < u.nvalid) { const int ent = ents[ai][m]; unsigned char* rowp = Y2 + (size_t)ent * DM + col0;
#pragma unroll
                    for (int bj = 0; bj < 2; ++bj) { const f32x4 v0 = acc[ai][bj][m][0] * 16.0f, v1 = acc[ai][bj][m][1] * 16.0f;
                        u32x2 w; w.x = pack4_fp8(v0[0], v0[1], v0[2], v0[3]); w.y = pack4_fp8(v1[0], v1[1], v1[2], v1[3]);
                        *(u32x2*)(rowp + bj * 128) = w; } } }
    }
};

typedef short s16x4 __attribute__((ext_vector_type(4)));
__device__ __forceinline__ s16x4 tr16(const LAS unsigned char* p) { return __builtin_bit_cast(s16x4, __builtin_amdgcn_ds_read_tr16_b64_v4i16((LAS s16x4*)p)); }
__device__ __forceinline__ bf16x8 tr_frag(const LAS unsigned char* tile, int pitchB, int k0, int c0, int lane) {
    const int g = lane >> 4, i = lane & 15;
    const LAS unsigned char* a = tile + (k0 + 8 * g + (i >> 2)) * pitchB + (c0 + 4 * (i & 3)) * 2;
    const s16x4 lo = tr16(a), hi = tr16(a + 4 * pitchB);
    return (bf16x8){lo[0], lo[1], lo[2], lo[3], hi[0], hi[1], hi[2], hi[3]};
}
__device__ __forceinline__ bf16x8 row_frag(const LAS unsigned char* tile, int pitchB, int r0, int k0, int lane) {
    return *(const LAS bf16x8*)(tile + (r0 + (lane & 15)) * pitchB + (k0 + 8 * (lane >> 4)) * 2);
}
#define DPPF(old_, src_, ctrl_, rmask_) __int_as_float(__builtin_amdgcn_update_dpp(__float_as_int(old_), __float_as_int(src_), (ctrl_), (rmask_), 0xf, false))
__device__ __forceinline__ float row16_sum(float v) {
    v += DPPF(0.f, v, 0x128, 0xf); v += DPPF(0.f, v, 0x124, 0xf); v += DPPF(0.f, v, 0x122, 0xf); v += DPPF(0.f, v, 0x121, 0xf); return v;
}
__device__ __forceinline__ float wscan_sum(float v, int) {
    v += DPPF(0.f, v, 0x111, 0xf); v += DPPF(0.f, v, 0x112, 0xf); v += DPPF(0.f, v, 0x114, 0xf); v += DPPF(0.f, v, 0x118, 0xf);
    v += DPPF(0.f, v, 0x142, 0xa); v += DPPF(0.f, v, 0x143, 0xc); return v;
}
__device__ __forceinline__ float wscan_max(float v, int) {
    const float ninf = -3.0e38f;
    v = fmaxf(v, DPPF(ninf, v, 0x111, 0xf)); v = fmaxf(v, DPPF(ninf, v, 0x112, 0xf)); v = fmaxf(v, DPPF(ninf, v, 0x114, 0xf)); v = fmaxf(v, DPPF(ninf, v, 0x118, 0xf));
    v = fmaxf(v, DPPF(ninf, v, 0x142, 0xa)); v = fmaxf(v, DPPF(ninf, v, 0x143, 0xc)); return v;
}
__device__ __forceinline__ float wave_max(float v) {
#pragma unroll
    for (int o = 32; o > 0; o >>= 1) v = fmaxf(v, __shfl_xor(v, o, 64));
    return v;
}
__device__ __forceinline__ void conv8x8_load(const bf16_t* src, size_t pitch, int tfirst, int len, u32x4 (&raw)[10]) {
#pragma unroll
    for (int i = 0; i < 10; ++i) { const int ts = tfirst - 1 + i; raw[i] = (ts >= 0 && ts < len) ? *(const u32x4*)(src + (size_t)ts * pitch) : (u32x4){0u, 0u, 0u, 0u}; }
}
__device__ __forceinline__ void conv8x8_compute(const u32x4 (&raw)[10], const float* cw, const float* cb, int ch, float scale, LAS unsigned char* dst, int dpitchB) {
    float w0[8], w1[8], w2[8], bb[8];
#pragma unroll
    for (int j = 0; j < 8; ++j) { w0[j] = cw[ch + j]; w1[j] = cw[2048 + ch + j]; w2[j] = cw[4096 + ch + j]; bb[j] = cb[ch + j]; }
    float a[8], b[8], c[8];
    unpack8(raw[0], a); unpack8(raw[1], b);
#pragma unroll
    for (int r = 0; r < 8; ++r) {
        unpack8(raw[r + 2], c);
        float o[8];
#pragma unroll
        for (int j = 0; j < 8; ++j) o[j] = silu_f(bb[j] + w0[j] * a[j] + w1[j] * b[j] + w2[j] * c[j]) * scale;
        *(LAS u32x4*)(dst + r * dpitchB) = pack8(o);
#pragma unroll
        for (int j = 0; j < 8; ++j) { a[j] = b[j]; b[j] = c[j]; }
    }
}
__device__ __forceinline__ void conv8x8(const bf16_t* src, size_t pitch, int tfirst, int len, const float* cw, const float* cb, int ch, float scale, LAS unsigned char* dst, int dpitchB) {
    u32x4 raw[10]; conv8x8_load(src, pitch, tfirst, len, raw); conv8x8_compute(raw, cw, cb, ch, scale, dst, dpitchB);
}

constexpr int SC_V0 = 0, SC_V1 = 65536, SC_K = 131072, SC_VEC = SC_K + 18432;
struct ScanSrc { const bf16_t* src; size_t pitch; int kcol, vcol, len, t0, c; const float* grow; bool isx; };
__device__ __forceinline__ ScanSrc scan_src(const Params& p, int step, int b, int h, int dir, int es) {
    ScanSrc q; q.isx = step >= 2;
    q.c = q.isx ? (dir ? 17 - step : step - 2) : (dir ? 1 - step : step);
    q.src = q.isx ? (const bf16_t*)(p.ws + WS_P) + (size_t)(b * SEQ) * PW : (const bf16_t*)(p.ws + WS_PC) + (size_t)(b * CTXL) * 2048;
    q.pitch = q.isx ? PW : 2048;
    q.kcol = (q.isx ? 1024 : 0) + h * HD + es * 64; q.vcol = (q.isx ? 2048 : 1024) + h * HD; q.len = q.isx ? SEQ : CTXL; q.t0 = q.c * CHK;
    q.grow = (const float*)(p.ws + WS_GATES) + (size_t)(q.isx ? b * SEQ + q.t0 : NTOK + b * CTXL + q.t0) * NGATE + dir * 8 + h;
    return q;
}
__device__ __forceinline__ void scan_vdma(const ScanSrc& q, LAS unsigned char* vb, int wid, int lane) {
#pragma unroll
    for (int i = 0; i < 8; ++i) { const int row = 2 * (8 * wid + i) + (lane >> 5); const int gc = (lane & 31) ^ (row & 7);
        GLDS16(q.src + (size_t)(q.t0 + row) * q.pitch + q.vcol + gc * 8, vb + (8 * wid + i) * 1024); }
}
__device__ __forceinline__ bf16x8 tr_frag_swz(const LAS unsigned char* tile, int k0, int c0, int lane) {
    const int g = lane >> 4, i = lane & 15, r = i >> 2, col = c0 + 4 * (i & 3);
    const int row = k0 + 8 * g + r;
    const LAS unsigned char* a0 = tile + row * 512 + (((col >> 3) ^ r) << 4) + ((col & 4) << 1);
    const LAS unsigned char* a1 = tile + (row + 4) * 512 + (((col >> 3) ^ (r + 4)) << 4) + ((col & 4) << 1);
    const s16x4 lo = tr16(a0), hi = tr16(a1);
    return (bf16x8){lo[0], lo[1], lo[2], lo[3], hi[0], hi[1], hi[2], hi[3]};
}
__device__ __forceinline__ void conv4x8_load(const bf16_t* src, size_t pitch, int tfirst, int len, u32x4 (&raw)[6]) {
#pragma unroll
    for (int i = 0; i < 6; ++i) { const int ts = tfirst - 1 + i; raw[i] = (ts >= 0 && ts < len) ? *(const u32x4*)(src + (size_t)ts * pitch) : (u32x4){0u, 0u, 0u, 0u}; }
}
__device__ __forceinline__ void conv4x8_load_async(const bf16_t* src, size_t pitch, int tfirst, int len, u32x4 (&raw)[6]) {
#pragma unroll
    for (int i = 0; i < 6; ++i) { const int ts = tfirst - 1 + i; const bf16_t* a = src + (size_t)ts * pitch;
        raw[i] = (u32x4){0u, 0u, 0u, 0u};
        if (ts >= 0 && ts < len) asm volatile("global_load_dwordx4 %0, %1, off" : "+v"(raw[i]) : "v"(a) : "memory"); }
}
__device__ __forceinline__ void conv4x8_compute(const u32x4 (&raw)[6], const float (&w0)[8], const float (&w1)[8], const float (&w2)[8], const float (&bb)[8], const LAS float* wrow, LAS unsigned char* dst, int dpitchB) {
    float a[8], b[8], c[8];
    unpack8(raw[0], a); unpack8(raw[1], b);
#pragma unroll
    for (int r = 0; r < 4; ++r) {
        unpack8(raw[r + 2], c);
        const float sc = 0.0625f * wrow[r];
        float o[8];
#pragma unroll
        for (int j = 0; j < 8; ++j) o[j] = silu_f(bb[j] + w0[j] * a[j] + w1[j] * b[j] + w2[j] * c[j]) * sc;
        const u32x4 pk = pack8(o);
        *(LAS u32x2*)(dst + r * dpitchB) = (u32x2){pk.x, pk.y}; *(LAS u32x2*)(dst + r * dpitchB + 32) = (u32x2){pk.z, pk.w};
#pragma unroll
        for (int j = 0; j < 8; ++j) { a[j] = b[j]; b[j] = c[j]; }
    }
}
__device__ __forceinline__ void phase_scan(const Params& p, LAS unsigned char* lds) {
    const int tid = threadIdx.x, lane = tid & 63, wid = __builtin_amdgcn_readfirstlane(tid >> 6), wm = wid >> 1, wn = wid & 1;
    LAS float* wtab = (LAS float*)(lds + SC_VEC);
    LAS float* sbl = wtab + 18 * 128;
    bf16_t* CST = (bf16_t*)(p.ws + WS_CST); float* NST = (float*)(p.ws + WS_NST); float* MST = (float*)(p.ws + WS_MST);
    const int cg = tid & 7, rb = (tid >> 3) & 31;
    const bf16x8 ones = (bf16x8){0x3f80, 0x3f80, 0x3f80, 0x3f80, 0x3f80, 0x3f80, 0x3f80, 0x3f80};
    for (int unit0 = blockIdx.x; unit0 < 256; unit0 += gridDim.x) {
        const int es = (unit0 >> 3) & 3, combo = (unit0 >> 5) * 8 + (unit0 & 7);
        const int dir = combo & 1, h = (combo >> 1) & 3, b = combo >> 3;
        const int sidx = (b * 4 + h) * 2 + dir;
        const int s0 = dir ? 127 - lane : lane, s1 = dir ? 63 - lane : 64 + lane;
        asm volatile("s_waitcnt vmcnt(0) lgkmcnt(0)" ::: "memory"); __builtin_amdgcn_s_barrier();
        float cw0[8], cw1[8], cw2[8], cbb[8];
        { const int ch = 1024 + h * HD + es * 64 + cg * 8;
#pragma unroll
          for (int j = 0; j < 8; ++j) { cw0[j] = p.conv_w[ch + j]; cw1[j] = p.conv_w[2048 + ch + j]; cw2[j] = p.conv_w[4096 + ch + j]; cbb[j] = p.conv_b[ch + j]; } }
        u32x4 kraw[6];
        {   const ScanSrc q = scan_src(p, 0, b, h, dir, es);
            scan_vdma(q, lds + SC_V0, wid, lane);
            if (tid < 256) conv4x8_load_async(q.src + q.kcol + cg * 8, q.pitch, q.t0 + rb * 4, q.len, kraw); }
        for (int st = wid; st < 18; st += 8) {
            const ScanSrc q = scan_src(p, st, b, h, dir, es);
            const float li0 = q.grow[(size_t)s0 * NGATE], lf0 = q.grow[(size_t)s0 * NGATE + 4], li1 = q.grow[(size_t)s1 * NGATE], lf1 = q.grow[(size_t)s1 * NGATE + 4];
            const float b0 = wscan_sum(lf0, lane); const float tot0 = __shfl(b0, 63, 64); const float b1 = wscan_sum(lf1, lane) + tot0; const float blast = __shfl(b1, 63, 64);
            const float a0 = blast - b0 + li0, a1 = blast - b1 + li1;
            const float mloc = wave_max(fmaxf(a0, a1));
            wtab[st * 128 + s0] = a0; wtab[st * 128 + s1] = a1;
            if (lane == 0) { sbl[st] = blast; sbl[32 + st] = mloc; }
        }
        asm volatile("s_waitcnt lgkmcnt(0)" ::: "memory"); __builtin_amdgcn_s_barrier();
        if (tid == 0) { float m = 0.f;
            for (int st = 0; st < 18; ++st) { const float bl = sbl[st], ml = sbl[32 + st]; const float mn = fmaxf(bl + m, ml); sbl[64 + st] = __expf(bl + m - mn); sbl[96 + st] = m; sbl[128 + st] = mn; m = mn; } }
        asm volatile("s_waitcnt lgkmcnt(0)" ::: "memory"); __builtin_amdgcn_s_barrier();
        for (int i = tid; i < 18 * 128; i += 512) wtab[i] = __expf(wtab[i] - sbl[128 + (i >> 7)]);
        f32x4 acc[2][4], accn[2];
#pragma unroll
        for (int n = 0; n < 2; ++n) { accn[n] = (f32x4){0.f, 0.f, 0.f, 0.f};
#pragma unroll
            for (int m = 0; m < 4; ++m) acc[n][m] = (f32x4){0.f, 0.f, 0.f, 0.f}; }
#define SCAN_STEP(step, KCUR, KNXT) do { \
            const ScanSrc q = scan_src(p, (step), b, h, dir, es); \
            if ((step) >= 3) asm volatile("s_waitcnt vmcnt(4) lgkmcnt(0)" ::: "memory"); else asm volatile("s_waitcnt vmcnt(0) lgkmcnt(0)" ::: "memory");     \
            __builtin_amdgcn_s_barrier();      \
            if (q.isx) { \
                if (wm == 0 && (lane & 15) == 0) { _Pragma("unroll") for (int n = 0; n < 2; ++n) *(f32x4*)(NST + ((size_t)sidx * 16 + q.c) * 256 + es * 64 + 32 * wn + 8 * (lane >> 4) + 4 * n) = accn[n]; } \
                if (es == 0 && tid == 0) MST[sidx * 16 + q.c] = sbl[96 + (step)]; \
            } \
            if ((step) < 17) { const ScanSrc qn = scan_src(p, (step) + 1, b, h, dir, es); scan_vdma(qn, lds + (((step) + 1) & 1 ? SC_V1 : SC_V0), wid, lane); }     \
            if (tid < 256) conv4x8_compute(KCUR, cw0, cw1, cw2, cbb, wtab + (step) * 128 + rb * 4, lds + SC_K + (rb * 4) * 144 + (cg >> 2) * 64 + (cg & 3) * 8, 144); \
            if ((step) < 17 && tid < 256) { const ScanSrc qn = scan_src(p, (step) + 1, b, h, dir, es); conv4x8_load_async(qn.src + qn.kcol + cg * 8, qn.pitch, qn.t0 + rb * 4, qn.len, KNXT); } \
            asm volatile("" ::: "memory"); \
            if (q.isx) {                                                          \
                bf16_t* cdst = CST + ((size_t)sidx * 16 + q.c) * 65536 + es * 64 + 32 * wn + 8 * (lane >> 4); \
                _Pragma("unroll") for (int m = 0; m < 4; ++m) { u32x4 o; o.x = cvt_pk_bf16(acc[0][m][0], acc[0][m][1]); o.y = cvt_pk_bf16(acc[0][m][2], acc[0][m][3]); o.z = cvt_pk_bf16(acc[1][m][0], acc[1][m][1]); o.w = cvt_pk_bf16(acc[1][m][2], acc[1][m][3]); \
                        *(u32x4*)(cdst + (size_t)(64 * wm + 16 * m + (lane & 15)) * 256) = o; } \
            } \
            asm volatile("s_waitcnt lgkmcnt(0)" ::: "memory"); __builtin_amdgcn_s_barrier();                 \
            const LAS unsigned char* vt = lds + (((step) & 1) ? SC_V1 : SC_V0); \
            const float so = sbl[64 + (step)]; \
            _Pragma("unroll") for (int n = 0; n < 2; ++n) { accn[n] *= so; _Pragma("unroll") for (int m = 0; m < 4; ++m) acc[n][m] *= so; } \
            _Pragma("unroll") for (int ks = 0; ks < 4; ++ks) { \
                bf16x8 af[4], bfr[2]; \
                _Pragma("unroll") for (int m = 0; m < 4; ++m) af[m] = tr_frag_swz(vt, ks * 32, 64 * wm + 16 * m, lane); \
                _Pragma("unroll") for (int n = 0; n < 2; ++n) bfr[n] = tr_frag(lds + SC_K, 144, ks * 32, 32 * wn + 16 * n, lane); \
                _Pragma("unroll") for (int n = 0; n < 2; ++n) { accn[n] = __builtin_amdgcn_mfma_f32_16x16x32_bf16(bfr[n], ones, accn[n], 0, 0, 0); \
                    _Pragma("unroll") for (int m = 0; m < 4; ++m) acc[n][m] = __builtin_amdgcn_mfma_f32_16x16x32_bf16(bfr[n], af[m], acc[n][m], 0, 0, 0); } \
            } } while (0)
#pragma unroll 1
        for (int step = 0; step < 18; ++step) { SCAN_STEP(step, kraw, kraw); }
#undef SCAN_STEP
    }
    asm volatile("s_waitcnt vmcnt(0) lgkmcnt(0)" ::: "memory"); __builtin_amdgcn_s_barrier();
}

constexpr int MX_Q = 0, MX_K = 67584, MX_P = 100352, MX_VEC = 135168;
enum { V_GF = 0, V_GB = 128, V_MF = 256, V_MB = 384, V_SIF = 512, V_SIB = 640, V_EMF = 768, V_EMB = 896, V_RF = 1024, V_RB = 1152, V_AF = 1280, V_AB = 1408, V_DQF = 1536, V_DQB = 1664,
       V_NF = 1792, V_NB = 2048, V_RSF = 2304, V_RSB = 2816, V_END = 3328 };
__device__ __forceinline__ void mix_unit(const Params& p, LAS unsigned char* lds, int unit) {
    const int tid = threadIdx.x, lane = tid & 63, wid = __builtin_amdgcn_readfirstlane(tid >> 6), wm = wid >> 2, wn = wid & 3, lg = lane >> 4, li_ = lane & 15;
    LAS float* vec = (LAS float*)(lds + MX_VEC);
    const int c = unit & 15, h = (unit >> 4) & 3, b = unit >> 6;
    const bf16_t* P = (const bf16_t*)(p.ws + WS_P); const float* G = (const float*)(p.ws + WS_GATES);
    const bf16_t* CST = (const bf16_t*)(p.ws + WS_CST); const float* NST = (const float*)(p.ws + WS_NST); const float* MST = (const float*)(p.ws + WS_MST);
    const int sf = (b * 4 + h) * 2, sb = sf + 1;
    const int t0 = c * CHK; const size_t tok0 = (size_t)b * SEQ + t0;
    const bf16_t* srcb = P + (size_t)(b * SEQ) * PW;
    __syncthreads();
    float gq[5] = {0.f, 0.f, 0.f, 0.f, 0.f}, nfq = 0.f, nbq = 0.f;
    if (wid < 2) { const int dir = wid; const float* grow = G + tok0 * NGATE + dir * 8 + h; const int s0 = dir ? 127 - lane : lane, s1 = dir ? 63 - lane : 64 + lane;
        gq[0] = grow[(size_t)s0 * NGATE]; gq[1] = grow[(size_t)s0 * NGATE + 4]; gq[2] = grow[(size_t)s1 * NGATE]; gq[3] = grow[(size_t)s1 * NGATE + 4]; gq[4] = MST[(dir ? sb : sf) * 16 + c]; }
    if (tid < 256) { nfq = NST[((size_t)sf * 16 + c) * 256 + tid]; nbq = NST[((size_t)sb * 16 + c) * 256 + tid]; }
    { const int cg = tid & 31, rb = tid >> 5;
      u32x4 qraw[10], kraw[10];
      conv8x8_load(srcb + h * HD + cg * 8, PW, t0 + rb * 8, SEQ, qraw); conv8x8_load(srcb + 1024 + h * HD + cg * 8, PW, t0 + rb * 8, SEQ, kraw);
      conv8x8_compute(qraw, p.conv_w, p.conv_b, h * HD + cg * 8, 1.0f, lds + MX_Q + (rb * 8) * 528 + cg * 16, 528);
      conv8x8_compute(kraw, p.conv_w, p.conv_b, 1024 + h * HD + cg * 8, 0.0625f, lds + MX_K + (rb * 8) * 528 + cg * 16, 528); }
    if (tid < 256) { vec[V_NF + tid] = nfq; vec[V_NB + tid] = nbq; }
    if (wid < 2) {
        const int dir = wid;
        const int s0 = dir ? 127 - lane : lane, s1 = dir ? 63 - lane : 64 + lane;
        const float min_ = gq[4], li0 = gq[0], lf0 = gq[1], li1 = gq[2], lf1 = gq[3];
        const float b0 = wscan_sum(lf0, lane); const float tot0 = __shfl(b0, 63, 64); const float b1 = wscan_sum(lf1, lane) + tot0;
        const float g0 = li0 - b0, g1 = li1 - b1;
        const float cm0 = wscan_max(g0, lane); const float tm0 = __shfl(cm0, 63, 64); const float cm1 = fmaxf(wscan_max(g1, lane), tm0);
        const float M0 = fmaxf(min_, cm0), M1 = fmaxf(min_, cm1);
        const int o = dir * 128;
        vec[V_GF + o + s0] = g0; vec[V_GF + o + s1] = g1; vec[V_MF + o + s0] = M0; vec[V_MF + o + s1] = M1;
        vec[V_SIF + o + s0] = __expf(min_ - M0); vec[V_SIF + o + s1] = __expf(min_ - M1);
        vec[V_EMF + o + s0] = __expf(-b0 - M0); vec[V_EMF + o + s1] = __expf(-b1 - M1);
    }
    __syncthreads();
    f32x4 sacc[4][2];
#pragma unroll
    for (int m = 0; m < 4; ++m)
#pragma unroll
        for (int n = 0; n < 2; ++n) sacc[m][n] = (f32x4){0.f, 0.f, 0.f, 0.f};
#pragma unroll 2
    for (int ks = 0; ks < 8; ++ks) {
        bf16x8 af[4], bfr[2];
#pragma unroll
        for (int m = 0; m < 4; ++m) af[m] = row_frag(lds + MX_Q, 528, 64 * wm + 16 * m, ks * 32, lane);
#pragma unroll
        for (int n = 0; n < 2; ++n) bfr[n] = row_frag(lds + MX_K, 528, 32 * wn + 16 * n, ks * 32, lane);
#pragma unroll
        for (int m = 0; m < 4; ++m)
#pragma unroll
            for (int n = 0; n < 2; ++n) sacc[m][n] = __builtin_amdgcn_mfma_f32_16x16x32_bf16(af[m], bfr[n], sacc[m][n], 0, 0, 0);
    }
    {
        const int t = tid >> 2, part = tid & 3; float df = 0.f, db = 0.f;
#pragma unroll 4
        for (int i = 0; i < 8; ++i) { float f[8]; unpack8(*(const LAS u32x4*)(lds + MX_Q + t * 528 + (part * 64 + i * 8) * 2), f);
#pragma unroll
            for (int j = 0; j < 8; ++j) { df += f[j] * vec[V_NF + part * 64 + i * 8 + j]; db += f[j] * vec[V_NB + part * 64 + i * 8 + j]; } }
        df += __shfl_xor(df, 1, 64); df += __shfl_xor(df, 2, 64); db += __shfl_xor(db, 1, 64); db += __shfl_xor(db, 2, 64);
        if (part == 0) { vec[V_DQF + t] = df; vec[V_DQB + t] = db; }
    }
    f32x4 pf[4][2], pb[4][2];
    {
        float gf[2], gb[2];
#pragma unroll
        for (int n = 0; n < 2; ++n) { const int s_ = 32 * wn + 16 * n + li_; gf[n] = vec[V_GF + s_]; gb[n] = vec[V_GB + s_]; }
#pragma unroll
        for (int m = 0; m < 4; ++m)
#pragma unroll
            for (int j = 0; j < 4; ++j) {
                const int t = 64 * wm + 16 * m + 4 * lg + j; const float Mf = vec[V_MF + t], Mb = vec[V_MB + t];
                float rsf = 0.f, rsb = 0.f;
#pragma unroll
                for (int n = 0; n < 2; ++n) { const int s_ = 32 * wn + 16 * n + li_;
                    const float ef = (s_ <= t) ? __expf(fminf(gf[n] - Mf, 0.f)) : 0.f, eb = (s_ >= t) ? __expf(fminf(gb[n] - Mb, 0.f)) : 0.f;
                    const float sv = sacc[m][n][j]; pf[m][n][j] = sv * ef; pb[m][n][j] = sv * eb; rsf += pf[m][n][j]; rsb += pb[m][n][j]; }
                rsf = row16_sum(rsf); rsb = row16_sum(rsb);
                if (li_ == 0) { vec[V_RSF + t * 4 + wn] = rsf; vec[V_RSB + t * 4 + wn] = rsb; }
            }
    }
    __syncthreads();
    if (tid < 128) { const int t = tid;
        const float denf = vec[V_RSF + t * 4] + vec[V_RSF + t * 4 + 1] + vec[V_RSF + t * 4 + 2] + vec[V_RSF + t * 4 + 3] + vec[V_SIF + t] * vec[V_DQF + t];
        const float denb = vec[V_RSB + t * 4] + vec[V_RSB + t * 4 + 1] + vec[V_RSB + t * 4 + 2] + vec[V_RSB + t * 4 + 3] + vec[V_SIB + t] * vec[V_DQB + t];
        const float rf = 1.0f / fmaxf(fabsf(denf), vec[V_EMF + t]), rb = 1.0f / fmaxf(fabsf(denb), vec[V_EMB + t]);
        vec[V_RF + t] = rf; vec[V_RB + t] = rb; vec[V_AF + t] = rf * vec[V_SIF + t]; vec[V_AB + t] = rb * vec[V_SIB + t]; }
    __syncthreads();
#pragma unroll
    for (int m = 0; m < 4; ++m)
#pragma unroll
        for (int j = 0; j < 4; ++j) { const int t = 64 * wm + 16 * m + 4 * lg + j; const float rf = vec[V_RF + t], rb = vec[V_RB + t];
#pragma unroll
            for (int n = 0; n < 2; ++n) *(LAS bf16_t*)(lds + MX_P + t * 272 + (32 * wn + 16 * n + li_) * 2) = f2bf(rf * pf[m][n][j] + rb * pb[m][n][j]); }
    f32x4 acc[4][4];
    {
        const bf16_t* cqf = CST + ((size_t)sf * 16 + c) * 65536 + (size_t)(64 * wn + li_) * 256 + 8 * lg;
        const bf16_t* cqb = CST + ((size_t)sb * 16 + c) * 65536 + (size_t)(64 * wn + li_) * 256 + 8 * lg;
        bf16x8 bq0[4], bq1[4];
#pragma unroll
        for (int n = 0; n < 4; ++n) bq0[n] = *(const bf16x8*)(cqf + (size_t)(16 * n) * 256);
#pragma unroll 1
        for (int dirq = 0; dirq < 2; ++dirq) {
            f32x4 accx[4][4];
#pragma unroll
            for (int m = 0; m < 4; ++m)
#pragma unroll
                for (int n = 0; n < 4; ++n) accx[m][n] = (f32x4){0.f, 0.f, 0.f, 0.f};
            const bf16_t* cx = dirq ? cqb : cqf;
#pragma unroll 1
            for (int ks = 0; ks < 8; ks += 2) {
#pragma unroll
                for (int n = 0; n < 4; ++n) bq1[n] = *(const bf16x8*)(cx + (size_t)(16 * n) * 256 + (ks + 1) * 32);
                {   bf16x8 af[4];
#pragma unroll
                    for (int m = 0; m < 4; ++m) af[m] = row_frag(lds + MX_Q, 528, 64 * wm + 16 * m, ks * 32, lane);
#pragma unroll
                    for (int m = 0; m < 4; ++m)
#pragma unroll
                        for (int n = 0; n < 4; ++n) accx[m][n] = __builtin_amdgcn_mfma_f32_16x16x32_bf16(af[m], bq0[n], accx[m][n], 0, 0, 0); }
                {   const bf16_t* nx = ks < 6 ? cx + (ks + 2) * 32 : cqb;
#pragma unroll
                    for (int n = 0; n < 4; ++n) bq0[n] = *(const bf16x8*)(nx + (size_t)(16 * n) * 256); }
                {   bf16x8 af[4];
#pragma unroll
                    for (int m = 0; m < 4; ++m) af[m] = row_frag(lds + MX_Q, 528, 64 * wm + 16 * m, (ks + 1) * 32, lane);
#pragma unroll
                    for (int m = 0; m < 4; ++m)
#pragma unroll
                        for (int n = 0; n < 4; ++n) accx[m][n] = __builtin_amdgcn_mfma_f32_16x16x32_bf16(af[m], bq1[n], accx[m][n], 0, 0, 0); }
            }
#pragma unroll
            for (int m = 0; m < 4; ++m)
#pragma unroll
                for (int j = 0; j < 4; ++j) { const int t = 64 * wm + 16 * m + 4 * lg + j; const float a_x = vec[(dirq ? V_AB : V_AF) + t];
#pragma unroll
                    for (int n = 0; n < 4; ++n) acc[m][n][j] = dirq ? acc[m][n][j] + a_x * accx[m][n][j] : a_x * accx[m][n][j]; }
        }
    }
    u32x4 vreg[8];
#pragma unroll
    for (int i = 0; i < 8; ++i) { const int piece = tid + 512 * i; vreg[i] = *(const u32x4*)(srcb + (size_t)(t0 + (piece >> 5)) * PW + 2048 + h * HD + (piece & 31) * 8); }
    __syncthreads();
#pragma unroll
    for (int i = 0; i < 8; ++i) { const int piece = tid + 512 * i, row = piece >> 5; *(LAS u32x4*)(lds + MX_Q + row * 528 + (piece & 31) * 16) = vreg[i]; }
    __syncthreads();
#pragma unroll
    for (int ks = 0; ks < 4; ++ks) {
        bf16x8 af[4], bfr[4];
#pragma unroll
        for (int m = 0; m < 4; ++m) af[m] = row_frag(lds + MX_P, 272, 64 * wm + 16 * m, ks * 32, lane);
#pragma unroll
        for (int n = 0; n < 4; ++n) bfr[n] = tr_frag(lds + MX_Q, 528, ks * 32, 64 * wn + 16 * n, lane);
#pragma unroll
        for (int m = 0; m < 4; ++m)
#pragma unroll
            for (int n = 0; n < 4; ++n) acc[m][n] = __builtin_amdgcn_mfma_f32_16x16x32_bf16(af[m], bfr[n], acc[m][n], 0, 0, 0);
    }
    u32x4 oraw[8];
#pragma unroll
    for (int i = 0; i < 8; ++i) { const int piece = tid + 512 * i; oraw[i] = *(const u32x4*)(P + (tok0 + (piece >> 5)) * PW + 3072 + h * HD + (piece & 31) * 8); }
#pragma unroll
    for (int m = 0; m < 4; ++m)
#pragma unroll
        for (int j = 0; j < 4; ++j) { const float sm = row16_sum(acc[m][0][j] + acc[m][1][j] + acc[m][2][j] + acc[m][3][j]);
            if (li_ == 0) vec[V_RSF + (64 * wm + 16 * m + 4 * lg + j) * 4 + wn] = sm; }
    __syncthreads();
    float mu[4][4];
#pragma unroll
    for (int m = 0; m < 4; ++m)
#pragma unroll
        for (int j = 0; j < 4; ++j) { const int t = 64 * wm + 16 * m + 4 * lg + j;
            mu[m][j] = (vec[V_RSF + t * 4] + vec[V_RSF + t * 4 + 1] + vec[V_RSF + t * 4 + 2] + vec[V_RSF + t * 4 + 3]) * (1.0f / 256.0f);
            float sq = 0.f;
#pragma unroll
            for (int n = 0; n < 4; ++n) { const float dl = acc[m][n][j] - mu[m][j]; sq += dl * dl; }
            sq = row16_sum(sq);
            if (li_ == 0) vec[V_RSB + t * 4 + wn] = sq; }
    __syncthreads();
#pragma unroll
    for (int m = 0; m < 4; ++m)
#pragma unroll
        for (int j = 0; j < 4; ++j) { const int t = 64 * wm + 16 * m + 4 * lg + j;
            const float rstd = rsqrtf((vec[V_RSB + t * 4] + vec[V_RSB + t * 4 + 1] + vec[V_RSB + t * 4 + 2] + vec[V_RSB + t * 4 + 3]) * (1.0f / 256.0f) + LN_EPS);
#pragma unroll
            for (int n = 0; n < 4; ++n) *(LAS float*)(lds + (t * 260 + 64 * wn + 16 * n + li_) * 4) = (acc[m][n][j] - mu[m][j]) * rstd; }
    __syncthreads();
    bf16_t* Y = (bf16_t*)(p.ws + WS_YCAT);
#pragma unroll
    for (int i = 0; i < 8; ++i) { const int piece = tid + 512 * i, row = piece >> 5, dg = piece & 31; const int col = h * HD + dg * 8;
        float o[8]; unpack8(oraw[i], o);
        const f32x4 h0 = *(const LAS f32x4*)(lds + (row * 260 + dg * 8) * 4), h1 = *(const LAS f32x4*)(lds + (row * 260 + dg * 8 + 4) * 4);
        const f32x4 w0 = *(const f32x4*)(p.mlstm_norm_w + col), w1 = *(const f32x4*)(p.mlstm_norm_w + col + 4);
        float y[8];
#pragma unroll
        for (int j = 0; j < 4; ++j) { y[j] = h0[j] * w0[j] * sigmoid_f(o[j]); y[4 + j] = h1[j] * w1[j] * sigmoid_f(o[4 + j]); }
        *(u32x4*)(Y + (tok0 + row) * DM + col) = pack8(y); }
}

constexpr int CM_W = 0, CM_V = 34816;
__device__ __forceinline__ void cmlp_unit(const Params& p, LAS unsigned char* lds, int unit) {
    const int tid = threadIdx.x, lane = tid & 63, wid = __builtin_amdgcn_readfirstlane(tid >> 6), wm = wid >> 2, wn = wid & 3, lg = lane >> 4, li_ = lane & 15;
    const int g = unit & 3, bc = unit >> 2;
    const size_t tok0 = (size_t)bc * CHK;
    const bf16_t* P = (const bf16_t*)(p.ws + WS_P);
    __syncthreads();
#pragma unroll
    for (int i = 0; i < 8; ++i) { const int idx = tid + 512 * i, row = idx >> 5, c4 = idx & 31;
        const float4 w = *(const float4*)(p.w_s + ((size_t)g * CHK + row) * CHK + c4 * 4);
        u32x2 o; o.x = cvt_pk_bf16(w.x, w.y); o.y = cvt_pk_bf16(w.z, w.w);
        *(LAS u32x2*)(lds + CM_W + row * 272 + c4 * 8) = o; }
#pragma unroll 2
    for (int i = 0; i < 8; ++i) { const int piece = tid + 512 * i, row = piece >> 5, dg = piece & 31;
        float f[8]; unpack8(*(const u32x4*)(P + (tok0 + row) * PW + 5120 + g * 256 + dg * 8), f);
        float sm = 0.f;
#pragma unroll
        for (int j = 0; j < 8; ++j) sm += f[j];
        sm = row16_sum(sm); sm += __shfl_xor(sm, 16, 64);
        const float mu = sm * (1.0f / 256.0f); float sq = 0.f;
#pragma unroll
        for (int j = 0; j < 8; ++j) { f[j] -= mu; sq += f[j] * f[j]; }
        sq = row16_sum(sq); sq += __shfl_xor(sq, 16, 64);
        const float rstd = rsqrtf(sq * (1.0f / 256.0f) + LN_EPS);
#pragma unroll
        for (int j = 0; j < 8; ++j) f[j] = f[j] * rstd * p.cmlp_norm_w[g * 256 + dg * 8 + j];
        *(LAS u32x4*)(lds + CM_V + row * 528 + dg * 16) = pack8(f); }
    __syncthreads();
    f32x4 acc[4][4];
#pragma unroll
    for (int m = 0; m < 4; ++m)
#pragma unroll
        for (int n = 0; n < 4; ++n) acc[m][n] = (f32x4){0.f, 0.f, 0.f, 0.f};
#pragma unroll
    for (int ks = 0; ks < 4; ++ks) {
        bf16x8 af[4], bfr[4];
#pragma unroll
        for (int m = 0; m < 4; ++m) af[m] = row_frag(lds + CM_W, 272, 64 * wm + 16 * m, ks * 32, lane);
#pragma unroll
        for (int n = 0; n < 4; ++n) bfr[n] = tr_frag(lds + CM_V, 528, ks * 32, 64 * wn + 16 * n, lane);
#pragma unroll
        for (int m = 0; m < 4; ++m)
#pragma unroll
            for (int n = 0; n < 4; ++n) acc[m][n] = __builtin_amdgcn_mfma_f32_16x16x32_bf16(af[m], bfr[n], acc[m][n], 0, 0, 0);
    }
    __syncthreads();
#pragma unroll
    for (int m = 0; m < 4; ++m)
#pragma unroll
        for (int j = 0; j < 4; ++j) { const int pp = 64 * wm + 16 * m + 4 * lg + j; const float bs = p.b_s[g * CHK + pp];
#pragma unroll
            for (int n = 0; n < 4; ++n) *(LAS float*)(lds + (pp * 260 + 64 * wn + 16 * n + li_) * 4) = acc[m][n][j] + bs; }
    __syncthreads();
    bf16_t* Y = (bf16_t*)(p.ws + WS_YCAT);
#pragma unroll 2
    for (int i = 0; i < 8; ++i) { const int piece = tid + 512 * i, row = piece >> 5, dg = piece & 31;
        float u[8]; unpack8(*(const u32x4*)(P + (tok0 + row) * PW + 4096 + g * 256 + dg * 8), u);
        const f32x4 s0 = *(const LAS f32x4*)(lds + (row * 260 + dg * 8) * 4), s1 = *(const LAS f32x4*)(lds + (row * 260 + dg * 8 + 4) * 4);
        float y[8];
#pragma unroll
        for (int j = 0; j < 4; ++j) { y[j] = u[j] * s0[j]; y[4 + j] = u[4 + j] * s1[j]; }
        *(u32x4*)(Y + (tok0 + row) * DM + 1024 + g * 256 + dg * 8) = pack8(y); }
}
__device__ __forceinline__ void phase_mix(const Params& p, LAS unsigned char* lds) {
#pragma unroll 1
    for (int u = blockIdx.x; u < 512; u += gridDim.x) mix_unit(p, lds, u);
#pragma unroll 1
    for (int u = blockIdx.x; u < 512; u += gridDim.x) cmlp_unit(p, lds, u);
    __syncthreads();
}

#define XB_TMO      128
#define XB_XCNT(j)  (256  + 64 * (j))
#define XB_XSUB(j)  (1280 + 64 * (j))
#define XB_XGEN(j)  (2304 + 64 * (j))
#define XB_TOP      3328
#define XB_TOPGEN   3392
#define XCD_BAR_WORDS 3456
#define XB_SPIN_CAP (1u << 18)

__device__ __forceinline__ unsigned xb_ld(unsigned* p)              { return __hip_atomic_load(p, __ATOMIC_RELAXED, __HIP_MEMORY_SCOPE_AGENT); }
__device__ __forceinline__ unsigned xb_add(unsigned* p, unsigned v) { return __hip_atomic_fetch_add(p, v, __ATOMIC_RELAXED, __HIP_MEMORY_SCOPE_AGENT); }
__device__ __forceinline__ unsigned xb_xcc_id() { return (unsigned)__builtin_amdgcn_s_getreg((3 << 11) | 20) & 0xFu; }
#define XB_SPIN(cond, bar) do { unsigned _sp = 0; while (cond) { __builtin_amdgcn_s_sleep(1); \
    if ((++_sp & 255u) == 0u) { if (xb_ld(&(bar)[XB_TMO])) break; if (_sp > XB_SPIN_CAP) { atomicAdd(&(bar)[XB_TMO], 1u); break; } } } } while (0)

struct XcdBarrier {
    unsigned* bar; unsigned x;
    volatile LAS unsigned* st;
};
__device__ __forceinline__ XcdBarrier xcd_barrier_post(unsigned* bar, volatile LAS unsigned* st) {
    XcdBarrier b; b.bar = bar; b.x = xb_xcc_id(); b.st = st;
    if (threadIdx.x == 0) (void)xb_add(&bar[XB_XCNT(b.x)], 1u);
    return b;
}
__device__ __forceinline__ void xcd_barrier_complete(unsigned* bar, unsigned x, unsigned& nloc, unsigned& nx) {
    const unsigned G = gridDim.x * gridDim.y * gridDim.z;
    unsigned sum, cnt, mine, sp = 0u;
    for (;;) {
        sum = 0u; cnt = 0u; mine = 0u;
#pragma unroll
        for (unsigned j = 0; j < 16; ++j) { const unsigned c = xb_ld(&bar[XB_XCNT(j)]); sum += c; cnt += (c > 0u) ? 1u : 0u; mine = (j == x) ? c : mine; }
        if (sum == G) break;
        __builtin_amdgcn_s_sleep(1);
        if ((++sp & 255u) == 0u) { if (xb_ld(&bar[XB_TMO])) break; if (sp > XB_SPIN_CAP) { atomicAdd(&bar[XB_TMO], 1u); break; } }
    }
    nloc = mine > 0u ? mine : 1u; nx = cnt > 0u ? cnt : 1u;
}
__device__ __forceinline__ void xcd_barrier(const XcdBarrier& b) {
    asm volatile("s_waitcnt vmcnt(0)" ::: "memory");
    __syncthreads();
    if (threadIdx.x == 0) {
        unsigned* bar = b.bar;
        __builtin_amdgcn_s_waitcnt(0);
        unsigned nloc = b.st[0], nx = b.st[1];
        if (nloc == 0u) { xcd_barrier_complete(bar, b.x, nloc, nx); b.st[0] = nloc; b.st[1] = nx; }
        const unsigned old = xb_add(&bar[XB_XSUB(b.x)], 1u);
        const unsigned gen = old / nloc;
        if (old + 1u == (gen + 1u) * nloc) {
            __builtin_amdgcn_fence(__ATOMIC_RELEASE, "agent");
            asm volatile("s_waitcnt vmcnt(0)" ::: "memory");
            const unsigned og = xb_add(&bar[XB_TOP], 1u);
            const unsigned tg = og / nx;
            if (og + 1u == (tg + 1u) * nx) xb_add(&bar[XB_TOPGEN], 1u);
            else XB_SPIN(xb_ld(&bar[XB_TOPGEN]) == tg, bar);
            __builtin_amdgcn_fence(__ATOMIC_ACQUIRE, "agent");
            xb_add(&bar[XB_XGEN(b.x)], 1u);
            asm volatile("s_waitcnt vmcnt(0)" ::: "memory");
        } else {
            XB_SPIN(xb_ld(&bar[XB_XGEN(b.x)]) == gen, bar);
            __builtin_amdgcn_fence(__ATOMIC_ACQUIRE, "agent");
            asm volatile("s_waitcnt vmcnt(0)" ::: "memory");
        }
    }
    __syncthreads();
}

enum { PH_PREP = 0, PH_HX = 1, PH_INPROJ = 2, PH_SCAN = 3, PH_MIX = 4, PH_OUTPROJ = 5, PH_LN1 = 6, PH_MOE1 = 7, PH_MOE2 = 8, PH_FINAL = 9, PH_END = 10 };
#ifndef DUP_PHASE
#define DUP_PHASE (-1)
#endif
constexpr int CW_BAR = 256;
__global__ void __launch_bounds__(512, 2) fwd(Params p, int lo, int hi) {
    extern __shared__ __attribute__((aligned(16))) unsigned char shm[];
    LAS unsigned char* lds = (LAS unsigned char*)shm;
    if (threadIdx.x < 4) ((LAS unsigned*)(lds + LDS_MISC))[threadIdx.x] = 0u;
    __syncthreads();
    XcdBarrier bar; bar.bar = (unsigned*)(p.ws + WS_CTL) + CW_BAR; bar.x = 0; bar.st = (volatile LAS unsigned*)(lds + LDS_MISC);
    if (hi - lo > 1) bar = xcd_barrier_post((unsigned*)(p.ws + WS_CTL) + CW_BAR, (volatile LAS unsigned*)(lds + LDS_MISC));
#define IN(k) (lo <= (k) && (k) < hi)
#define SEAM(k) do { if (IN(k) && IN((k) + 1)) xcd_barrier(bar); } while (0)
#define PHASE(k, ...) do { if (IN(k)) { __VA_ARGS__; if (DUP_PHASE == (k)) { xcd_barrier(bar); __VA_ARGS__; } } SEAM(k); } while (0)
    PHASE(PH_PREP, { phase_mod(p, lds); phase_postab(p); phase_convert(p, lds, 0, gridDim.x == 256 ? CONV_ITEMS_ALL - CONV_TAIL : CONV_ITEMS_ALL, blockIdx.x, gridDim.x); });
    PHASE(PH_HX, phase_hx(p, lds));
    PHASE(PH_INPROJ, { { SchedIn S{&p}; EpiIn E{&p}; pg8::gemm_phase<true, false>(lds, DM * 2, S, E); }
        { SchedIn8 S{&p}; EpiIn E{&p}; pg8::gemm_phase<true, true>(lds, DM, S, E); }
        if (gridDim.x == 256 && blockIdx.x >= 64 && blockIdx.x < 192) {
            const int f = CONV_ITEMS_ALL - CONV_TAIL + ((int)blockIdx.x - 64) * CT_B1; phase_convert(p, lds, f, f + CT_B1, 0, 1); } });
    PHASE(PH_SCAN, phase_scan(p, lds));
    PHASE(PH_MIX, phase_mix(p, lds));
    PHASE(PH_OUTPROJ, { SchedOut S{&p}; EpiOut E{&p}; pg8::gemm_phase<false, false>(lds, DM * 2, S, E); });
    PHASE(PH_LN1, phase_ln1(p, lds));
    PHASE(PH_MOE1, { LAS int* tab = (LAS int*)(lds + LDS_TAB); moe_build_table(p, tab); SchedMoe1 S{&p, tab}; EpiMoe1 E{&p}; pg8::gemm_phase<true, true>(lds, DM, S, E); });
    PHASE(PH_MOE2, { LAS int* tab = (LAS int*)(lds + LDS_TAB); moe_build_table(p, tab); SchedMoe2 S{&p, tab}; EpiMoe2 E{&p, lds}; pg8::gemm_phase<true, true>(lds, DE, S, E); });
    PHASE(PH_FINAL, phase_final(p, lds));
#undef PHASE
#undef IN
#undef SEAM
}

#ifndef MK_N_LAUNCHES
#define MK_N_LAUNCHES 1
#endif
extern "C" void kernel_launch(void* const* d_in, const int* in_sizes, int n_in, void* d_out, int out_size, void* d_ws, size_t ws_size, hipStream_t stream) {
    static int grid = 0;
    if (grid == 0) {
        if (n_in != 26 || out_size != NTOK * DM || ws_size < WS_END) { fprintf(stderr, "kernel_launch: unexpected shapes: n_in %d out %d ws %zu (need %zu)\n", n_in, out_size, ws_size, (size_t)WS_END); grid = -1; return; }
        int dev = 0, cus = 0, per_cu = 0;
        if (hipGetDevice(&dev) != hipSuccess || hipDeviceGetAttribute(&cus, hipDeviceAttributeMultiprocessorCount, dev) != hipSuccess) { grid = -1; return; }
        if (hipFuncSetAttribute((const void*)fwd, hipFuncAttributeMaxDynamicSharedMemorySize, LDS_TOTAL) != hipSuccess) { fprintf(stderr, "kernel_launch: hipFuncSetAttribute failed\n"); grid = -1; return; }
        if (hipOccupancyMaxActiveBlocksPerMultiprocessor(&per_cu, (const void*)fwd, 512, LDS_TOTAL) != hipSuccess || per_cu < 1) { fprintf(stderr, "kernel_launch: occupancy query says %d\n", per_cu); }
        (void)hipGetLastError();
        grid = cus;
    }
    if (grid < 0) return;
    Params p{};
    const float* const* in = (const float* const*)d_in;
    p.x = in[0]; p.c = in[1]; p.ctx = in[2]; p.c_ctx = in[3]; p.w_mod = in[4]; p.b_mod = in[5]; p.w_in = in[6]; p.conv_w = in[7]; p.conv_b = in[8]; p.gate_bias = in[9];
    p.mlstm_norm_w = in[10]; p.cmlp_norm_w = in[11]; p.w_s = in[12]; p.b_s = in[13]; p.w_out = in[14]; p.ln1_w = in[15]; p.ln1_b = in[16];
    p.r1_w = in[17]; p.r1_b = in[18]; p.r2_w = in[19]; p.r2_b = in[20]; p.w_gate = in[21]; p.w_up = in[22]; p.w_down = in[23]; p.ln2_w = in[24]; p.ln2_b = in[25];
    p.out = (float*)d_out; p.ws = (unsigned char*)d_ws;
    (void)hipMemsetAsync(p.ws, 0, WS_ZERO_END, stream);
#if MK_N_LAUNCHES == 1
    fwd<<<grid, 512, LDS_TOTAL, stream>>>(p, 0, PH_END);
#else
    for (int ph = 0; ph < PH_END; ++ph) fwd<<<grid, 512, LDS_TOTAL, stream>>>(p, ph, ph + 1);
#endif
}
```

```cpp
#include <hip/hip_runtime.h>
#include <cstdio>
#include <cstdint>

typedef unsigned short bf16_t;

constexpr int DM = 2048, NB = 8, SEQ = 2048, CTXL = 256;
constexpr int NTOK = NB * SEQ;
constexpr int NCTX = NB * CTXL;
constexpr int NROWS = NTOK + NCTX;
constexpr int DIN = 6160, DML = 1024, NH = 4, HD = 256, CHK = 128;
constexpr int NGATE = 16;
constexpr int PW = 6144;
constexpr int NE = 32, DE = 1024;
constexpr int NMOD = 6;
constexpr float ALPHA = 1.189207115002721f;
constexpr float LN_EPS = 1e-6f;
constexpr int HCAP = 40960;

constexpr size_t al256(size_t x) { return (x + 255) & ~(size_t)255; }
constexpr size_t WS_CTL   = 0;
constexpr size_t CTL_BYTES = 65536;
constexpr size_t WS_MOD   = WS_CTL + CTL_BYTES;
constexpr size_t MOD_BYTES = al256((size_t)9 * NMOD * DM * 4);
constexpr size_t WS_STATS = WS_MOD + MOD_BYTES;
constexpr size_t WS_ZERO_END = WS_STATS + al256((size_t)NTOK * 2 * 4);
constexpr size_t WS_POS   = WS_ZERO_END;
constexpr size_t WS_HX    = WS_POS + al256((size_t)96 * 1024 * 4);
constexpr size_t WS_GATES = WS_HX + al256((size_t)NROWS * DM * 2);
constexpr size_t WS_P     = WS_GATES + al256((size_t)NROWS * NGATE * 4);
constexpr size_t WS_PC    = WS_P + al256((size_t)NTOK * PW * 2);
constexpr size_t WS_YCAT  = WS_PC + al256((size_t)NCTX * 2048 * 2);
constexpr size_t WS_T     = WS_YCAT;
constexpr size_t WS_X1    = WS_YCAT + al256((size_t)NTOK * DM * 2);
constexpr size_t WS_LIST  = WS_X1 + al256((size_t)NTOK * DM * 4);
constexpr size_t WS_RT    = WS_LIST + al256((size_t)NE * NTOK * 4);
constexpr size_t WS_H     = WS_P;
constexpr size_t WS_Y2    = WS_RT + al256((size_t)NTOK * 2 * 4);
constexpr size_t WS_HDIR  = WS_Y2;
constexpr size_t WS_BTIN  = WS_Y2 + al256((size_t)NTOK * 2 * DM * 2);
constexpr size_t WS_BTOUT = WS_BTIN + al256((size_t)PW * DM * 2);
constexpr size_t WS_BTGU  = WS_BTOUT + al256((size_t)DM * DM * 2);
constexpr size_t WS_BTDN  = WS_BTGU + al256((size_t)NE * 2 * DE * DM * 2);
constexpr size_t WS_NST   = WS_BTDN + al256((size_t)NE * DM * DE * 2);
constexpr size_t WS_MST   = WS_NST + al256((size_t)64 * 16 * 256 * 4);
constexpr size_t WS_CST   = WS_Y2;
constexpr size_t WS_RWT   = WS_MST + al256((size_t)64 * 16 * 4);
constexpr size_t WS_RWH   = WS_RWT + al256((size_t)36 * DM * 4);
constexpr size_t WS_HX8   = WS_RWH + al256((size_t)2 * 48 * DM * 2);
constexpr size_t WS_WGT   = WS_HX8 + al256((size_t)NTOK * DM);
constexpr size_t WS_END   = WS_WGT + al256((size_t)NGATE * DM * 4);

constexpr int CW_CNT = 0;

struct Params {
    const float *x, *c, *ctx, *c_ctx, *w_mod, *b_mod, *w_in, *conv_w, *conv_b, *gate_bias, *mlstm_norm_w, *cmlp_norm_w, *w_s, *b_s, *w_out,
                *ln1_w, *ln1_b, *r1_w, *r1_b, *r2_w, *r2_b, *w_gate, *w_up, *w_down, *ln2_w, *ln2_b;
    float* out;
    unsigned char* ws;
};

__device__ __forceinline__ bf16_t f2bf(float f) { return __builtin_bit_cast(bf16_t, (__bf16)f); }
__device__ __forceinline__ float bf2f(bf16_t b) { return __uint_as_float(((unsigned)b) << 16); }
__device__ __forceinline__ float silu_f(float x) { return x * __builtin_amdgcn_rcpf(1.0f + __expf(-x)); }
__device__ __forceinline__ float sigmoid_f(float x) { return __builtin_amdgcn_rcpf(1.0f + __expf(-x)); }
__device__ __forceinline__ float logsigmoid_f(float x) { return fminf(x, 0.0f) - log1pf(__expf(-fabsf(x))); }
__device__ __forceinline__ float gelu_tanh_f(float x) {
    const float z = 0.7978845608028654f * (x + 0.044715f * x * x * x);
    const float e = __expf(2.0f * z);
    const float th = 1.0f - 2.0f * __builtin_amdgcn_rcpf(e + 1.0f);
    return 0.5f * x * (1.0f + th);
}
__device__ __forceinline__ float wave_sum(float v) {
#pragma unroll
    for (int o = 32; o > 0; o >>= 1) v += __shfl_xor(v, o, 64);
    return v;
}
__device__ __forceinline__ float pos_val(const float* pos, int tok_in_seq, int col) {
    const int r = tok_in_seq >> 6, cc = tok_in_seq & 63;
    return col < 1024 ? pos[r * 1024 + col] : pos[32 * 1024 + cc * 1024 + (col - 1024)];
}

#define LAS __attribute__((address_space(3)))
typedef short bf16x8 __attribute__((ext_vector_type(8)));
typedef float f32x4 __attribute__((ext_vector_type(4)));
typedef unsigned u32x4 __attribute__((ext_vector_type(4)));
constexpr int LDS_STAGE = 131072;
constexpr int LDS_TOTAL = 163840;
constexpr int LDS_ROWS  = 131072;
constexpr int LDS_TAB   = 150528;
constexpr int LDS_MISC  = 163840 - 256;

typedef int i32x4 __attribute__((ext_vector_type(4)));
typedef int i32x8 __attribute__((ext_vector_type(8)));
__device__ __forceinline__ i32x8 cat8(const bf16x8 lo, const bf16x8 hi) { return __builtin_shufflevector(__builtin_bit_cast(i32x4, lo), __builtin_bit_cast(i32x4, hi), 0, 1, 2, 3, 4, 5, 6, 7); }
constexpr int F8_SCALE_W = 0x79797979;
constexpr int F8_SCALE_A = 0x7f7f7f7f;
constexpr float F8_WMUL = 64.0f;
__device__ __forceinline__ unsigned pack4_fp8(float a, float b, float c, float d) { int w = 0; w = __builtin_amdgcn_cvt_pk_fp8_f32(a, b, w, false); w = __builtin_amdgcn_cvt_pk_fp8_f32(c, d, w, true); return (unsigned)w; }
typedef float f32x2_t __attribute__((ext_vector_type(2)));
__device__ __forceinline__ void unpack8_fp8(const unsigned lo, const unsigned hi, float (&f)[8]) {
    const f32x2_t a = __builtin_amdgcn_cvt_pk_f32_fp8((int)lo, false), b = __builtin_amdgcn_cvt_pk_f32_fp8((int)lo, true), c = __builtin_amdgcn_cvt_pk_f32_fp8((int)hi, false), d = __builtin_amdgcn_cvt_pk_f32_fp8((int)hi, true);
    f[0] = a[0]; f[1] = a[1]; f[2] = b[0]; f[3] = b[1]; f[4] = c[0]; f[5] = c[1]; f[6] = d[0]; f[7] = d[1];
}
typedef _Float16 h16x2 __attribute__((ext_vector_type(2)));
__device__ __forceinline__ unsigned pack2_h16(float a, float b) { h16x2 h; h.x = (_Float16)a; h.y = (_Float16)b; return __builtin_bit_cast(unsigned, h); }
__device__ __forceinline__ void unpack2_h16(unsigned w, float& a, float& b) { const h16x2 h = __builtin_bit_cast(h16x2, w); a = (float)h.x; b = (float)h.y; }
typedef unsigned u32x2 __attribute__((ext_vector_type(2)));
typedef __bf16 bf16x2_t __attribute__((ext_vector_type(2)));
typedef float f32x2v_t __attribute__((ext_vector_type(2)));
__device__ __forceinline__ unsigned cvt_pk_bf16(float lo, float hi) { const f32x2v_t v = {lo, hi}; return __builtin_bit_cast(unsigned, __builtin_convertvector(v, bf16x2_t)); }
__device__ __forceinline__ void unpack8(const u32x4 v, float (&f)[8]) {
    f[0] = __uint_as_float(v.x << 16); f[1] = __uint_as_float(v.x & 0xffff0000u); f[2] = __uint_as_float(v.y << 16); f[3] = __uint_as_float(v.y & 0xffff0000u);
    f[4] = __uint_as_float(v.z << 16); f[5] = __uint_as_float(v.z & 0xffff0000u); f[6] = __uint_as_float(v.w << 16); f[7] = __uint_as_float(v.w & 0xffff0000u);
}
__device__ __forceinline__ u32x4 pack8(const float (&f)[8]) { u32x4 w; w.x = cvt_pk_bf16(f[0], f[1]); w.y = cvt_pk_bf16(f[2], f[3]); w.z = cvt_pk_bf16(f[4], f[5]); w.w = cvt_pk_bf16(f[6], f[7]); return w; }


__device__ __forceinline__ void phase_mod(const Params& p, LAS unsigned char* lds) {
    LAS float* sc = (LAS float*)lds;
    LAS float* red = sc + 9 * 128;
    float* MOD = (float*)(p.ws + WS_MOD);
    const int tid = threadIdx.x;
    for (int item = blockIdx.x; item < 768; item += gridDim.x) {
        const int cb = item % 48, kb = item / 48;
        __syncthreads();
        for (int i = tid; i < 9 * 128; i += 512) {
            const int r = i / 128, k = i % 128;
            const float v = r < 8 ? p.c[r * DM + kb * 128 + k] : p.c_ctx[kb * 128 + k];
            sc[r * 128 + k] = silu_f(v);
        }
        __syncthreads();
        const int col = cb * 256 + (tid & 255), kh = tid >> 8;
        float acc[9];
#pragma unroll
        for (int r = 0; r < 9; ++r) acc[r] = 0.f;
        const float* wp = p.w_mod + (size_t)(kb * 128 + kh * 64) * (NMOD * DM) + col;
#pragma unroll 8
        for (int k = 0; k < 64; ++k) {
            const float w = wp[(size_t)k * (NMOD * DM)];
#pragma unroll
            for (int r = 0; r < 9; ++r) acc[r] += sc[r * 128 + kh * 64 + k] * w;
        }
        if (kh == 1) {
#pragma unroll
            for (int r = 0; r < 9; ++r) red[(tid & 255) * 9 + r] = acc[r];
        }
        __syncthreads();
        if (kh == 0) {
            const float bias = kb == 0 ? p.b_mod[col] : 0.f;
#pragma unroll
            for (int r = 0; r < 9; ++r) atomicAdd(&MOD[r * (NMOD * DM) + col], acc[r] + red[tid * 9 + r] + bias);
        }
    }
    __syncthreads();
}
__device__ __forceinline__ void phase_postab(const Params& p) {
    float* pos = (float*)(p.ws + WS_POS);
    for (int i = blockIdx.x * 512 + threadIdx.x; i < 96 * 1024; i += gridDim.x * 512) {
        const int row = i / 1024, j = i % 1024, jj = j & 511;
        const float omega = 1.0f / powf(10000.0f, (float)jj / 512.0f);
        const float pv = row < 32 ? (float)row : (float)(row - 32);
        const float a = pv * omega;
        pos[i] = j < 512 ? sinf(a) : cosf(a);
    }
    float* rwt = (float*)(p.ws + WS_RWT);
    for (int i = blockIdx.x * 512 + threadIdx.x; i < 36 * DM; i += gridDim.x * 512) {
        const int k = i / 36, j = i % 36;
        rwt[j * DM + k] = j < 4 ? p.r1_w[k * 4 + j] : p.r2_w[k * 32 + (j - 4)];
    }
    bf16_t* rwh = (bf16_t*)(p.ws + WS_RWH);
    for (int i = blockIdx.x * 512 + threadIdx.x; i < 48 * DM; i += gridDim.x * 512) {
        const int j = i / DM, k = i % DM;
        const float w = j < 4 ? p.r1_w[k * 4 + j] : j < 36 ? p.r2_w[k * 32 + (j - 4)] : 0.f;
        const bf16_t hi = f2bf(w); const bf16_t lo = f2bf(w - bf2f(hi));
        rwh[i] = hi; rwh[48 * DM + i] = lo;
    }
    float* wgt = (float*)(p.ws + WS_WGT);
    for (int i = blockIdx.x * 512 + threadIdx.x; i < NGATE * DM; i += gridDim.x * 512) { const int k = i >> 4, g = i & 15; wgt[g * DM + k] = p.w_in[(size_t)k * DIN + 4096 + g]; }
}

#define GLDS16(gptr, lptr) __builtin_amdgcn_global_load_lds((const unsigned*)(gptr), (LAS unsigned*)(lptr), 16, 0, 0)
constexpr int HXB = 68 * 256;
__device__ __forceinline__ void hx_stage(const Params& p, LAS float* ldsf, int buf, int chunk, int rowb, int wid, int lane) {
    const float* MOD = (const float*)(p.ws + WS_MOD); const float* pos = (const float*)(p.ws + WS_POS); const float* wgt = (const float*)(p.ws + WS_WGT);
    LAS float* xb = ldsf + buf * HXB; LAS float* pb = xb + 24 * 256; LAS float* mb = xb + 48 * 256; LAS float* wb = xb + 52 * 256;
    const int co = chunk * 256 + lane * 4;
#pragma unroll
    for (int r = 0; r < 3; ++r) { const int row = rowb + wid * 3 + r; const bool isx = row < NTOK; const int ts = row % SEQ;
        GLDS16((isx ? p.x + (size_t)row * DM : p.ctx + (size_t)(row - NTOK) * DM) + co, xb + (wid * 3 + r) * 256);
        if (isx) GLDS16((chunk < 4 ? pos + (ts >> 6) * 1024 : pos + 32 * 1024 + (ts & 63) * 1024 - 1024) + co, pb + (wid * 3 + r) * 256); }
    if (wid < 4) { const int row = (wid & 2) ? rowb + 23 : rowb; const int b = row < NTOK ? row / SEQ : 8;
        GLDS16(MOD + (size_t)b * (NMOD * DM) + ((wid & 1) ? 0 : DM) + co, mb + wid * 256); }
    for (int j = wid; j < 16; j += 8) GLDS16(wgt + (size_t)j * DM + co, wb + j * 256);
}
__device__ __forceinline__ void phase_hx(const Params& p, LAS unsigned char* lds) {
    bf16_t* HX = (bf16_t*)(p.ws + WS_HX); unsigned char* HX8 = (unsigned char*)(p.ws + WS_HX8);
    float* G = (float*)(p.ws + WS_GATES);
    LAS float* ldsf = (LAS float*)lds;
    const int tid = threadIdx.x, lane = tid & 63, wid = __builtin_amdgcn_readfirstlane(tid >> 6);
    for (int bt = blockIdx.x; bt < NROWS / 24; bt += gridDim.x) {
        const int rowb = bt * 24, row0 = rowb + wid * 3;
        const int bfirst = rowb < NTOK ? rowb / SEQ : 8;
        bool isx[3]; int pset[3];
#pragma unroll
        for (int r = 0; r < 3; ++r) { const int row = row0 + r; isx[r] = row < NTOK; pset[r] = ((row < NTOK ? row / SEQ : 8) != bfirst) ? 2 : 0; }
        float acc[3][NGATE];
#pragma unroll
        for (int r = 0; r < 3; ++r)
#pragma unroll
            for (int g = 0; g < NGATE; ++g) acc[r][g] = 0.f;
        asm volatile("s_waitcnt vmcnt(0) lgkmcnt(0)" ::: "memory"); __builtin_amdgcn_s_barrier();
        hx_stage(p, ldsf, 0, 0, rowb, wid, lane);
#pragma unroll 1
        for (int chunk = 0; chunk < 8; ++chunk) {
            asm volatile("s_waitcnt vmcnt(0) lgkmcnt(0)" ::: "memory"); __builtin_amdgcn_s_barrier();
            if (chunk < 7) hx_stage(p, ldsf, (chunk + 1) & 1, chunk + 1, rowb, wid, lane);
            const LAS float* xb = ldsf + (chunk & 1) * HXB + lane * 4; const LAS float* pb = xb + 24 * 256; const LAS float* mb = xb + 48 * 256; const LAS float* wb = xb + 52 * 256;
            const int col = chunk * 256 + lane * 4;
            f32x4 hv[3];
#pragma unroll
            for (int r = 0; r < 3; ++r) { f32x4 v = *(const LAS f32x4*)(xb + (wid * 3 + r) * 256);
                if (isx[r]) v += *(const LAS f32x4*)(pb + (wid * 3 + r) * 256);
                hv[r] = v * (*(const LAS f32x4*)(mb + pset[r] * 256) + 1.0f) + *(const LAS f32x4*)(mb + (pset[r] + 1) * 256);
                u32x2 o; o.x = cvt_pk_bf16(hv[r][0], hv[r][1]); o.y = cvt_pk_bf16(hv[r][2], hv[r][3]);
                *(u32x2*)(HX + (size_t)(row0 + r) * DM + col) = o;
                if (isx[r]) *(unsigned*)(HX8 + (size_t)(row0 + r) * DM + col) = pack4_fp8(hv[r][0], hv[r][1], hv[r][2], hv[r][3]); }
#pragma unroll
            for (int g = 0; g < NGATE; ++g) { const f32x4 w = *(const LAS f32x4*)(wb + g * 256);
#pragma unroll
                for (int r = 0; r < 3; ++r) acc[r][g] += hv[r][0] * w[0] + hv[r][1] * w[1] + hv[r][2] * w[2] + hv[r][3] * w[3]; }
        }
        {
            float v24[24], v12[12], v6[6];
            const bool h5 = lane & 32, h4 = lane & 16, h3 = lane & 8, h2 = lane & 4;
#pragma unroll
            for (int f = 0; f < 24; ++f) { const float lo = acc[f / 16][f % 16], hi = acc[(f + 24) / 16][(f + 24) % 16]; v24[f] = (h5 ? hi : lo) + __shfl_xor(h5 ? lo : hi, 32, 64); }
#pragma unroll
            for (int f = 0; f < 12; ++f) v12[f] = (h4 ? v24[f + 12] : v24[f]) + __shfl_xor(h4 ? v24[f] : v24[f + 12], 16, 64);
#pragma unroll
            for (int f = 0; f < 6; ++f) v6[f] = (h3 ? v12[f + 6] : v12[f]) + __shfl_xor(h3 ? v12[f] : v12[f + 6], 8, 64);
            const int f0 = (h5 ? 24 : 0) + (h4 ? 12 : 0) + (h3 ? 6 : 0) + (h2 ? 3 : 0);
#pragma unroll
            for (int f = 0; f < 3; ++f) { float x = (h2 ? v6[f + 3] : v6[f]) + __shfl_xor(h2 ? v6[f] : v6[f + 3], 4, 64); x += __shfl_xor(x, 2, 64); x += __shfl_xor(x, 1, 64);
                if ((lane & 3) == 0) { const int ff = f0 + f, r = ff >> 4, g = ff & 15; float v = x + p.gate_bias[g]; if ((g >> 2) & 1) v = logsigmoid_f(v); G[(size_t)(row0 + r) * NGATE + g] = v; } }
        }
    }
    asm volatile("s_waitcnt vmcnt(0) lgkmcnt(0)" ::: "memory"); __builtin_amdgcn_s_barrier();
}

constexpr int L1_X = 0, L1_P = 16384, L1_W = 16384 + 4096, L1_BUF = L1_W + 2 * 24576, L1_RED = 2 * L1_BUF;
constexpr int L1_LG = L1_RED;
__device__ __forceinline__ void ln1_stage(const Params& p, LAS unsigned char* lds, int buf, int chunk, int tokb, int b, int wid, int lane) {
    const bf16_t* X1 = (const bf16_t*)(p.ws + WS_X1); const bf16_t* RW = (const bf16_t*)(p.ws + WS_RWH); const float* MOD = (const float*)(p.ws + WS_MOD);
    LAS unsigned char* base = lds + buf * L1_BUF;
#pragma unroll
    for (int r2 = 0; r2 < 2; ++r2) { const int row = wid * 4 + 2 * r2 + (lane >> 5); const int gc = (lane & 31) ^ (row & 31);
        GLDS16(X1 + (size_t)(tokb + row) * DM + chunk * 256 + gc * 8, base + L1_X + (wid * 4 + 2 * r2) * 512); }
#pragma unroll
    for (int q = 0; q < 6; ++q) { const int rr = (wid * 6 + q) * 2 + (lane >> 5); const int n = rr % 48; const int gc = (lane & 31) ^ (n & 31);
        GLDS16(RW + (size_t)rr * DM + chunk * 256 + gc * 8, base + L1_W + (wid * 6 + q) * 1024); }
    const int cf = chunk * 256 + lane * 4;
    if (wid == 4) GLDS16(p.ln1_w + cf, base + L1_P);
    if (wid == 5) GLDS16(p.ln1_b + cf, base + L1_P + 1024);
    if (wid == 6) GLDS16(MOD + (size_t)b * (NMOD * DM) + 4 * DM + cf, base + L1_P + 2048);
    if (wid == 7) GLDS16(MOD + (size_t)b * (NMOD * DM) + 3 * DM + cf, base + L1_P + 3072);
}
__device__ __forceinline__ void phase_ln1(const Params& p, LAS unsigned char* lds) {
    const float* ST = (const float*)(p.ws + WS_STATS);
    unsigned char* T = (unsigned char*)(p.ws + WS_T);
    unsigned* cnt = (unsigned*)(p.ws + WS_CTL) + CW_CNT;
    int* list = (int*)(p.ws + WS_LIST);
    float* RT = (float*)(p.ws + WS_RT);
    LAS float* ldsf = (LAS float*)lds;
    const int tid = threadIdx.x, lane = tid & 63, wid = __builtin_amdgcn_readfirstlane(tid >> 6), li_ = lane & 15, lg = lane >> 4;
    for (int rb = blockIdx.x; rb < NTOK / 32; rb += gridDim.x) {
        const int tokb = rb * 32, b = tokb / SEQ, row0 = tokb + wid * 4;
        float mean[2], rstd[2];
#pragma unroll
        for (int m = 0; m < 2; ++m) { const float s1 = ST[(size_t)(tokb + 16 * m + li_) * 2], s2 = ST[(size_t)(tokb + 16 * m + li_) * 2 + 1];
            mean[m] = s1 * (1.0f / DM); rstd[m] = rsqrtf(fmaxf(s2 * (1.0f / DM) - mean[m] * mean[m], 0.f) + LN_EPS); }
        f32x4 acc[2][3];
#pragma unroll
        for (int m = 0; m < 2; ++m)
#pragma unroll
            for (int n = 0; n < 3; ++n) acc[m][n] = (f32x4){0.f, 0.f, 0.f, 0.f};
        asm volatile("s_waitcnt vmcnt(0) lgkmcnt(0)" ::: "memory"); __builtin_amdgcn_s_barrier();
        ln1_stage(p, lds, 0, 0, tokb, b, wid, lane);
#pragma unroll 1
        for (int chunk = 0; chunk < 8; ++chunk) {
            asm volatile("s_waitcnt vmcnt(0) lgkmcnt(0)" ::: "memory"); __builtin_amdgcn_s_barrier();
            if (chunk < 7) ln1_stage(p, lds, (chunk + 1) & 1, chunk + 1, tokb, b, wid, lane);
            const LAS unsigned char* base = lds + (chunk & 1) * L1_BUF;
            const int kc = 4 * wid + lg;
            const LAS float* pp = (const LAS float*)(base + L1_P) + kc * 8;
            const f32x4 lw0 = *(const LAS f32x4*)(pp), lw1 = *(const LAS f32x4*)(pp + 4), lb0 = *(const LAS f32x4*)(pp + 256), lb1 = *(const LAS f32x4*)(pp + 260);
            const f32x4 sc0 = *(const LAS f32x4*)(pp + 512) + 1.0f, sc1 = *(const LAS f32x4*)(pp + 516) + 1.0f, sh0 = *(const LAS f32x4*)(pp + 768), sh1 = *(const LAS f32x4*)(pp + 772);
            bf16x8 ahi[2], alo[2];
#pragma unroll
            for (int m = 0; m < 2; ++m) { const int row = 16 * m + li_;
                const u32x4 xw = *(const LAS u32x4*)(base + L1_X + row * 512 + ((kc ^ (row & 31)) << 4));
                float x[8]; unpack2_h16(xw.x, x[0], x[1]); unpack2_h16(xw.y, x[2], x[3]); unpack2_h16(xw.z, x[4], x[5]); unpack2_h16(xw.w, x[6], x[7]);
                float t[8];
#pragma unroll
                for (int j = 0; j < 4; ++j) { t[j] = ((x[j] - mean[m]) * rstd[m] * lw0[j] + lb0[j]) * sc0[j] + sh0[j]; t[4 + j] = ((x[4 + j] - mean[m]) * rstd[m] * lw1[j] + lb1[j]) * sc1[j] + sh1[j]; }
                u32x2 tw; tw.x = pack4_fp8(t[0], t[1], t[2], t[3]); tw.y = pack4_fp8(t[4], t[5], t[6], t[7]);
                *(u32x2*)(T + (size_t)(tokb + row) * DM + chunk * 256 + kc * 8) = tw;
                u32x4 hw, lw_; float r_[8];
                hw.x = cvt_pk_bf16(t[0], t[1]); hw.y = cvt_pk_bf16(t[2], t[3]); hw.z = cvt_pk_bf16(t[4], t[5]); hw.w = cvt_pk_bf16(t[6], t[7]);
                unpack8(hw, r_);
#pragma unroll
                for (int j = 0; j < 8; ++j) r_[j] = t[j] - r_[j];
                lw_.x = cvt_pk_bf16(r_[0], r_[1]); lw_.y = cvt_pk_bf16(r_[2], r_[3]); lw_.z = cvt_pk_bf16(r_[4], r_[5]); lw_.w = cvt_pk_bf16(r_[6], r_[7]);
                ahi[m] = __builtin_bit_cast(bf16x8, hw); alo[m] = __builtin_bit_cast(bf16x8, lw_); }
#pragma unroll
            for (int n = 0; n < 3; ++n) { const int rown = 16 * n + li_;
                const bf16x8 bhi = *(const LAS bf16x8*)(base + L1_W + rown * 512 + ((kc ^ (rown & 31)) << 4));
                const bf16x8 blo = *(const LAS bf16x8*)(base + L1_W + 24576 + rown * 512 + ((kc ^ (rown & 31)) << 4));
#pragma unroll
                for (int m = 0; m < 2; ++m) {
                    acc[m][n] = __builtin_amdgcn_mfma_f32_16x16x32_bf16(ahi[m], bhi, acc[m][n], 0, 0, 0);
                    acc[m][n] = __builtin_amdgcn_mfma_f32_16x16x32_bf16(ahi[m], blo, acc[m][n], 0, 0, 0);
                    acc[m][n] = __builtin_amdgcn_mfma_f32_16x16x32_bf16(alo[m], bhi, acc[m][n], 0, 0, 0); } }
        }
        asm volatile("s_waitcnt vmcnt(0) lgkmcnt(0)" ::: "memory"); __builtin_amdgcn_s_barrier();
        {   LAS float* red = (LAS float*)lds + wid * (32 * 48);
#pragma unroll
            for (int m = 0; m < 2; ++m)
#pragma unroll
                for (int n = 0; n < 3; ++n)
#pragma unroll
                    for (int j = 0; j < 4; ++j) red[(16 * m + 4 * lg + j) * 48 + 16 * n + li_] = acc[m][n][j]; }
        asm volatile("s_waitcnt lgkmcnt(0)" ::: "memory"); __builtin_amdgcn_s_barrier();
        LAS float* lgt = (LAS float*)(lds + L1_LG);
        for (int i = tid; i < 32 * 36; i += 512) { const int tkn = i / 36, j = i % 36; float sum = 0.f;
#pragma unroll
            for (int w = 0; w < 8; ++w) sum += ((const LAS float*)lds)[w * (32 * 48) + tkn * 48 + j];
            lgt[i] = sum; }
        asm volatile("s_waitcnt lgkmcnt(0)" ::: "memory"); __builtin_amdgcn_s_barrier();
        LAS int* esel = (LAS int*)(lds + L1_LG + 32 * 36 * 4);
        if (lane < 4) {
            const int tok = row0 + lane;
            const LAS float* lg = lgt + (wid * 4 + lane) * 36;
            int grp = 0; float l1[4];
#pragma unroll
            for (int j = 0; j < 4; ++j) l1[j] = lg[j] + p.r1_b[j];
            float best = l1[0];
#pragma unroll
            for (int j = 1; j < 4; ++j) if (l1[j] > best) { best = l1[j]; grp = j; }
            float se = 0.f;
#pragma unroll
            for (int j = 0; j < 4; ++j) se += __expf(l1[j] - best);
            const float pg = 1.0f / se;
            float v0 = -3.0e38f, v1 = -3.0e38f; int i0 = 0, i1 = 0;
#pragma unroll
            for (int j = 0; j < 8; ++j) {
                const float l = lg[4 + grp * 8 + j] + p.r2_b[grp * 8 + j];
                if (l > v0) { v1 = v0; i1 = i0; v0 = l; i0 = j; } else if (l > v1) { v1 = l; i1 = j; }
            }
            const float ex = __expf(v1 - v0);
            RT[tok * 2 + 0] = pg / (1.0f + ex); RT[tok * 2 + 1] = pg * ex / (1.0f + ex);
            esel[(wid * 4 + lane) * 2 + 0] = grp * 8 + i0; esel[(wid * 4 + lane) * 2 + 1] = grp * 8 + i1;
        }
        asm volatile("s_waitcnt lgkmcnt(0)" ::: "memory"); __builtin_amdgcn_s_barrier();
        if (tid < 32) {
            int c = 0;
            for (int i = 0; i < 64; ++i) c += (esel[i] == tid) ? 1 : 0;
            esel[64 + tid] = c > 0 ? (int)atomicAdd(&cnt[tid], (unsigned)c) : 0;
        }
        asm volatile("s_waitcnt vmcnt(0) lgkmcnt(0)" ::: "memory"); __builtin_amdgcn_s_barrier();
        if (tid < 64) {
            const int e = esel[tid]; int lr = 0;
            for (int i = 0; i < tid; ++i) lr += (esel[i] == e) ? 1 : 0;
            list[(size_t)e * NTOK + esel[64 + e] + lr] = (rb * 32 + (tid >> 1)) * 2 + (tid & 1);
        }
    }
    asm volatile("s_waitcnt vmcnt(0) lgkmcnt(0)" ::: "memory"); __builtin_amdgcn_s_barrier();
}

struct FinRaw { u32x2 ya[4], yb[4]; u32x4 x[4]; u32x2 g, st; };
__device__ __forceinline__ void fin_request(const Params& p, int tok, int lane, FinRaw& r) {
    const bf16_t* X1 = (const bf16_t*)(p.ws + WS_X1); const unsigned char* Y2 = (const unsigned char*)(p.ws + WS_Y2);
    const float* RT = (const float*)(p.ws + WS_RT); const float* ST = (const float*)(p.ws + WS_STATS);
#pragma unroll
    for (int i = 0; i < 4; ++i) { const int col = i * 512 + lane * 8;
        const unsigned char* a0 = Y2 + (size_t)(tok * 2) * DM + col; const unsigned char* a1 = a0 + DM; const bf16_t* a2 = X1 + (size_t)tok * DM + col;
        asm volatile("global_load_dwordx2 %0, %1, off" : "=v"(r.ya[i]) : "v"(a0) : "memory");
        asm volatile("global_load_dwordx2 %0, %1, off" : "=v"(r.yb[i]) : "v"(a1) : "memory");
        asm volatile("global_load_dwordx4 %0, %1, off" : "=v"(r.x[i]) : "v"(a2) : "memory"); }
    { const float* a3 = RT + tok * 2; const float* a4 = ST + (size_t)tok * 2;
      asm volatile("global_load_dwordx2 %0, %1, off" : "=v"(r.g) : "v"(a3) : "memory");
      asm volatile("global_load_dwordx2 %0, %1, off" : "=v"(r.st) : "v"(a4) : "memory"); }
}
__device__ __forceinline__ void phase_final(const Params& p, LAS unsigned char* lds) {
    const float* MOD = (const float*)(p.ws + WS_MOD);
    const int tid = threadIdx.x, lane = tid & 63, wid = __builtin_amdgcn_readfirstlane(tid >> 6);
    LAS float* PRM = (LAS float*)lds;
    LAS float* GT = PRM + 4 * DM;
    asm volatile("s_waitcnt vmcnt(0) lgkmcnt(0)" ::: "memory"); __builtin_amdgcn_s_barrier();
    {   const int col = tid * 4; const int pidx = (((col >> 9) * 2 + ((col >> 2) & 1)) * 64 + ((col & 511) >> 3)) * 4;
        *(LAS f32x4*)(PRM + pidx) = *(const f32x4*)(p.ln1_w + col) * ALPHA; *(LAS f32x4*)(PRM + DM + pidx) = *(const f32x4*)(p.ln1_b + col) * ALPHA;
        *(LAS f32x4*)(PRM + 2 * DM + pidx) = *(const f32x4*)(p.ln2_w + col); *(LAS f32x4*)(PRM + 3 * DM + pidx) = *(const f32x4*)(p.ln2_b + col);
#pragma unroll
        for (int b = 0; b < NB; ++b) *(LAS f32x4*)(GT + b * DM + pidx) = *(const f32x4*)(MOD + (size_t)b * (NMOD * DM) + 5 * DM + col);
    }
    asm volatile("s_waitcnt vmcnt(0) lgkmcnt(0)" ::: "memory"); __builtin_amdgcn_s_barrier();
    const int stride = gridDim.x * 8;
    int tok = blockIdx.x * 8 + wid;
    if (tok >= NTOK) return;
    FinRaw r; fin_request(p, tok, lane, r);
    bool first = true;
#pragma unroll 1
    for (; tok < NTOK; tok += stride) {
        if (first) asm volatile("s_waitcnt vmcnt(0)" ::: "memory"); else asm volatile("s_waitcnt vmcnt(8)" ::: "memory");
        first = false;
        const LAS float* gt = GT + (tok / SEQ) * DM;
        const unsigned ug0 = r.g.x, ug1 = r.g.y, us1 = r.st.x, us2 = r.st.y;
        const float g0 = __uint_as_float(ug0) * 0.0625f, g1 = __uint_as_float(ug1) * 0.0625f;
        const float st1 = __uint_as_float(us1), st2 = __uint_as_float(us2);
        const float mean1 = st1 * (1.0f / DM), rstd1 = rsqrtf(fmaxf(st2 * (1.0f / DM) - mean1 * mean1, 0.f) + LN_EPS);
        float v[32]; float s = 0.f;
#pragma unroll
        for (int i = 0; i < 4; ++i) {
            float ya[8], yb[8]; unpack8_fp8(r.ya[i].x, r.ya[i].y, ya); unpack8_fp8(r.yb[i].x, r.yb[i].y, yb);
            float xr[8]; unpack2_h16(r.x[i].x, xr[0], xr[1]); unpack2_h16(r.x[i].y, xr[2], xr[3]); unpack2_h16(r.x[i].z, xr[4], xr[5]); unpack2_h16(r.x[i].w, xr[6], xr[7]);
            const int o0 = (i * 2 * 64 + lane) * 4, o1 = o0 + 256;
            const f32x4 xa = ((f32x4){xr[0], xr[1], xr[2], xr[3]} - mean1) * rstd1 * *(const LAS f32x4*)(PRM + o0) + *(const LAS f32x4*)(PRM + DM + o0);
            const f32x4 xb = ((f32x4){xr[4], xr[5], xr[6], xr[7]} - mean1) * rstd1 * *(const LAS f32x4*)(PRM + o1) + *(const LAS f32x4*)(PRM + DM + o1);
            const f32x4 ga = *(const LAS f32x4*)(gt + o0), gb = *(const LAS f32x4*)(gt + o1);
#pragma unroll
            for (int j = 0; j < 4; ++j) { v[i * 8 + j] = xa[j] + ga[j] * (g0 * ya[j] + g1 * yb[j]); v[i * 8 + 4 + j] = xb[j] + gb[j] * (g0 * ya[4 + j] + g1 * yb[4 + j]); }
#pragma unroll
            for (int j = 0; j < 8; ++j) s += v[i * 8 + j];
        }
        {   const int tn = tok + stride < NTOK ? tok + stride : tok;
            fin_request(p, tn, lane, r); }
        const float mu = wave_sum(s) * (1.0f / DM);
        float q = 0.f;
#pragma unroll
        for (int i = 0; i < 32; ++i) { const float dlt = v[i] - mu; q += dlt * dlt; }
        const float rstd = rsqrtf(wave_sum(q) * (1.0f / DM) + LN_EPS);
#pragma unroll
        for (int i = 0; i < 4; ++i) {
            const int col = i * 512 + lane * 8;
            const int o0 = (i * 2 * 64 + lane) * 4, o1 = o0 + 256;
            const f32x4 wa = *(const LAS f32x4*)(PRM + 2 * DM + o0), wb = *(const LAS f32x4*)(PRM + 2 * DM + o1), ba = *(const LAS f32x4*)(PRM + 3 * DM + o0), bb = *(const LAS f32x4*)(PRM + 3 * DM + o1);
            f32x4 oa, ob;
#pragma unroll
            for (int j = 0; j < 4; ++j) { oa[j] = (v[i * 8 + j] - mu) * rstd * wa[j] + ba[j]; ob[j] = (v[i * 8 + 4 + j] - mu) * rstd * wb[j] + bb[j]; }
            *(f32x4*)(p.out + (size_t)tok * DM + col) = oa; *(f32x4*)(p.out + (size_t)tok * DM + col + 4) = ob;
        }
    }
    asm volatile("s_waitcnt vmcnt(0)" ::: "memory");
}

__device__ __forceinline__ void conv_item_src(const Params& p, int item, const float*& src, int& ld, unsigned char*& dst, int& K, bool& f8) {
    f8 = false;
    if (item < 1536) {
        const int nt = item % 48, kt = item / 48; const int n0 = nt * 128, sc = n0 < 4096 ? n0 : n0 + NGATE;
        ld = DIN; K = DM; src = p.w_in + (size_t)(kt * 64) * DIN + sc;
        if (n0 >= 3072 && n0 < 4096) { dst = (unsigned char*)(p.ws + WS_BTIN) + (size_t)3072 * DM * 2 + (size_t)(n0 - 3072) * DM + kt * 64; f8 = true; }
        else if (n0 >= 5120) { dst = (unsigned char*)(p.ws + WS_BTIN) + (size_t)5120 * DM * 2 + (size_t)(n0 - 5120) * DM + kt * 64; f8 = true; }
        else dst = (unsigned char*)(p.ws + WS_BTIN) + ((size_t)n0 * DM + kt * 64) * 2;
        return;
    }
    item -= 1536;
    if (item < 512) {
        const int nt = item % 16, kt = item / 16;
        ld = DM; K = DM; src = p.w_out + (size_t)(kt * 64) * DM + nt * 128; dst = (unsigned char*)(p.ws + WS_BTOUT) + ((size_t)(nt * 128) * DM + kt * 64) * 2; return;
    }
    item -= 512;
    if (item < 16384) {
        const int kt = item & 31, pn = (item >> 5) & 7, which = (item >> 8) & 1, e = item >> 9;
        ld = DE; K = DM; src = (which ? p.w_up : p.w_gate) + (size_t)e * DM * DE + (size_t)(kt * 64) * DE + pn * 128;
        dst = (unsigned char*)(p.ws + WS_BTGU) + ((size_t)(e * 8 + pn) * 256 + which * 128) * DM + kt * 64; f8 = true; return;
    }
    item -= 16384;
    {
        const int kt = item & 15, nt = (item >> 4) & 15, e = item >> 8;
        ld = DM; K = DE; src = p.w_down + (size_t)e * DE * DM + (size_t)(kt * 64) * DM + nt * 128;
        dst = (unsigned char*)(p.ws + WS_BTDN) + ((size_t)e * DM + nt * 128) * DE + kt * 64; f8 = true;
    }
}
constexpr int CONV_ITEMS_ALL = 1536 + 512 + 16384 + 8192;
constexpr int CT_B1 = 18;
constexpr int CONV_TAIL = 128 * CT_B1;
__device__ __forceinline__ void phase_convert(const Params& p, LAS unsigned char* lds, const int first, const int CONV_ITEMS, const int start, const int stride) {
    LAS float* tile = (LAS float*)lds;
    const int tid = threadIdx.x;
    float4 r[4];
    int item = first + start;
    const float* src; int ld; unsigned char* dst; int K; bool f8;
    if (item < CONV_ITEMS) {
        conv_item_src(p, item, src, ld, dst, K, f8);
#pragma unroll
        for (int i = 0; i < 4; ++i) { const int idx = tid + 512 * i; r[i] = *(const float4*)(src + (size_t)(idx >> 5) * ld + (idx & 31) * 4); }
    }
    for (; item < CONV_ITEMS; item += stride) {
        __syncthreads();
#pragma unroll
        for (int i = 0; i < 4; ++i) { const int idx = tid + 512 * i; LAS float* t = tile + (idx >> 5) * 129 + (idx & 31) * 4; t[0] = r[i].x; t[1] = r[i].y; t[2] = r[i].z; t[3] = r[i].w; }
        unsigned char* cdst = dst; const int cK = K; const bool cf8 = f8;
        const int nitem = item + stride;
        if (nitem < CONV_ITEMS) {
            conv_item_src(p, nitem, src, ld, dst, K, f8);
#pragma unroll
            for (int i = 0; i < 4; ++i) { const int idx = tid + 512 * i; r[i] = *(const float4*)(src + (size_t)(idx >> 5) * ld + (idx & 31) * 4); }
        }
        __syncthreads();
#pragma unroll
        for (int i = 0; i < 2; ++i) {
            const int o = tid + 512 * i, kg = o & 7, n = o >> 3;
            const LAS float* t = tile + (kg * 8) * 129 + n;
            if (cf8) { u32x2 w;
                w.x = pack4_fp8(t[0 * 129] * F8_WMUL, t[1 * 129] * F8_WMUL, t[2 * 129] * F8_WMUL, t[3 * 129] * F8_WMUL);
                w.y = pack4_fp8(t[4 * 129] * F8_WMUL, t[5 * 129] * F8_WMUL, t[6 * 129] * F8_WMUL, t[7 * 129] * F8_WMUL);
                *(u32x2*)(cdst + (size_t)n * cK + kg * 8) = w;
            } else { u32x4 w;
                w.x = cvt_pk_bf16(t[0 * 129], t[1 * 129]); w.y = cvt_pk_bf16(t[2 * 129], t[3 * 129]);
                w.z = cvt_pk_bf16(t[4 * 129], t[5 * 129]); w.w = cvt_pk_bf16(t[6 * 129], t[7 * 129]);
                *(u32x4*)(cdst + ((size_t)n * cK + kg * 8) * 2) = w; }
        }
    }
    __syncthreads();
}

namespace pg8 {
constexpr int BM = 256, BK = 64, HALF = 128, HTB = HALF * BK * 2, STAGE_BYTES = 8 * HTB;
__device__ __forceinline__ int lds_byte(int r, int c) { const int st = (r >> 4) * 2 + (c >> 5), rr = r & 15, cc = c & 31, ob = rr * 64 + cc * 2; return st * 1024 + (ob ^ (((ob >> 9) & 1) << 5)); }
__device__ __forceinline__ void stage_rc(int b, int& R, int& C) { const int st = b / 1024, sb = b % 1024, swz = sb ^ (((sb >> 9) & 1) << 5); R = (st >> 1) * 16 + swz / 64; C = (st & 1) * 32 + (swz % 64) / 2; }
__device__ __forceinline__ int perm32(int rho) { const int n = rho >> 4, i = rho & 15; return 8 * (i >> 2) + 4 * n + (i & 3); }

struct Unit {
    const char* a;
    const char* b;
    const int* rows;
    int rows_lds;
    int nvalid;
    int pm, pn, e, aux;
};

template <bool PERM, bool F8, class Epi, class Sched>
__device__ __forceinline__ void gemm_phase(LAS unsigned char* lds, const int KB, const Sched& S, const Epi& E) {
    const int tid = threadIdx.x, wid = __builtin_amdgcn_readfirstlane(tid >> 6), lane = tid & 63, wr = wid >> 2, wc = wid & 3, fr = lane & 15, fq = lane >> 4;
    const int nt = KB / 128;
    unsigned vb0, vb1;
    { int Rr[2], Cc[2]; stage_rc(tid * 16, Rr[0], Cc[0]); stage_rc(tid * 16 + 8192, Rr[1], Cc[1]);
      const int Rb0 = PERM ? ((Rr[0] & ~31) + perm32(Rr[0] & 31)) : Rr[0], Rb1 = PERM ? ((Rr[1] & ~31) + perm32(Rr[1] & 31)) : Rr[1];
      vb0 = (unsigned)(Rb0 * KB + 2 * Cc[0]); vb1 = (unsigned)(Rb1 * KB + 2 * Cc[1]); }
    const size_t kstep = (size_t)(BK * 2);
    const size_t hstepB = (size_t)HALF * KB;
    const unsigned ldsw = (unsigned)wid * 1024u;
    const int aoff = lds_byte(wr * 64 + fr, fq * 8), boff = lds_byte(wc * 32 + fr, fq * 8);
#define PG8_SA(b, h) (((b) * 2 + (h)) * HTB)
#define PG8_SB(b, h) ((4 + (b) * 2 + (h)) * HTB)
#define PG8_STAGE2(bufoff, gbase, v0, v1) do { \
        __builtin_amdgcn_global_load_lds((const unsigned*)((const char*)(gbase) + (v0)), (LAS unsigned*)(lds + (bufoff) + ldsw), 16, 0, 0); \
        __builtin_amdgcn_global_load_lds((const unsigned*)((const char*)(gbase) + (v1)), (LAS unsigned*)(lds + (bufoff) + ldsw + 8192), 16, 0, 0); } while (0)
#define PG8_LD16(off) (*(const LAS i32x4*)(lds + (off)))
#define PG8_LDA(dst, b, h) do { if constexpr (F8) { _Pragma("unroll") for (int m = 0; m < 4; ++m) dst##8[m] = __builtin_shufflevector(PG8_LD16(PG8_SA(b, h) + aoff + m * 2048), PG8_LD16(PG8_SA(b, h) + aoff + m * 2048 + 1024), 0, 1, 2, 3, 4, 5, 6, 7); } \
        else { _Pragma("unroll") for (int m = 0; m < 4; ++m) _Pragma("unroll") for (int k = 0; k < 2; ++k) dst[m][k] = *(const LAS bf16x8*)(lds + PG8_SA(b, h) + aoff + m * 2048 + k * 1024); } } while (0)
#define PG8_LDB(dst, b, h) do { if constexpr (F8) { _Pragma("unroll") for (int n = 0; n < 2; ++n) dst##8[n] = __builtin_shufflevector(PG8_LD16(PG8_SB(b, h) + boff + n * 2048), PG8_LD16(PG8_SB(b, h) + boff + n * 2048 + 1024), 0, 1, 2, 3, 4, 5, 6, 7); } \
        else { _Pragma("unroll") for (int n = 0; n < 2; ++n) _Pragma("unroll") for (int k = 0; k < 2; ++k) dst[n][k] = *(const LAS bf16x8*)(lds + PG8_SB(b, h) + boff + n * 2048 + k * 1024); } } while (0)
#define PG8_MMA(ai, bj, At, Bt) do { __builtin_amdgcn_s_setprio(1); \
        if constexpr (F8) { _Pragma("unroll") for (int m = 0; m < 4; ++m) _Pragma("unroll") for (int n = 0; n < 2; ++n) \
            asm volatile("v_mfma_scale_f32_16x16x128_f8f6f4 %0, %1, %2, %0, %3, %4 op_sel_hi:[0,0,0]" : "+v"(acc[ai][bj][m][n]) : "v"(Bt##8[n]), "v"(At##8[m]), "v"(f8sw), "v"(f8sa)); } \
        else { _Pragma("unroll") for (int m = 0; m < 4; ++m) _Pragma("unroll") for (int n = 0; n < 2; ++n) _Pragma("unroll") for (int k = 0; k < 2; ++k) \
            acc[ai][bj][m][n] = __builtin_amdgcn_mfma_f32_16x16x32_bf16(Bt[n][k], At[m][k], acc[ai][bj][m][n], 0, 0, 0); } \
        __builtin_amdgcn_s_setprio(0); } while (0)
#define PG8_WAIT_V(n) asm volatile("s_waitcnt vmcnt(" #n ")" ::: "memory")
#define PG8_WAIT_L(n) asm volatile("s_waitcnt lgkmcnt(" #n ")" ::: "memory")
#define PG8_BAR __builtin_amdgcn_s_barrier()
#define PG8_SCHED __builtin_amdgcn_sched_barrier(0)
#define PG8_VOFF(u, v00, v01, v10, v11) do { int Rr[2], Cc[2]; int tq = tid; asm volatile("" : "+v"(tq)); stage_rc(tq * 16, Rr[0], Cc[0]); stage_rc(tq * 16 + 8192, Rr[1], Cc[1]); \
        if ((u).rows_lds >= 0) { const int nvm = (u).nvalid - 1; const LAS int* rl_ = (const LAS int*)(lds + (u).rows_lds); \
            const int r00 = Rr[0] < nvm ? Rr[0] : nvm, r01 = Rr[1] < nvm ? Rr[1] : nvm, r10 = (Rr[0] + 128) < nvm ? (Rr[0] + 128) : nvm, r11 = (Rr[1] + 128) < nvm ? (Rr[1] + 128) : nvm; \
            v00 = (unsigned)((rl_[r00] >> 1) * KB + 2 * Cc[0]); v01 = (unsigned)((rl_[r01] >> 1) * KB + 2 * Cc[1]); \
            v10 = (unsigned)((rl_[r10] >> 1) * KB + 2 * Cc[0]); v11 = (unsigned)((rl_[r11] >> 1) * KB + 2 * Cc[1]); \
        } else { v00 = (unsigned)(Rr[0] * KB + 2 * Cc[0]); v01 = (unsigned)(Rr[1] * KB + 2 * Cc[1]); v10 = (unsigned)((Rr[0] + 128) * KB + 2 * Cc[0]); v11 = (unsigned)((Rr[1] + 128) * KB + 2 * Cc[1]); } } while (0)
    Unit cur, nxt; int ui = 0;
    if (!S.next(0, cur)) return;
    f32x4 acc[2][2][4][2];
#pragma unroll
    for (int a = 0; a < 2; ++a)
#pragma unroll
        for (int b = 0; b < 2; ++b)
#pragma unroll
            for (int m = 0; m < 4; ++m)
#pragma unroll
                for (int n = 0; n < 2; ++n) acc[a][b][m][n] = (f32x4){0.f, 0.f, 0.f, 0.f};
    bf16x8 At[4][2], B0[2][2], B1[2][2]; i32x8 At8[4], B08[2], B18[2];
    const int f8sw = F8_SCALE_W, f8sa = F8_SCALE_A;
    unsigned vc00, vc01, vc10, vc11, vn00, vn01, vn10, vn11;
    PG8_VOFF(cur, vc00, vc01, vc10, vc11);
    const char* cA = cur.a; const char* cB = cur.b;
    PG8_STAGE2(PG8_SB(0, 0), cB, vb0, vb1); PG8_STAGE2(PG8_SA(0, 0), cA, vc00, vc01); PG8_STAGE2(PG8_SB(0, 1), cB + hstepB, vb0, vb1); PG8_STAGE2(PG8_SA(0, 1), cA, vc10, vc11);
    if (wr == 1) PG8_BAR;
    PG8_WAIT_V(4); PG8_BAR;
    PG8_STAGE2(PG8_SB(1, 0), cB + kstep, vb0, vb1); PG8_STAGE2(PG8_SA(1, 0), cA + kstep, vc00, vc01); PG8_STAGE2(PG8_SB(1, 1), cB + hstepB + kstep, vb0, vb1);
    PG8_WAIT_V(6); PG8_BAR;
    for (;;) {
        const bool has_next = S.next(ui + 1, nxt);
        const char* nA = has_next ? nxt.a : cA; const char* nB = has_next ? nxt.b : cB;
        if (has_next) { PG8_VOFF(nxt, vn00, vn01, vn10, vn11); } else { vn00 = vc00; vn01 = vc01; vn10 = vc10; vn11 = vc11; }
        for (int t = 0; t < nt; t += 2) {
            const bool last = (t == nt - 2);
            const char* a1 = cA + (size_t)(t + 1) * kstep;
            const char* a2 = last ? nA : cA + (size_t)(t + 2) * kstep; const char* b2 = last ? nB : cB + (size_t)(t + 2) * kstep;
            const char* a3 = a2 + kstep; const char* b3 = b2 + kstep;
            const unsigned w00 = last ? vn00 : vc00, w01 = last ? vn01 : vc01, w10 = last ? vn10 : vc10, w11 = last ? vn11 : vc11;
            PG8_LDB(B0, 0, 0); PG8_SCHED; PG8_LDA(At, 0, 0); PG8_STAGE2(PG8_SA(1, 1), a1, vc10, vc11);
            PG8_WAIT_L(8); PG8_BAR; PG8_WAIT_L(0); PG8_MMA(0, 0, At, B0); PG8_BAR; PG8_SCHED;
            PG8_LDB(B1, 0, 1); PG8_STAGE2(PG8_SB(0, 0), b2, vb0, vb1);
            PG8_BAR; PG8_WAIT_L(0); PG8_MMA(0, 1, At, B1); PG8_BAR;
            PG8_LDA(At, 0, 1); PG8_STAGE2(PG8_SA(0, 0), a2, w00, w01);
            PG8_BAR; PG8_WAIT_L(0); PG8_MMA(1, 0, At, B0); PG8_BAR; PG8_SCHED;
            PG8_STAGE2(PG8_SB(0, 1), b2 + hstepB, vb0, vb1);
            PG8_WAIT_V(6); PG8_BAR; PG8_MMA(1, 1, At, B1); PG8_BAR;
            PG8_LDB(B0, 1, 0); PG8_SCHED; PG8_LDA(At, 1, 0); PG8_STAGE2(PG8_SA(0, 1), a2, w10, w11);
            PG8_WAIT_L(8); PG8_BAR; PG8_WAIT_L(0); PG8_MMA(0, 0, At, B0); PG8_BAR; PG8_SCHED;
            PG8_LDB(B1, 1, 1); PG8_STAGE2(PG8_SB(1, 0), b3, vb0, vb1);
            PG8_BAR; PG8_WAIT_L(0); PG8_MMA(0, 1, At, B1); PG8_BAR;
            PG8_LDA(At, 1, 1); PG8_STAGE2(PG8_SA(1, 0), a3, w00, w01);
            PG8_BAR; PG8_WAIT_L(0); PG8_MMA(1, 0, At, B0); PG8_BAR; PG8_SCHED;
            PG8_STAGE2(PG8_SB(1, 1), b3 + hstepB, vb0, vb1);
            PG8_WAIT_V(6); PG8_BAR; PG8_MMA(1, 1, At, B1); PG8_BAR;
        }
        if constexpr (F8) asm volatile("s_nop 15\n\ts_nop 15" ::: "memory");
        E(acc, cur, wr, wc, fr, fq);
        if (!has_next) break;
#pragma unroll
        for (int a = 0; a < 2; ++a)
#pragma unroll
            for (int b = 0; b < 2; ++b)
#pragma unroll
                for (int m = 0; m < 4; ++m)
#pragma unroll
                    for (int n = 0; n < 2; ++n) acc[a][b][m][n] = (f32x4){0.f, 0.f, 0.f, 0.f};
        cur = nxt; cA = nA; cB = nB; vc00 = vn00; vc01 = vn01; vc10 = vn10; vc11 = vn11; ++ui;
    }
    PG8_WAIT_V(0);
    if (wr == 0) PG8_BAR;
    PG8_BAR;
#undef PG8_SA
#undef PG8_SB
#undef PG8_STAGE2
#undef PG8_LDA
#undef PG8_LDB
#undef PG8_LD16
#undef PG8_MMA
#undef PG8_WAIT_V
#undef PG8_WAIT_L
#undef PG8_BAR
#undef PG8_SCHED
#undef PG8_VOFF
}

__device__ __forceinline__ void static_tile(int L, int nM, int nN, int& pm, int& pn) {
    const int nwg = nM * nN; int wgid = L;
    { const int q = nwg / 8, r = nwg % 8, xcd = wgid % 8, off = wgid / 8; wgid = (xcd < r ? xcd * (q + 1) : r * (q + 1) + (xcd - r) * q) + off; }
    const int nig = 8 * nN, gid = wgid / nig, fm = gid * 8, gsz = (nM - fm) < 8 ? (nM - fm) : 8;
    pm = fm + ((wgid % nig) % gsz); pn = (wgid % nig) / gsz;
}
}

struct SchedIn {
    const Params* p;
    __device__ __forceinline__ bool next(int i, pg8::Unit& u) const {
        const long L = (long)i * gridDim.x + blockIdx.x;
        const char* HXb = (const char*)(p->ws + WS_HX); const char* BT = (const char*)(p->ws + WS_BTIN);
        u.rows = nullptr; u.rows_lds = -1; u.nvalid = 256; u.e = 0;
        if (L < 1024) { int j; pg8::static_tile((int)L, 64, 16, u.pm, j); u.pn = j < 12 ? j : j + 4; u.aux = 0; u.a = HXb + (size_t)u.pm * 256 * DM * 2; u.b = BT + (size_t)u.pn * 256 * DM * 2; return true; }
        if (L < 1088) { const int l = (int)L - 1024; u.pm = l >> 3; u.pn = l & 7; u.aux = 1; u.a = HXb + (size_t)(NTOK + u.pm * 256) * DM * 2; u.b = BT + (size_t)(4 + u.pn) * 256 * DM * 2; return true; }
        return false;
    }
};
struct SchedIn8 {
    const Params* p;
    __device__ __forceinline__ bool next(int i, pg8::Unit& u) const {
        int U;
        if (gridDim.x == 256) { const int c = blockIdx.x;
            if (c < 64) { if (i >= 1) return false; U = c; } else if (c < 192) { if (i >= 2) return false; U = 64 + (c - 64) * 2 + i; } else { if (i >= 3) return false; U = 320 + (c - 192) * 3 + i; }
        } else { const long L = (long)i * gridDim.x + blockIdx.x; if (L >= 512) return false; U = (int)L; }
        const int idx = U & 7;
        u.rows = nullptr; u.rows_lds = -1; u.nvalid = 256; u.e = 0; u.aux = 0; u.pm = U >> 3; u.pn = idx < 4 ? 12 + idx : 16 + idx;
        u.a = (const char*)(p->ws + WS_HX8) + (size_t)u.pm * 256 * DM;
        u.b = (const char*)(p->ws + WS_BTIN) + (idx < 4 ? (size_t)3072 * DM * 2 + (size_t)idx * 256 * DM : (size_t)5120 * DM * 2 + (size_t)(idx - 4) * 256 * DM); return true;
    }
};
struct EpiIn {
    const Params* p;
    __device__ __forceinline__ void operator()(const f32x4 (&acc)[2][2][4][2], const pg8::Unit& u, int wr, int wc, int fr, int fq) const {
        bf16_t* O; int ldc; bool act = false;
        if (u.aux == 0) { O = (bf16_t*)(p->ws + WS_P); ldc = PW; act = u.pn >= 16; } else { O = (bf16_t*)(p->ws + WS_PC); ldc = 2048; }
        const int row0 = u.pm * 256 + wr * 64 + fr, col0 = u.pn * 256 + wc * 32 + 8 * fq;
#pragma unroll
        for (int ai = 0; ai < 2; ++ai)
#pragma unroll
            for (int m = 0; m < 4; ++m) { bf16_t* rowp = O + (size_t)(row0 + ai * 128 + m * 16) * ldc + col0;
#pragma unroll
                for (int bj = 0; bj < 2; ++bj) { f32x4 v0 = acc[ai][bj][m][0], v1 = acc[ai][bj][m][1];
                    if (act) {
#pragma unroll
                        for (int j = 0; j < 4; ++j) { v0[j] = gelu_tanh_f(v0[j]); v1[j] = gelu_tanh_f(v1[j]); } }
                    u32x4 w; w.x = cvt_pk_bf16(v0[0], v0[1]); w.y = cvt_pk_bf16(v0[2], v0[3]); w.z = cvt_pk_bf16(v1[0], v1[1]); w.w = cvt_pk_bf16(v1[2], v1[3]);
                    *(u32x4*)(rowp + bj * 128) = w; } }
    }
};
struct SchedOut {
    const Params* p;
    __device__ __forceinline__ bool next(int i, pg8::Unit& u) const {
        const long L = (long)i * gridDim.x + blockIdx.x; if (L >= 512) return false;
        pg8::static_tile((int)L, 64, 8, u.pm, u.pn); u.rows = nullptr; u.rows_lds = -1; u.nvalid = 256; u.e = 0; u.aux = 0;
        u.a = (const char*)(p->ws + WS_YCAT) + (size_t)u.pm * 256 * DM * 2; u.b = (const char*)(p->ws + WS_BTOUT) + (size_t)u.pn * 256 * DM * 2; return true;
    }
};
struct EpiOut {
    const Params* p;
    __device__ __forceinline__ void operator()(const f32x4 (&acc)[2][2][4][2], const pg8::Unit& u, int wr, int wc, int fr, int fq) const {
        bf16_t* X1 = (bf16_t*)(p->ws + WS_X1); const float* pos = (const float*)(p->ws + WS_POS); const float* MOD = (const float*)(p->ws + WS_MOD); float* ST = (float*)(p->ws + WS_STATS);
        const int row0 = u.pm * 256 + wr * 64 + fr, col0 = u.pn * 256 + wc * 32 + 4 * fq;
        const int b = (u.pm * 256) / SEQ;
        f32x4 g1[2][2];
#pragma unroll
        for (int bj = 0; bj < 2; ++bj)
#pragma unroll
            for (int n = 0; n < 2; ++n) g1[bj][n] = *(const f32x4*)(MOD + (size_t)b * (NMOD * DM) + 2 * DM + col0 + bj * 128 + n * 16);
#pragma unroll
        for (int ai = 0; ai < 2; ++ai)
#pragma unroll
            for (int mp = 0; mp < 2; ++mp) {
                f32x4 xv[2][2][2], pv[2][2][2];
#pragma unroll
                for (int mm = 0; mm < 2; ++mm) { const int row = row0 + ai * 128 + (mp * 2 + mm) * 16; const int ts = row % SEQ, rr = ts >> 6, cc = ts & 63;
#pragma unroll
                    for (int bj = 0; bj < 2; ++bj)
#pragma unroll
                        for (int n = 0; n < 2; ++n) { const int col = col0 + bj * 128 + n * 16;
                            xv[mm][bj][n] = *(const f32x4*)(p->x + (size_t)row * DM + col);
                            pv[mm][bj][n] = *(const f32x4*)(col < 1024 ? pos + rr * 1024 + col : pos + 32 * 1024 + cc * 1024 + (col - 1024)); } }
#pragma unroll
                for (int mm = 0; mm < 2; ++mm) { const int m = mp * 2 + mm; const int row = row0 + ai * 128 + m * 16;
                    float s1 = 0.f, s2 = 0.f;
#pragma unroll
                    for (int bj = 0; bj < 2; ++bj)
#pragma unroll
                        for (int n = 0; n < 2; ++n) { const int col = col0 + bj * 128 + n * 16;
                            const f32x4 v = (xv[mm][bj][n] + pv[mm][bj][n]) * ALPHA + g1[bj][n] * acc[ai][bj][m][n];
                            { u32x2 o; o.x = pack2_h16(v[0], v[1]); o.y = pack2_h16(v[2], v[3]); *(u32x2*)(X1 + (size_t)row * DM + col) = o; }
                            s1 += (v[0] + v[1]) + (v[2] + v[3]); s2 += (v[0] * v[0] + v[1] * v[1]) + (v[2] * v[2] + v[3] * v[3]); }
                    s1 += __shfl_xor(s1, 16, 64); s2 += __shfl_xor(s2, 16, 64); s1 += __shfl_xor(s1, 32, 64); s2 += __shfl_xor(s2, 32, 64);
                    if (fq == 0) { atomicAdd(ST + (size_t)row * 2, s1); atomicAdd(ST + (size_t)row * 2 + 1, s2); } }
            }
    }
};
__device__ __forceinline__ bool moe_unit(int i, const LAS int* tab, int& P, int& nt) {
    const int G = gridDim.x, c = blockIdx.x;
    const int wgid = (G % 8 == 0) ? (c % 8) * (G / 8) + c / 8 : c;
    const long L = (long)i * G + wgid; P = (int)(L >> 3); nt = (int)(L & 7);
    return P < tab[160 * 4];
}
__device__ __forceinline__ void moe_build_table(const Params& p, LAS int* tab) {
    if (threadIdx.x == 0) {
        const unsigned* cnt = (const unsigned*)(p.ws + WS_CTL) + CW_CNT;
        int np = 0, off = 0;
        for (int e = 0; e < NE; ++e) { const int c = (int)cnt[e]; const int nmt = (c + 255) >> 8;
            for (int mt = 0; mt < nmt; ++mt) { tab[np * 4 + 0] = e; tab[np * 4 + 1] = mt; tab[np * 4 + 2] = off + mt * 256; tab[np * 4 + 3] = (c - mt * 256) < 256 ? (c - mt * 256) : 256; ++np; }
            off += nmt * 256; }
        tab[160 * 4] = np;
    }
    __syncthreads();
    LAS int* rl = (LAS int*)((LAS unsigned char*)tab - LDS_TAB + LDS_ROWS);
    for (int i = 0; i < 8; ++i) { int P, nt; if (!moe_unit(i, tab, P, nt)) break;
        const int e = tab[P * 4], mt = tab[P * 4 + 1];
        if (threadIdx.x < 256) rl[i * 256 + threadIdx.x] = ((const int*)(p.ws + WS_LIST))[(size_t)e * NTOK + mt * 256 + threadIdx.x]; }
    __syncthreads();
}
struct SchedMoe1 {
    const Params* p; const LAS int* tab;
    __device__ __forceinline__ bool next(int i, pg8::Unit& u) const {
        int P, nt; if (!moe_unit(i, tab, P, nt)) return false;
        const int e = tab[P * 4], mt = tab[P * 4 + 1];
        u.e = e; u.pm = P; u.pn = nt; u.aux = tab[P * 4 + 2]; u.nvalid = tab[P * 4 + 3];
        u.rows = nullptr; u.rows_lds = LDS_ROWS + i * 1024;
        u.a = (const char*)(p->ws + WS_T); u.b = (const char*)(p->ws + WS_BTGU) + (size_t)(e * 8 + nt) * 256 * DM; return true;
    }
};
struct EpiMoe1 {
    const Params* p;
    __device__ __forceinline__ void operator()(const f32x4 (&acc)[2][2][4][2], const pg8::Unit& u, int wr, int wc, int fr, int fq) const {
        unsigned char* H = (unsigned char*)(p->ws + WS_H);
        const int row0 = u.aux + wr * 64 + fr, col0 = u.pn * 128 + wc * 32 + 8 * fq;
#pragma unroll
        for (int ai = 0; ai < 2; ++ai)
#pragma unroll
            for (int m = 0; m < 4; ++m) { unsigned char* rowp = H + (size_t)(row0 + ai * 128 + m * 16) * DE + col0;
                float h[8];
#pragma unroll
                for (int n = 0; n < 2; ++n)
#pragma unroll
                    for (int j = 0; j < 4; ++j) h[n * 4 + j] = silu_f(acc[ai][0][m][n][j]) * acc[ai][1][m][n][j];
                u32x2 w; w.x = pack4_fp8(h[0], h[1], h[2], h[3]); w.y = pack4_fp8(h[4], h[5], h[6], h[7]);
                *(u32x2*)rowp = w; }
    }
};
struct SchedMoe2 {
    const Params* p; const LAS int* tab;
    __device__ __forceinline__ bool next(int i, pg8::Unit& u) const {
        int P, nt; if (!moe_unit(i, tab, P, nt)) return false;
        const int e = tab[P * 4], mt = tab[P * 4 + 1];
        u.e = LDS_ROWS + i * 1024; u.pm = P; u.pn = nt; u.aux = mt; u.nvalid = tab[P * 4 + 3]; u.rows = nullptr; u.rows_lds = -1;
        u.a = (const char*)(p->ws + WS_H) + (size_t)tab[P * 4 + 2] * DE; u.b = (const char*)(p->ws + WS_BTDN) + ((size_t)e * DM + nt * 256) * DE; return true;
    }
};
struct EpiMoe2 {
    const Params* p; LAS unsigned char* lds;
    __device__ __forceinline__ void operator()(const f32x4 (&acc)[2][2][4][2], const pg8::Unit& u, int wr, int wc, int fr, int fq) const {
        unsigned char* Y2 = (unsigned char*)(p->ws + WS_Y2);
        const LAS int* list = (const LAS int*)(lds + u.e);
        const int r0 = wr * 64 + fr, col0 = u.pn * 256 + wc * 32 + 8 * fq;
        int ents[2][4];
#pragma unroll
        for (int ai = 0; ai < 2; ++ai)
#pragma unroll
            for (int m = 0; m < 4; ++m) { const int r = r0 + ai * 128 + m * 16; ents[ai][m] = r < u.nvalid ? list[r] : 0; }
#pragma unroll
        for (int ai = 0; ai < 2; ++ai)
#pragma unroll
            for (int m = 0; m < 4; ++m) { const int r = r0 + ai * 128 + m * 16;
                if (r < u.nvalid) { const int ent = ents[ai][m]; unsigned char* rowp = Y2 + (size_t)ent * DM + col0;
#pragma unroll
                    for (int bj = 0; bj < 2; ++bj) { const f32x4 v0 = acc[ai][bj][m][0] * 16.0f, v1 = acc[ai][bj][m][1] * 16.0f;
                        u32x2 w; w.x = pack4_fp8(v0[0], v0[1], v0[2], v0[3]); w.y = pack4_fp8(v1[0], v1[1], v1[2], v1[3]);
                        *(u32x2*)(rowp + bj * 128) = w; } } }
    }
};

typedef short s16x4 __attribute__((ext_vector_type(4)));
__device__ __forceinline__ s16x4 tr16(const LAS unsigned char* p) { return __builtin_bit_cast(s16x4, __builtin_amdgcn_ds_read_tr16_b64_v4i16((LAS s16x4*)p)); }
__device__ __forceinline__ bf16x8 tr_frag(const LAS unsigned char* tile, int pitchB, int k0, int c0, int lane) {
    const int g = lane >> 4, i = lane & 15;
    const LAS unsigned char* a = tile + (k0 + 8 * g + (i >> 2)) * pitchB + (c0 + 4 * (i & 3)) * 2;
    const s16x4 lo = tr16(a), hi = tr16(a + 4 * pitchB);
    return (bf16x8){lo[0], lo[1], lo[2], lo[3], hi[0], hi[1], hi[2], hi[3]};
}
__device__ __forceinline__ bf16x8 row_frag(const LAS unsigned char* tile, int pitchB, int r0, int k0, int lane) {
    return *(const LAS bf16x8*)(tile + (r0 + (lane & 15)) * pitchB + (k0 + 8 * (lane >> 4)) * 2);
}
#define DPPF(old_, src_, ctrl_, rmask_) __int_as_float(__builtin_amdgcn_update_dpp(__float_as_int(old_), __float_as_int(src_), (ctrl_), (rmask_), 0xf, false))
__device__ __forceinline__ float row16_sum(float v) {
    v += DPPF(0.f, v, 0x128, 0xf); v += DPPF(0.f, v, 0x124, 0xf); v += DPPF(0.f, v, 0x122, 0xf); v += DPPF(0.f, v, 0x121, 0xf); return v;
}
__device__ __forceinline__ float wscan_sum(float v, int) {
    v += DPPF(0.f, v, 0x111, 0xf); v += DPPF(0.f, v, 0x112, 0xf); v += DPPF(0.f, v, 0x114, 0xf); v += DPPF(0.f, v, 0x118, 0xf);
    v += DPPF(0.f, v, 0x142, 0xa); v += DPPF(0.f, v, 0x143, 0xc); return v;
}
__device__ __forceinline__ float wscan_max(float v, int) {
    const float ninf = -3.0e38f;
    v = fmaxf(v, DPPF(ninf, v, 0x111, 0xf)); v = fmaxf(v, DPPF(ninf, v, 0x112, 0xf)); v = fmaxf(v, DPPF(ninf, v, 0x114, 0xf)); v = fmaxf(v, DPPF(ninf, v, 0x118, 0xf));
    v = fmaxf(v, DPPF(ninf, v, 0x142, 0xa)); v = fmaxf(v, DPPF(ninf, v, 0x143, 0xc)); return v;
}
__device__ __forceinline__ float wave_max(float v) {
#pragma unroll
    for (int o = 32; o > 0; o >>= 1) v = fmaxf(v, __shfl_xor(v, o, 64));
    return v;
}
__device__ __forceinline__ void conv8x8_load(const bf16_t* src, size_t pitch, int tfirst, int len, u32x4 (&raw)[10]) {
#pragma unroll
    for (int i = 0; i < 10; ++i) { const int ts = tfirst - 1 + i; raw[i] = (ts >= 0 && ts < len) ? *(const u32x4*)(src + (size_t)ts * pitch) : (u32x4){0u, 0u, 0u, 0u}; }
}
__device__ __forceinline__ void conv8x8_compute(const u32x4 (&raw)[10], const float* cw, const float* cb, int ch, float scale, LAS unsigned char* dst, int dpitchB) {
    float w0[8], w1[8], w2[8], bb[8];
#pragma unroll
    for (int j = 0; j < 8; ++j) { w0[j] = cw[ch + j]; w1[j] = cw[2048 + ch + j]; w2[j] = cw[4096 + ch + j]; bb[j] = cb[ch + j]; }
    float a[8], b[8], c[8];
    unpack8(raw[0], a); unpack8(raw[1], b);
#pragma unroll
    for (int r = 0; r < 8; ++r) {
        unpack8(raw[r + 2], c);
        float o[8];
#pragma unroll
        for (int j = 0; j < 8; ++j) o[j] = silu_f(bb[j] + w0[j] * a[j] + w1[j] * b[j] + w2[j] * c[j]) * scale;
        *(LAS u32x4*)(dst + r * dpitchB) = pack8(o);
#pragma unroll
        for (int j = 0; j < 8; ++j) { a[j] = b[j]; b[j] = c[j]; }
    }
}
__device__ __forceinline__ void conv8x8(const bf16_t* src, size_t pitch, int tfirst, int len, const float* cw, const float* cb, int ch, float scale, LAS unsigned char* dst, int dpitchB) {
    u32x4 raw[10]; conv8x8_load(src, pitch, tfirst, len, raw); conv8x8_compute(raw, cw, cb, ch, scale, dst, dpitchB);
}

constexpr int SC_V0 = 0, SC_V1 = 65536, SC_K = 131072, SC_VEC = SC_K + 18432;
struct ScanSrc { const bf16_t* src; size_t pitch; int kcol, vcol, len, t0, c; const float* grow; bool isx; };
__device__ __forceinline__ ScanSrc scan_src(const Params& p, int step, int b, int h, int dir, int es) {
    ScanSrc q; q.isx = step >= 2;
    q.c = q.isx ? (dir ? 17 - step : step - 2) : (dir ? 1 - step : step);
    q.src = q.isx ? (const bf16_t*)(p.ws + WS_P) + (size_t)(b * SEQ) * PW : (const bf16_t*)(p.ws + WS_PC) + (size_t)(b * CTXL) * 2048;
    q.pitch = q.isx ? PW : 2048;
    q.kcol = (q.isx ? 1024 : 0) + h * HD + es * 64; q.vcol = (q.isx ? 2048 : 1024) + h * HD; q.len = q.isx ? SEQ : CTXL; q.t0 = q.c * CHK;
    q.grow = (const float*)(p.ws + WS_GATES) + (size_t)(q.isx ? b * SEQ + q.t0 : NTOK + b * CTXL + q.t0) * NGATE + dir * 8 + h;
    return q;
}
__device__ __forceinline__ void glds16_asm(const void* g, unsigned ldsaddr) {
    asm volatile("s_mov_b32 m0, %1\n\ts_nop 0\n\tglobal_load_lds_dwordx4 %0, off" :: "v"(g), "s"(ldsaddr) : "memory", "m0");
}
__device__ __forceinline__ void scan_vdma(const ScanSrc& q, LAS unsigned char* vb, int wid, int lane) {
    const unsigned base = __builtin_amdgcn_readfirstlane((unsigned)(__SIZE_TYPE__)(vb + 8 * wid * 1024));
#pragma unroll
    for (int i = 0; i < 8; ++i) { const int row = 2 * (8 * wid + i) + (lane >> 5); const int gc = (lane & 31) ^ (row & 7);
        glds16_asm(q.src + (size_t)(q.t0 + row) * q.pitch + q.vcol + gc * 8, base + i * 1024); }
}
__device__ __forceinline__ bf16x8 tr_frag_swz(const LAS unsigned char* tile, int k0, int c0, int lane) {
    const int g = lane >> 4, i = lane & 15, r = i >> 2, col = c0 + 4 * (i & 3);
    const int row = k0 + 8 * g + r;
    const LAS unsigned char* a0 = tile + row * 512 + (((col >> 3) ^ r) << 4) + ((col & 4) << 1);
    const LAS unsigned char* a1 = tile + (row + 4) * 512 + (((col >> 3) ^ (r + 4)) << 4) + ((col & 4) << 1);
    const s16x4 lo = tr16(a0), hi = tr16(a1);
    return (bf16x8){lo[0], lo[1], lo[2], lo[3], hi[0], hi[1], hi[2], hi[3]};
}
__device__ __forceinline__ void conv4x8_load(const bf16_t* src, size_t pitch, int tfirst, int len, u32x4 (&raw)[6]) {
#pragma unroll
    for (int i = 0; i < 6; ++i) { const int ts = tfirst - 1 + i; raw[i] = (ts >= 0 && ts < len) ? *(const u32x4*)(src + (size_t)ts * pitch) : (u32x4){0u, 0u, 0u, 0u}; }
}
__device__ __forceinline__ void conv4x8_load_async(const bf16_t* src, size_t pitch, int tfirst, int len, u32x4 (&raw)[6]) {
#pragma unroll
    for (int i = 0; i < 6; ++i) { const int ts = tfirst - 1 + i; const bf16_t* a = src + (size_t)ts * pitch;
        raw[i] = (u32x4){0u, 0u, 0u, 0u};
        if (ts >= 0 && ts < len) asm volatile("global_load_dwordx4 %0, %1, off" : "+v"(raw[i]) : "v"(a) : "memory"); }
}
__device__ __forceinline__ void conv4x8_compute(const u32x4 (&raw)[6], const float (&w0)[8], const float (&w1)[8], const float (&w2)[8], const float (&bb)[8], const LAS float* wrow, LAS unsigned char* dst, int dpitchB) {
    float a[8], b[8], c[8];
    unpack8(raw[0], a); unpack8(raw[1], b);
#pragma unroll
    for (int r = 0; r < 4; ++r) {
        unpack8(raw[r + 2], c);
        const float sc = 0.0625f * wrow[r];
        float o[8];
#pragma unroll
        for (int j = 0; j < 8; ++j) o[j] = silu_f(bb[j] + w0[j] * a[j] + w1[j] * b[j] + w2[j] * c[j]) * sc;
        const u32x4 pk = pack8(o);
        *(LAS u32x2*)(dst + r * dpitchB) = (u32x2){pk.x, pk.y}; *(LAS u32x2*)(dst + r * dpitchB + 32) = (u32x2){pk.z, pk.w};
#pragma unroll
        for (int j = 0; j < 8; ++j) { a[j] = b[j]; b[j] = c[j]; }
    }
}
__device__ __forceinline__ void phase_scan(const Params& p, LAS unsigned char* lds) {
    const int tid = threadIdx.x, lane = tid & 63, wid = __builtin_amdgcn_readfirstlane(tid >> 6), wm = wid >> 1, wn = wid & 1;
    LAS float* wtab = (LAS float*)(lds + SC_VEC);
    LAS float* sbl = wtab + 18 * 128;
    bf16_t* CST = (bf16_t*)(p.ws + WS_CST); float* NST = (float*)(p.ws + WS_NST); float* MST = (float*)(p.ws + WS_MST);
    const int cg = tid & 7, rb = (tid >> 3) & 31;
    const bf16x8 ones = (bf16x8){0x3f80, 0x3f80, 0x3f80, 0x3f80, 0x3f80, 0x3f80, 0x3f80, 0x3f80};
    for (int unit0 = blockIdx.x; unit0 < 256; unit0 += gridDim.x) {
        const int es = (unit0 >> 3) & 3, combo = (unit0 >> 5) * 8 + (unit0 & 7);
        const int dir = combo & 1, h = (combo >> 1) & 3, b = combo >> 3;
        const int sidx = (b * 4 + h) * 2 + dir;
        const int s0 = dir ? 127 - lane : lane, s1 = dir ? 63 - lane : 64 + lane;
        asm volatile("s_waitcnt vmcnt(0) lgkmcnt(0)" ::: "memory"); __builtin_amdgcn_s_barrier();
        LAS float* taps = sbl + 160;
        if (tid < 64) { const int ch = 1024 + h * HD + es * 64 + tid;
            taps[tid] = p.conv_w[ch]; taps[64 + tid] = p.conv_w[2048 + ch]; taps[128 + tid] = p.conv_w[4096 + ch]; taps[192 + tid] = p.conv_b[ch]; }
        u32x4 kraw[6], krb[6];
#pragma unroll
        for (int i = 0; i < 6; ++i) krb[i] = (u32x4){0u, 0u, 0u, 0u};
        {   const ScanSrc q = scan_src(p, 0, b, h, dir, es);
            scan_vdma(q, lds + SC_V0, wid, lane);
            if (tid < 256) conv4x8_load_async(q.src + q.kcol + cg * 8, q.pitch, q.t0 + rb * 4, q.len, kraw); }
        for (int st = wid; st < 18; st += 8) {
            const ScanSrc q = scan_src(p, st, b, h, dir, es);
            const float li0 = q.grow[(size_t)s0 * NGATE], lf0 = q.grow[(size_t)s0 * NGATE + 4], li1 = q.grow[(size_t)s1 * NGATE], lf1 = q.grow[(size_t)s1 * NGATE + 4];
            const float b0 = wscan_sum(lf0, lane); const float tot0 = __shfl(b0, 63, 64); const float b1 = wscan_sum(lf1, lane) + tot0; const float blast = __shfl(b1, 63, 64);
            const float a0 = blast - b0 + li0, a1 = blast - b1 + li1;
            const float mloc = wave_max(fmaxf(a0, a1));
            wtab[st * 128 + s0] = a0; wtab[st * 128 + s1] = a1;
            if (lane == 0) { sbl[st] = blast; sbl[32 + st] = mloc; }
        }
        asm volatile("s_waitcnt lgkmcnt(0)" ::: "memory"); __builtin_amdgcn_s_barrier();
        if (tid == 0) { float m = 0.f;
            for (int st = 0; st < 18; ++st) { const float bl = sbl[st], ml = sbl[32 + st]; const float mn = fmaxf(bl + m, ml); sbl[64 + st] = __expf(bl + m - mn); sbl[96 + st] = m; sbl[128 + st] = mn; m = mn; } }
        asm volatile("s_waitcnt lgkmcnt(0)" ::: "memory"); __builtin_amdgcn_s_barrier();
        for (int i = tid; i < 18 * 128; i += 512) wtab[i] = __expf(wtab[i] - sbl[128 + (i >> 7)]);
        f32x4 acc[2][4], accn[2];
#pragma unroll
        for (int n = 0; n < 2; ++n) { accn[n] = (f32x4){0.f, 0.f, 0.f, 0.f};
#pragma unroll
            for (int m = 0; m < 4; ++m) acc[n][m] = (f32x4){0.f, 0.f, 0.f, 0.f}; }
#define SCAN_STEP(step, KCUR, KNXT) do { \
            const ScanSrc q = scan_src(p, (step), b, h, dir, es); \
            if ((step) >= 3) asm volatile("s_waitcnt vmcnt(4) lgkmcnt(0)" ::: "memory"); else asm volatile("s_waitcnt vmcnt(0) lgkmcnt(0)" ::: "memory");     \
            __builtin_amdgcn_s_barrier();      \
            if (q.isx) { \
                if (wm == 0 && (lane & 15) == 0) { _Pragma("unroll") for (int n = 0; n < 2; ++n) *(f32x4*)(NST + ((size_t)sidx * 16 + q.c) * 256 + es * 64 + 32 * wn + 8 * (lane >> 4) + 4 * n) = accn[n]; } \
                if (es == 0 && tid == 0) MST[sidx * 16 + q.c] = sbl[96 + (step)]; \
            } \
            if ((step) < 17) { const ScanSrc qn = scan_src(p, (step) + 1, b, h, dir, es); scan_vdma(qn, lds + (((step) + 1) & 1 ? SC_V1 : SC_V0), wid, lane); }     \
            if ((step) < 17 && tid < 256) { const ScanSrc qn = scan_src(p, (step) + 1, b, h, dir, es); conv4x8_load_async(qn.src + qn.kcol + cg * 8, qn.pitch, qn.t0 + rb * 4, qn.len, KNXT); }     \
            asm volatile("" ::: "memory"); \
            if (q.isx) {                                                          \
                bf16_t* cdst = CST + ((size_t)sidx * 16 + q.c) * 65536 + es * 64 + 32 * wn + 8 * (lane >> 4); \
                _Pragma("unroll") for (int m = 0; m < 4; ++m) { u32x4 o; o.x = cvt_pk_bf16(acc[0][m][0], acc[0][m][1]); o.y = cvt_pk_bf16(acc[0][m][2], acc[0][m][3]); o.z = cvt_pk_bf16(acc[1][m][0], acc[1][m][1]); o.w = cvt_pk_bf16(acc[1][m][2], acc[1][m][3]); \
                        *(u32x4*)(cdst + (size_t)(64 * wm + 16 * m + (lane & 15)) * 256) = o; } \
            } \
            if (tid < 256) { float cw0[8], cw1[8], cw2[8], cbb[8]; \
                _Pragma("unroll") for (int hh = 0; hh < 2; ++hh) { const f32x4 t0 = *(const LAS f32x4*)(taps + cg * 8 + hh * 4), t1 = *(const LAS f32x4*)(taps + 64 + cg * 8 + hh * 4), t2 = *(const LAS f32x4*)(taps + 128 + cg * 8 + hh * 4), t3 = *(const LAS f32x4*)(taps + 192 + cg * 8 + hh * 4); \
                    _Pragma("unroll") for (int j = 0; j < 4; ++j) { cw0[hh * 4 + j] = t0[j]; cw1[hh * 4 + j] = t1[j]; cw2[hh * 4 + j] = t2[j]; cbb[hh * 4 + j] = t3[j]; } } \
                conv4x8_compute(KCUR, cw0, cw1, cw2, cbb, wtab + (step) * 128 + rb * 4, lds + SC_K + (rb * 4) * 144 + (cg >> 2) * 64 + (cg & 3) * 8, 144); } \
            asm volatile("s_waitcnt lgkmcnt(0)" ::: "memory"); __builtin_amdgcn_s_barrier();                 \
            const LAS unsigned char* vt = lds + (((step) & 1) ? SC_V1 : SC_V0); \
            const float so = sbl[64 + (step)]; \
            _Pragma("unroll") for (int n = 0; n < 2; ++n) { accn[n] *= so; _Pragma("unroll") for (int m = 0; m < 4; ++m) acc[n][m] *= so; } \
            _Pragma("unroll") for (int ks = 0; ks < 4; ++ks) { \
                bf16x8 af[4], bfr[2]; \
                _Pragma("unroll") for (int m = 0; m < 4; ++m) af[m] = tr_frag_swz(vt, ks * 32, 64 * wm + 16 * m, lane); \
                _Pragma("unroll") for (int n = 0; n < 2; ++n) bfr[n] = tr_frag(lds + SC_K, 144, ks * 32, 32 * wn + 16 * n, lane); \
                _Pragma("unroll") for (int n = 0; n < 2; ++n) { accn[n] = __builtin_amdgcn_mfma_f32_16x16x32_bf16(bfr[n], ones, accn[n], 0, 0, 0); \
                    _Pragma("unroll") for (int m = 0; m < 4; ++m) acc[n][m] = __builtin_amdgcn_mfma_f32_16x16x32_bf16(bfr[n], af[m], acc[n][m], 0, 0, 0); } \
            } } while (0)
#pragma unroll 1
        for (int step = 0; step < 18; step += 2) { SCAN_STEP(step, kraw, krb); SCAN_STEP(step + 1, krb, kraw); }
#undef SCAN_STEP
    }
    asm volatile("s_waitcnt vmcnt(0) lgkmcnt(0)" ::: "memory"); __builtin_amdgcn_s_barrier();
}

constexpr int MX_Q = 0, MX_K = 67584, MX_P = 100352, MX_VEC = 135168;
enum { V_GF = 0, V_GB = 128, V_MF = 256, V_MB = 384, V_SIF = 512, V_SIB = 640, V_EMF = 768, V_EMB = 896, V_RF = 1024, V_RB = 1152, V_AF = 1280, V_AB = 1408, V_DQF = 1536, V_DQB = 1664,
       V_NF = 1792, V_NB = 2048, V_RSF = 2304, V_RSB = 2816, V_END = 3328 };
__device__ __forceinline__ void mix_unit(const Params& p, LAS unsigned char* lds, int unit) {
    const int tid = threadIdx.x, lane = tid & 63, wid = __builtin_amdgcn_readfirstlane(tid >> 6), wm = wid >> 2, wn = wid & 3, lg = lane >> 4, li_ = lane & 15;
    LAS float* vec = (LAS float*)(lds + MX_VEC);
    const int c = unit & 15, h = (unit >> 4) & 3, b = unit >> 6;
    const bf16_t* P = (const bf16_t*)(p.ws + WS_P); const float* G = (const float*)(p.ws + WS_GATES);
    const bf16_t* CST = (const bf16_t*)(p.ws + WS_CST); const float* NST = (const float*)(p.ws + WS_NST); const float* MST = (const float*)(p.ws + WS_MST);
    const int sf = (b * 4 + h) * 2, sb = sf + 1;
    const int t0 = c * CHK; const size_t tok0 = (size_t)b * SEQ + t0;
    const bf16_t* srcb = P + (size_t)(b * SEQ) * PW;
    __syncthreads();
    float gq[5] = {0.f, 0.f, 0.f, 0.f, 0.f}, nfq = 0.f, nbq = 0.f;
    if (wid < 2) { const int dir = wid; const float* grow = G + tok0 * NGATE + dir * 8 + h; const int s0 = dir ? 127 - lane : lane, s1 = dir ? 63 - lane : 64 + lane;
        gq[0] = grow[(size_t)s0 * NGATE]; gq[1] = grow[(size_t)s0 * NGATE + 4]; gq[2] = grow[(size_t)s1 * NGATE]; gq[3] = grow[(size_t)s1 * NGATE + 4]; gq[4] = MST[(dir ? sb : sf) * 16 + c]; }
    if (tid < 256) { nfq = NST[((size_t)sf * 16 + c) * 256 + tid]; nbq = NST[((size_t)sb * 16 + c) * 256 + tid]; }
    { const int cg = tid & 31, rb = tid >> 5;
      u32x4 qraw[10], kraw[10];
      conv8x8_load(srcb + h * HD + cg * 8, PW, t0 + rb * 8, SEQ, qraw); conv8x8_load(srcb + 1024 + h * HD + cg * 8, PW, t0 + rb * 8, SEQ, kraw);
      conv8x8_compute(qraw, p.conv_w, p.conv_b, h * HD + cg * 8, 1.0f, lds + MX_Q + (rb * 8) * 528 + cg * 16, 528);
      conv8x8_compute(kraw, p.conv_w, p.conv_b, 1024 + h * HD + cg * 8, 0.0625f, lds + MX_K + (rb * 8) * 528 + cg * 16, 528); }
    if (tid < 256) { vec[V_NF + tid] = nfq; vec[V_NB + tid] = nbq; }
    if (wid < 2) {
        const int dir = wid;
        const int s0 = dir ? 127 - lane : lane, s1 = dir ? 63 - lane : 64 + lane;
        const float min_ = gq[4], li0 = gq[0], lf0 = gq[1], li1 = gq[2], lf1 = gq[3];
        const float b0 = wscan_sum(lf0, lane); const float tot0 = __shfl(b0, 63, 64); const float b1 = wscan_sum(lf1, lane) + tot0;
        const float g0 = li0 - b0, g1 = li1 - b1;
        const float cm0 = wscan_max(g0, lane); const float tm0 = __shfl(cm0, 63, 64); const float cm1 = fmaxf(wscan_max(g1, lane), tm0);
        const float M0 = fmaxf(min_, cm0), M1 = fmaxf(min_, cm1);
        const int o = dir * 128;
        vec[V_GF + o + s0] = g0; vec[V_GF + o + s1] = g1; vec[V_MF + o + s0] = M0; vec[V_MF + o + s1] = M1;
        vec[V_SIF + o + s0] = __expf(min_ - M0); vec[V_SIF + o + s1] = __expf(min_ - M1);
        vec[V_EMF + o + s0] = __expf(-b0 - M0); vec[V_EMF + o + s1] = __expf(-b1 - M1);
    }
    __syncthreads();
    f32x4 sacc[4][2];
#pragma unroll
    for (int m = 0; m < 4; ++m)
#pragma unroll
        for (int n = 0; n < 2; ++n) sacc[m][n] = (f32x4){0.f, 0.f, 0.f, 0.f};
#pragma unroll 2
    for (int ks = 0; ks < 8; ++ks) {
        bf16x8 af[4], bfr[2];
#pragma unroll
        for (int m = 0; m < 4; ++m) af[m] = row_frag(lds + MX_Q, 528, 64 * wm + 16 * m, ks * 32, lane);
#pragma unroll
        for (int n = 0; n < 2; ++n) bfr[n] = row_frag(lds + MX_K, 528, 32 * wn + 16 * n, ks * 32, lane);
#pragma unroll
        for (int m = 0; m < 4; ++m)
#pragma unroll
            for (int n = 0; n < 2; ++n) sacc[m][n] = __builtin_amdgcn_mfma_f32_16x16x32_bf16(af[m], bfr[n], sacc[m][n], 0, 0, 0);
    }
    {
        const int t = tid >> 2, part = tid & 3; float df = 0.f, db = 0.f;
#pragma unroll 4
        for (int i = 0; i < 8; ++i) { float f[8]; unpack8(*(const LAS u32x4*)(lds + MX_Q + t * 528 + (part * 64 + i * 8) * 2), f);
#pragma unroll
            for (int j = 0; j < 8; ++j) { df += f[j] * vec[V_NF + part * 64 + i * 8 + j]; db += f[j] * vec[V_NB + part * 64 + i * 8 + j]; } }
        df += __shfl_xor(df, 1, 64); df += __shfl_xor(df, 2, 64); db += __shfl_xor(db, 1, 64); db += __shfl_xor(db, 2, 64);
        if (part == 0) { vec[V_DQF + t] = df; vec[V_DQB + t] = db; }
    }
    f32x4 pf[4][2], pb[4][2];
    {
        float gf[2], gb[2];
#pragma unroll
        for (int n = 0; n < 2; ++n) { const int s_ = 32 * wn + 16 * n + li_; gf[n] = vec[V_GF + s_]; gb[n] = vec[V_GB + s_]; }
#pragma unroll
        for (int m = 0; m < 4; ++m)
#pragma unroll
            for (int j = 0; j < 4; ++j) {
                const int t = 64 * wm + 16 * m + 4 * lg + j; const float Mf = vec[V_MF + t], Mb = vec[V_MB + t];
                float rsf = 0.f, rsb = 0.f;
#pragma unroll
                for (int n = 0; n < 2; ++n) { const int s_ = 32 * wn + 16 * n + li_;
                    const float ef = (s_ <= t) ? __expf(fminf(gf[n] - Mf, 0.f)) : 0.f, eb = (s_ >= t) ? __expf(fminf(gb[n] - Mb, 0.f)) : 0.f;
                    const float sv = sacc[m][n][j]; pf[m][n][j] = sv * ef; pb[m][n][j] = sv * eb; rsf += pf[m][n][j]; rsb += pb[m][n][j]; }
                rsf = row16_sum(rsf); rsb = row16_sum(rsb);
                if (li_ == 0) { vec[V_RSF + t * 4 + wn] = rsf; vec[V_RSB + t * 4 + wn] = rsb; }
            }
    }
    __syncthreads();
    if (tid < 128) { const int t = tid;
        const float denf = vec[V_RSF + t * 4] + vec[V_RSF + t * 4 + 1] + vec[V_RSF + t * 4 + 2] + vec[V_RSF + t * 4 + 3] + vec[V_SIF + t] * vec[V_DQF + t];
        const float denb = vec[V_RSB + t * 4] + vec[V_RSB + t * 4 + 1] + vec[V_RSB + t * 4 + 2] + vec[V_RSB + t * 4 + 3] + vec[V_SIB + t] * vec[V_DQB + t];
        const float rf = 1.0f / fmaxf(fabsf(denf), vec[V_EMF + t]), rb = 1.0f / fmaxf(fabsf(denb), vec[V_EMB + t]);
        vec[V_RF + t] = rf; vec[V_RB + t] = rb; vec[V_AF + t] = rf * vec[V_SIF + t]; vec[V_AB + t] = rb * vec[V_SIB + t]; }
    __syncthreads();
#pragma unroll
    for (int m = 0; m < 4; ++m)
#pragma unroll
        for (int j = 0; j < 4; ++j) { const int t = 64 * wm + 16 * m + 4 * lg + j; const float rf = vec[V_RF + t], rb = vec[V_RB + t];
#pragma unroll
            for (int n = 0; n < 2; ++n) *(LAS bf16_t*)(lds + MX_P + t * 272 + (32 * wn + 16 * n + li_) * 2) = f2bf(rf * pf[m][n][j] + rb * pb[m][n][j]); }
    f32x4 acc[4][4];
    {
        const bf16_t* cqf = CST + ((size_t)sf * 16 + c) * 65536 + (size_t)(64 * wn + li_) * 256 + 8 * lg;
        const bf16_t* cqb = CST + ((size_t)sb * 16 + c) * 65536 + (size_t)(64 * wn + li_) * 256 + 8 * lg;
        bf16x8 bq0[4], bq1[4];
#pragma unroll
        for (int n = 0; n < 4; ++n) bq0[n] = *(const bf16x8*)(cqf + (size_t)(16 * n) * 256);
#pragma unroll 1
        for (int dirq = 0; dirq < 2; ++dirq) {
            f32x4 accx[4][4];
#pragma unroll
            for (int m = 0; m < 4; ++m)
#pragma unroll
                for (int n = 0; n < 4; ++n) accx[m][n] = (f32x4){0.f, 0.f, 0.f, 0.f};
            const bf16_t* cx = dirq ? cqb : cqf;
#pragma unroll 1
            for (int ks = 0; ks < 8; ks += 2) {
#pragma unroll
                for (int n = 0; n < 4; ++n) bq1[n] = *(const bf16x8*)(cx + (size_t)(16 * n) * 256 + (ks + 1) * 32);
                {   bf16x8 af[4];
#pragma unroll
                    for (int m = 0; m < 4; ++m) af[m] = row_frag(lds + MX_Q, 528, 64 * wm + 16 * m, ks * 32, lane);
#pragma unroll
                    for (int m = 0; m < 4; ++m)
#pragma unroll
                        for (int n = 0; n < 4; ++n) accx[m][n] = __builtin_amdgcn_mfma_f32_16x16x32_bf16(af[m], bq0[n], accx[m][n], 0, 0, 0); }
                {   const bf16_t* nx = ks < 6 ? cx + (ks + 2) * 32 : cqb;
#pragma unroll
                    for (int n = 0; n < 4; ++n) bq0[n] = *(const bf16x8*)(nx + (size_t)(16 * n) * 256); }
                {   bf16x8 af[4];
#pragma unroll
                    for (int m = 0; m < 4; ++m) af[m] = row_frag(lds + MX_Q, 528, 64 * wm + 16 * m, (ks + 1) * 32, lane);
#pragma unroll
                    for (int m = 0; m < 4; ++m)
#pragma unroll
                        for (int n = 0; n < 4; ++n) accx[m][n] = __builtin_amdgcn_mfma_f32_16x16x32_bf16(af[m], bq1[n], accx[m][n], 0, 0, 0); }
            }
#pragma unroll
            for (int m = 0; m < 4; ++m)
#pragma unroll
                for (int j = 0; j < 4; ++j) { const int t = 64 * wm + 16 * m + 4 * lg + j; const float a_x = vec[(dirq ? V_AB : V_AF) + t];
#pragma unroll
                    for (int n = 0; n < 4; ++n) acc[m][n][j] = dirq ? acc[m][n][j] + a_x * accx[m][n][j] : a_x * accx[m][n][j]; }
        }
    }
    u32x4 vreg[8];
#pragma unroll
    for (int i = 0; i < 8; ++i) { const int piece = tid + 512 * i; vreg[i] = *(const u32x4*)(srcb + (size_t)(t0 + (piece >> 5)) * PW + 2048 + h * HD + (piece & 31) * 8); }
    __syncthreads();
#pragma unroll
    for (int i = 0; i < 8; ++i) { const int piece = tid + 512 * i, row = piece >> 5; *(LAS u32x4*)(lds + MX_Q + row * 528 + (piece & 31) * 16) = vreg[i]; }
    __syncthreads();
#pragma unroll
    for (int ks = 0; ks < 4; ++ks) {
        bf16x8 af[4], bfr[4];
#pragma unroll
        for (int m = 0; m < 4; ++m) af[m] = row_frag(lds + MX_P, 272, 64 * wm + 16 * m, ks * 32, lane);
#pragma unroll
        for (int n = 0; n < 4; ++n) bfr[n] = tr_frag(lds + MX_Q, 528, ks * 32, 64 * wn + 16 * n, lane);
#pragma unroll
        for (int m = 0; m < 4; ++m)
#pragma unroll
            for (int n = 0; n < 4; ++n) acc[m][n] = __builtin_amdgcn_mfma_f32_16x16x32_bf16(af[m], bfr[n], acc[m][n], 0, 0, 0);
    }
    u32x4 oraw[8];
#pragma unroll
    for (int i = 0; i < 8; ++i) { const int piece = tid + 512 * i; oraw[i] = *(const u32x4*)(P + (tok0 + (piece >> 5)) * PW + 3072 + h * HD + (piece & 31) * 8); }
#pragma unroll
    for (int m = 0; m < 4; ++m)
#pragma unroll
        for (int j = 0; j < 4; ++j) { const float sm = row16_sum(acc[m][0][j] + acc[m][1][j] + acc[m][2][j] + acc[m][3][j]);
            if (li_ == 0) vec[V_RSF + (64 * wm + 16 * m + 4 * lg + j) * 4 + wn] = sm; }
    __syncthreads();
    float mu[4][4];
#pragma unroll
    for (int m = 0; m < 4; ++m)
#pragma unroll
        for (int j = 0; j < 4; ++j) { const int t = 64 * wm + 16 * m + 4 * lg + j;
            mu[m][j] = (vec[V_RSF + t * 4] + vec[V_RSF + t * 4 + 1] + vec[V_RSF + t * 4 + 2] + vec[V_RSF + t * 4 + 3]) * (1.0f / 256.0f);
            float sq = 0.f;
#pragma unroll
            for (int n = 0; n < 4; ++n) { const float dl = acc[m][n][j] - mu[m][j]; sq += dl * dl; }
            sq = row16_sum(sq);
            if (li_ == 0) vec[V_RSB + t * 4 + wn] = sq; }
    __syncthreads();
#pragma unroll
    for (int m = 0; m < 4; ++m)
#pragma unroll
        for (int j = 0; j < 4; ++j) { const int t = 64 * wm + 16 * m + 4 * lg + j;
            const float rstd = rsqrtf((vec[V_RSB + t * 4] + vec[V_RSB + t * 4 + 1] + vec[V_RSB + t * 4 + 2] + vec[V_RSB + t * 4 + 3]) * (1.0f / 256.0f) + LN_EPS);
#pragma unroll
            for (int n = 0; n < 4; ++n) *(LAS float*)(lds + (t * 260 + 64 * wn + 16 * n + li_) * 4) = (acc[m][n][j] - mu[m][j]) * rstd; }
    __syncthreads();
    bf16_t* Y = (bf16_t*)(p.ws + WS_YCAT);
#pragma unroll
    for (int i = 0; i < 8; ++i) { const int piece = tid + 512 * i, row = piece >> 5, dg = piece & 31; const int col = h * HD + dg * 8;
        float o[8]; unpack8(oraw[i], o);
        const f32x4 h0 = *(const LAS f32x4*)(lds + (row * 260 + dg * 8) * 4), h1 = *(const LAS f32x4*)(lds + (row * 260 + dg * 8 + 4) * 4);
        const f32x4 w0 = *(const f32x4*)(p.mlstm_norm_w + col), w1 = *(const f32x4*)(p.mlstm_norm_w + col + 4);
        float y[8];
#pragma unroll
        for (int j = 0; j < 4; ++j) { y[j] = h0[j] * w0[j] * sigmoid_f(o[j]); y[4 + j] = h1[j] * w1[j] * sigmoid_f(o[4 + j]); }
        *(u32x4*)(Y + (tok0 + row) * DM + col) = pack8(y); }
}

constexpr int CM_W = 0, CM_V = 34816;
__device__ __forceinline__ void cmlp_unit(const Params& p, LAS unsigned char* lds, int unit) {
    const int tid = threadIdx.x, lane = tid & 63, wid = __builtin_amdgcn_readfirstlane(tid >> 6), wm = wid >> 2, wn = wid & 3, lg = lane >> 4, li_ = lane & 15;
    const int g = unit & 3, bc = unit >> 2;
    const size_t tok0 = (size_t)bc * CHK;
    const bf16_t* P = (const bf16_t*)(p.ws + WS_P);
    __syncthreads();
#pragma unroll
    for (int i = 0; i < 8; ++i) { const int idx = tid + 512 * i, row = idx >> 5, c4 = idx & 31;
        const float4 w = *(const float4*)(p.w_s + ((size_t)g * CHK + row) * CHK + c4 * 4);
        u32x2 o; o.x = cvt_pk_bf16(w.x, w.y); o.y = cvt_pk_bf16(w.z, w.w);
        *(LAS u32x2*)(lds + CM_W + row * 272 + c4 * 8) = o; }
#pragma unroll 2
    for (int i = 0; i < 8; ++i) { const int piece = tid + 512 * i, row = piece >> 5, dg = piece & 31;
        float f[8]; unpack8(*(const u32x4*)(P + (tok0 + row) * PW + 5120 + g * 256 + dg * 8), f);
        float sm = 0.f;
#pragma unroll
        for (int j = 0; j < 8; ++j) sm += f[j];
        sm = row16_sum(sm); sm += __shfl_xor(sm, 16, 64);
        const float mu = sm * (1.0f / 256.0f); float sq = 0.f;
#pragma unroll
        for (int j = 0; j < 8; ++j) { f[j] -= mu; sq += f[j] * f[j]; }
        sq = row16_sum(sq); sq += __shfl_xor(sq, 16, 64);
        const float rstd = rsqrtf(sq * (1.0f / 256.0f) + LN_EPS);
#pragma unroll
        for (int j = 0; j < 8; ++j) f[j] = f[j] * rstd * p.cmlp_norm_w[g * 256 + dg * 8 + j];
        *(LAS u32x4*)(lds + CM_V + row * 528 + dg * 16) = pack8(f); }
    __syncthreads();
    f32x4 acc[4][4];
#pragma unroll
    for (int m = 0; m < 4; ++m)
#pragma unroll
        for (int n = 0; n < 4; ++n) acc[m][n] = (f32x4){0.f, 0.f, 0.f, 0.f};
#pragma unroll
    for (int ks = 0; ks < 4; ++ks) {
        bf16x8 af[4], bfr[4];
#pragma unroll
        for (int m = 0; m < 4; ++m) af[m] = row_frag(lds + CM_W, 272, 64 * wm + 16 * m, ks * 32, lane);
#pragma unroll
        for (int n = 0; n < 4; ++n) bfr[n] = tr_frag(lds + CM_V, 528, ks * 32, 64 * wn + 16 * n, lane);
#pragma unroll
        for (int m = 0; m < 4; ++m)
#pragma unroll
            for (int n = 0; n < 4; ++n) acc[m][n] = __builtin_amdgcn_mfma_f32_16x16x32_bf16(af[m], bfr[n], acc[m][n], 0, 0, 0);
    }
    __syncthreads();
#pragma unroll
    for (int m = 0; m < 4; ++m)
#pragma unroll
        for (int j = 0; j < 4; ++j) { const int pp = 64 * wm + 16 * m + 4 * lg + j; const float bs = p.b_s[g * CHK + pp];
#pragma unroll
            for (int n = 0; n < 4; ++n) *(LAS float*)(lds + (pp * 260 + 64 * wn + 16 * n + li_) * 4) = acc[m][n][j] + bs; }
    __syncthreads();
    bf16_t* Y = (bf16_t*)(p.ws + WS_YCAT);
#pragma unroll 2
    for (int i = 0; i < 8; ++i) { const int piece = tid + 512 * i, row = piece >> 5, dg = piece & 31;
        float u[8]; unpack8(*(const u32x4*)(P + (tok0 + row) * PW + 4096 + g * 256 + dg * 8), u);
        const f32x4 s0 = *(const LAS f32x4*)(lds + (row * 260 + dg * 8) * 4), s1 = *(const LAS f32x4*)(lds + (row * 260 + dg * 8 + 4) * 4);
        float y[8];
#pragma unroll
        for (int j = 0; j < 4; ++j) { y[j] = u[j] * s0[j]; y[4 + j] = u[4 + j] * s1[j]; }
        *(u32x4*)(Y + (tok0 + row) * DM + 1024 + g * 256 + dg * 8) = pack8(y); }
}
__device__ __forceinline__ void phase_mix(const Params& p, LAS unsigned char* lds) {
#pragma unroll 1
    for (int u = blockIdx.x; u < 512; u += gridDim.x) mix_unit(p, lds, u);
#pragma unroll 1
    for (int u = blockIdx.x; u < 512; u += gridDim.x) cmlp_unit(p, lds, u);
    __syncthreads();
}

#define XB_TMO      128
#define XB_XCNT(j)  (256  + 64 * (j))
#define XB_XSUB(j)  (1280 + 64 * (j))
#define XB_XGEN(j)  (2304 + 64 * (j))
#define XB_TOP      3328
#define XB_TOPGEN   3392
#define XCD_BAR_WORDS 3456
#define XB_SPIN_CAP (1u << 18)

__device__ __forceinline__ unsigned xb_ld(unsigned* p)              { return __hip_atomic_load(p, __ATOMIC_RELAXED, __HIP_MEMORY_SCOPE_AGENT); }
__device__ __forceinline__ unsigned xb_add(unsigned* p, unsigned v) { return __hip_atomic_fetch_add(p, v, __ATOMIC_RELAXED, __HIP_MEMORY_SCOPE_AGENT); }
__device__ __forceinline__ unsigned xb_xcc_id() { return (unsigned)__builtin_amdgcn_s_getreg((3 << 11) | 20) & 0xFu; }
#define XB_SPIN(cond, bar) do { unsigned _sp = 0; while (cond) { __builtin_amdgcn_s_sleep(1); \
    if ((++_sp & 255u) == 0u) { if (xb_ld(&(bar)[XB_TMO])) break; if (_sp > XB_SPIN_CAP) { atomicAdd(&(bar)[XB_TMO], 1u); break; } } } } while (0)

struct XcdBarrier {
    unsigned* bar; unsigned x;
    volatile LAS unsigned* st;
};
__device__ __forceinline__ XcdBarrier xcd_barrier_post(unsigned* bar, volatile LAS unsigned* st) {
    XcdBarrier b; b.bar = bar; b.x = xb_xcc_id(); b.st = st;
    if (threadIdx.x == 0) (void)xb_add(&bar[XB_XCNT(b.x)], 1u);
    return b;
}
__device__ __forceinline__ void xcd_barrier_complete(unsigned* bar, unsigned x, unsigned& nloc, unsigned& nx) {
    const unsigned G = gridDim.x * gridDim.y * gridDim.z;
    unsigned sum, cnt, mine, sp = 0u;
    for (;;) {
        sum = 0u; cnt = 0u; mine = 0u;
#pragma unroll
        for (unsigned j = 0; j < 16; ++j) { const unsigned c = xb_ld(&bar[XB_XCNT(j)]); sum += c; cnt += (c > 0u) ? 1u : 0u; mine = (j == x) ? c : mine; }
        if (sum == G) break;
        __builtin_amdgcn_s_sleep(1);
        if ((++sp & 255u) == 0u) { if (xb_ld(&bar[XB_TMO])) break; if (sp > XB_SPIN_CAP) { atomicAdd(&bar[XB_TMO], 1u); break; } }
    }
    nloc = mine > 0u ? mine : 1u; nx = cnt > 0u ? cnt : 1u;
}
__device__ __forceinline__ void xcd_barrier(const XcdBarrier& b) {
    asm volatile("s_waitcnt vmcnt(0)" ::: "memory");
    __syncthreads();
    if (threadIdx.x == 0) {
        unsigned* bar = b.bar;
        __builtin_amdgcn_s_waitcnt(0);
        unsigned nloc = b.st[0], nx = b.st[1];
        if (nloc == 0u) { xcd_barrier_complete(bar, b.x, nloc, nx); b.st[0] = nloc; b.st[1] = nx; }
        const unsigned old = xb_add(&bar[XB_XSUB(b.x)], 1u);
        const unsigned gen = old / nloc;
        if (old + 1u == (gen + 1u) * nloc) {
            __builtin_amdgcn_fence(__ATOMIC_RELEASE, "agent");
            asm volatile("s_waitcnt vmcnt(0)" ::: "memory");
            const unsigned og = xb_add(&bar[XB_TOP], 1u);
            const unsigned tg = og / nx;
            if (og + 1u == (tg + 1u) * nx) xb_add(&bar[XB_TOPGEN], 1u);
            else XB_SPIN(xb_ld(&bar[XB_TOPGEN]) == tg, bar);
            __builtin_amdgcn_fence(__ATOMIC_ACQUIRE, "agent");
            xb_add(&bar[XB_XGEN(b.x)], 1u);
            asm volatile("s_waitcnt vmcnt(0)" ::: "memory");
        } else {
            XB_SPIN(xb_ld(&bar[XB_XGEN(b.x)]) == gen, bar);
            __builtin_amdgcn_fence(__ATOMIC_ACQUIRE, "agent");
            asm volatile("s_waitcnt vmcnt(0)" ::: "memory");
        }
    }
    __syncthreads();
}

enum { PH_PREP = 0, PH_HX = 1, PH_INPROJ = 2, PH_SCAN = 3, PH_MIX = 4, PH_OUTPROJ = 5, PH_LN1 = 6, PH_MOE1 = 7, PH_MOE2 = 8, PH_FINAL = 9, PH_END = 10 };
#ifndef DUP_PHASE
#define DUP_PHASE (-1)
#endif
constexpr int CW_BAR = 256;
__global__ void __launch_bounds__(512, 2) fwd(Params p, int lo, int hi) {
    extern __shared__ __attribute__((aligned(16))) unsigned char shm[];
    LAS unsigned char* lds = (LAS unsigned char*)shm;
    if (threadIdx.x < 4) ((LAS unsigned*)(lds + LDS_MISC))[threadIdx.x] = 0u;
    __syncthreads();
    XcdBarrier bar; bar.bar = (unsigned*)(p.ws + WS_CTL) + CW_BAR; bar.x = 0; bar.st = (volatile LAS unsigned*)(lds + LDS_MISC);
    if (hi - lo > 1) bar = xcd_barrier_post((unsigned*)(p.ws + WS_CTL) + CW_BAR, (volatile LAS unsigned*)(lds + LDS_MISC));
#define IN(k) (lo <= (k) && (k) < hi)
#define SEAM(k) do { if (IN(k) && IN((k) + 1)) xcd_barrier(bar); } while (0)
#define PHASE(k, ...) do { if (IN(k)) { __VA_ARGS__; if (DUP_PHASE == (k)) { xcd_barrier(bar); __VA_ARGS__; } } SEAM(k); } while (0)
    PHASE(PH_PREP, { phase_mod(p, lds); phase_postab(p); phase_convert(p, lds, 0, gridDim.x == 256 ? CONV_ITEMS_ALL - CONV_TAIL : CONV_ITEMS_ALL, blockIdx.x, gridDim.x); });
    PHASE(PH_HX, phase_hx(p, lds));
    PHASE(PH_INPROJ, { { SchedIn S{&p}; EpiIn E{&p}; pg8::gemm_phase<true, false>(lds, DM * 2, S, E); }
        { SchedIn8 S{&p}; EpiIn E{&p}; pg8::gemm_phase<true, true>(lds, DM, S, E); }
        if (gridDim.x == 256 && blockIdx.x >= 64 && blockIdx.x < 192) {
            const int f = CONV_ITEMS_ALL - CONV_TAIL + ((int)blockIdx.x - 64) * CT_B1; phase_convert(p, lds, f, f + CT_B1, 0, 1); } });
    PHASE(PH_SCAN, phase_scan(p, lds));
    PHASE(PH_MIX, phase_mix(p, lds));
    PHASE(PH_OUTPROJ, { SchedOut S{&p}; EpiOut E{&p}; pg8::gemm_phase<false, false>(lds, DM * 2, S, E); });
    PHASE(PH_LN1, phase_ln1(p, lds));
    PHASE(PH_MOE1, { LAS int* tab = (LAS int*)(lds + LDS_TAB); moe_build_table(p, tab); SchedMoe1 S{&p, tab}; EpiMoe1 E{&p}; pg8::gemm_phase<true, true>(lds, DM, S, E); });
    PHASE(PH_MOE2, { LAS int* tab = (LAS int*)(lds + LDS_TAB); moe_build_table(p, tab); SchedMoe2 S{&p, tab}; EpiMoe2 E{&p, lds}; pg8::gemm_phase<true, true>(lds, DE, S, E); });
    PHASE(PH_FINAL, phase_final(p, lds));
#undef PHASE
#undef IN
#undef SEAM
}

#ifndef MK_N_LAUNCHES
#define MK_N_LAUNCHES 1
#endif
extern "C" void kernel_launch(void* const* d_in, const int* in_sizes, int n_in, void* d_out, int out_size, void* d_ws, size_t ws_size, hipStream_t stream) {
    static int grid = 0;
    if (grid == 0) {
        if (n_in != 26 || out_size != NTOK * DM || ws_size < WS_END) { fprintf(stderr, "kernel_launch: unexpected shapes: n_in %d out %d ws %zu (need %zu)\n", n_in, out_size, ws_size, (size_t)WS_END); grid = -1; return; }
        int dev = 0, cus = 0, per_cu = 0;
        if (hipGetDevice(&dev) != hipSuccess || hipDeviceGetAttribute(&cus, hipDeviceAttributeMultiprocessorCount, dev) != hipSuccess) { grid = -1; return; }
        if (hipFuncSetAttribute((const void*)fwd, hipFuncAttributeMaxDynamicSharedMemorySize, LDS_TOTAL) != hipSuccess) { fprintf(stderr, "kernel_launch: hipFuncSetAttribute failed\n"); grid = -1; return; }
        if (hipOccupancyMaxActiveBlocksPerMultiprocessor(&per_cu, (const void*)fwd, 512, LDS_TOTAL) != hipSuccess || per_cu < 1) { fprintf(stderr, "kernel_launch: occupancy query says %d\n", per_cu); }
        (void)hipGetLastError();
        grid = cus;
    }
    if (grid < 0) return;
    Params p{};
    const float* const* in = (const float* const*)d_in;
    p.x = in[0]; p.c = in[1]; p.ctx = in[2]; p.c_ctx = in[3]; p.w_mod = in[4]; p.b_mod = in[5]; p.w_in = in[6]; p.conv_w = in[7]; p.conv_b = in[8]; p.gate_bias = in[9];
    p.mlstm_norm_w = in[10]; p.cmlp_norm_w = in[11]; p.w_s = in[12]; p.b_s = in[13]; p.w_out = in[14]; p.ln1_w = in[15]; p.ln1_b = in[16];
    p.r1_w = in[17]; p.r1_b = in[18]; p.r2_w = in[19]; p.r2_b = in[20]; p.w_gate = in[21]; p.w_up = in[22]; p.w_down = in[23]; p.ln2_w = in[24]; p.ln2_b = in[25];
    p.out = (float*)d_out; p.ws = (unsigned char*)d_ws;
    (void)hipMemsetAsync(p.ws, 0, WS_ZERO_END, stream);
#if MK_N_LAUNCHES == 1
    fwd<<<grid, 512, LDS_TOTAL, stream>>>(p, 0, PH_END);
#else
    for (int ph = 0; ph < PH_END; ++ph) fwd<<<grid, 512, LDS_TOTAL, stream>>>(p, ph, ph + 1);
#endif
}
```

```cpp
#include <hip/hip_runtime.h>
#include <cstdio>
#include <cstdint>

typedef unsigned short bf16_t;

constexpr int DM = 2048, NB = 8, SEQ = 2048, CTXL = 256;
constexpr int NTOK = NB * SEQ;
constexpr int NCTX = NB * CTXL;
constexpr int NROWS = NTOK + NCTX;
constexpr int DIN = 6160, DML = 1024, NH = 4, HD = 256, CHK = 128;
constexpr int NGATE = 16;
constexpr int PW = 6144;
constexpr int NE = 32, DE = 1024;
constexpr int NMOD = 6;
constexpr float ALPHA = 1.189207115002721f;
constexpr float LN_EPS = 1e-6f;
constexpr int HCAP = 40960;

constexpr size_t al256(size_t x) { return (x + 255) & ~(size_t)255; }
constexpr size_t WS_CTL   = 0;
constexpr size_t CTL_BYTES = 65536;
constexpr size_t WS_MOD   = WS_CTL + CTL_BYTES;
constexpr size_t MOD_BYTES = al256((size_t)9 * NMOD * DM * 4);
constexpr size_t WS_STATS = WS_MOD + MOD_BYTES;
constexpr size_t WS_ZERO_END = WS_STATS + al256((size_t)NTOK * 2 * 4);
constexpr size_t WS_POS   = WS_ZERO_END;
constexpr size_t WS_HX    = WS_POS + al256((size_t)96 * 1024 * 4);
constexpr size_t WS_GATES = WS_HX + al256((size_t)NROWS * DM * 2);
constexpr size_t WS_P     = WS_GATES + al256((size_t)NROWS * NGATE * 4);
constexpr size_t WS_PC    = WS_P + al256((size_t)NTOK * PW * 2);
constexpr size_t WS_YCAT  = WS_PC + al256((size_t)NCTX * 2048 * 2);
constexpr size_t WS_T     = WS_YCAT;
constexpr size_t WS_X1    = WS_YCAT + al256((size_t)NTOK * DM * 2);
constexpr size_t WS_LIST  = WS_X1 + al256((size_t)NTOK * DM * 4);
constexpr size_t WS_RT    = WS_LIST + al256((size_t)NE * NTOK * 4);
constexpr size_t WS_H     = WS_P;
constexpr size_t WS_Y2    = WS_RT + al256((size_t)NTOK * 2 * 4);
constexpr size_t WS_HDIR  = WS_Y2;
constexpr size_t WS_BTIN  = WS_Y2 + al256((size_t)NTOK * 2 * DM * 2);
constexpr size_t WS_BTOUT = WS_BTIN + al256((size_t)PW * DM * 2);
constexpr size_t WS_BTGU  = WS_BTOUT + al256((size_t)DM * DM * 2);
constexpr size_t WS_BTDN  = WS_BTGU + al256((size_t)NE * 2 * DE * DM * 2);
constexpr size_t WS_NST   = WS_BTDN + al256((size_t)NE * DM * DE * 2);
constexpr size_t WS_MST   = WS_NST + al256((size_t)64 * 16 * 256 * 4);
constexpr size_t WS_CST   = WS_Y2;
constexpr size_t WS_RWT   = WS_MST + al256((size_t)64 * 16 * 4);
constexpr size_t WS_RWH   = WS_RWT + al256((size_t)36 * DM * 4);
constexpr size_t WS_HX8   = WS_RWH + al256((size_t)2 * 48 * DM * 2);
constexpr size_t WS_WGT   = WS_HX8 + al256((size_t)NTOK * DM);
constexpr size_t WS_END   = WS_WGT + al256((size_t)NGATE * DM * 4);

constexpr int CW_CNT = 0;

struct Params {
    const float *x, *c, *ctx, *c_ctx, *w_mod, *b_mod, *w_in, *conv_w, *conv_b, *gate_bias, *mlstm_norm_w, *cmlp_norm_w, *w_s, *b_s, *w_out,
                *ln1_w, *ln1_b, *r1_w, *r1_b, *r2_w, *r2_b, *w_gate, *w_up, *w_down, *ln2_w, *ln2_b;
    float* out;
    unsigned char* ws;
};

__device__ __forceinline__ bf16_t f2bf(float f) { return __builtin_bit_cast(bf16_t, (__bf16)f); }
__device__ __forceinline__ float bf2f(bf16_t b) { return __uint_as_float(((unsigned)b) << 16); }
__device__ __forceinline__ float silu_f(float x) { return x * __builtin_amdgcn_rcpf(1.0f + __expf(-x)); }
__device__ __forceinline__ float sigmoid_f(float x) { return __builtin_amdgcn_rcpf(1.0f + __expf(-x)); }
__device__ __forceinline__ float logsigmoid_f(float x) { return fminf(x, 0.0f) - log1pf(__expf(-fabsf(x))); }
__device__ __forceinline__ float gelu_tanh_f(float x) {
    const float z = 0.7978845608028654f * (x + 0.044715f * x * x * x);
    const float e = __expf(2.0f * z);
    const float th = 1.0f - 2.0f * __builtin_amdgcn_rcpf(e + 1.0f);
    return 0.5f * x * (1.0f + th);
}
__device__ __forceinline__ float wave_sum(float v) {
#pragma unroll
    for (int o = 32; o > 0; o >>= 1) v += __shfl_xor(v, o, 64);
    return v;
}
__device__ __forceinline__ float pos_val(const float* pos, int tok_in_seq, int col) {
    const int r = tok_in_seq >> 6, cc = tok_in_seq & 63;
    return col < 1024 ? pos[r * 1024 + col] : pos[32 * 1024 + cc * 1024 + (col - 1024)];
}

#define LAS __attribute__((address_space(3)))
typedef short bf16x8 __attribute__((ext_vector_type(8)));
typedef float f32x4 __attribute__((ext_vector_type(4)));
typedef unsigned u32x4 __attribute__((ext_vector_type(4)));
constexpr int LDS_STAGE = 131072;
constexpr int LDS_TOTAL = 163840;
constexpr int LDS_ROWS  = 131072;
constexpr int LDS_TAB   = 150528;
constexpr int LDS_MISC  = 163840 - 256;

typedef int i32x4 __attribute__((ext_vector_type(4)));
typedef int i32x8 __attribute__((ext_vector_type(8)));
__device__ __forceinline__ i32x8 cat8(const bf16x8 lo, const bf16x8 hi) { return __builtin_shufflevector(__builtin_bit_cast(i32x4, lo), __builtin_bit_cast(i32x4, hi), 0, 1, 2, 3, 4, 5, 6, 7); }
constexpr int F8_SCALE_W = 0x79797979;
constexpr int F8_SCALE_A = 0x7f7f7f7f;
constexpr float F8_WMUL = 64.0f;
__device__ __forceinline__ unsigned pack4_fp8(float a, float b, float c, float d) { int w = 0; w = __builtin_amdgcn_cvt_pk_fp8_f32(a, b, w, false); w = __builtin_amdgcn_cvt_pk_fp8_f32(c, d, w, true); return (unsigned)w; }
typedef float f32x2_t __attribute__((ext_vector_type(2)));
__device__ __forceinline__ void unpack8_fp8(const unsigned lo, const unsigned hi, float (&f)[8]) {
    const f32x2_t a = __builtin_amdgcn_cvt_pk_f32_fp8((int)lo, false), b = __builtin_amdgcn_cvt_pk_f32_fp8((int)lo, true), c = __builtin_amdgcn_cvt_pk_f32_fp8((int)hi, false), d = __builtin_amdgcn_cvt_pk_f32_fp8((int)hi, true);
    f[0] = a[0]; f[1] = a[1]; f[2] = b[0]; f[3] = b[1]; f[4] = c[0]; f[5] = c[1]; f[6] = d[0]; f[7] = d[1];
}
typedef _Float16 h16x2 __attribute__((ext_vector_type(2)));
__device__ __forceinline__ unsigned pack2_h16(float a, float b) { h16x2 h; h.x = (_Float16)a; h.y = (_Float16)b; return __builtin_bit_cast(unsigned, h); }
__device__ __forceinline__ void unpack2_h16(unsigned w, float& a, float& b) { const h16x2 h = __builtin_bit_cast(h16x2, w); a = (float)h.x; b = (float)h.y; }
typedef unsigned u32x2 __attribute__((ext_vector_type(2)));
typedef __bf16 bf16x2_t __attribute__((ext_vector_type(2)));
typedef float f32x2v_t __attribute__((ext_vector_type(2)));
__device__ __forceinline__ unsigned cvt_pk_bf16(float lo, float hi) { const f32x2v_t v = {lo, hi}; return __builtin_bit_cast(unsigned, __builtin_convertvector(v, bf16x2_t)); }
__device__ __forceinline__ void unpack8(const u32x4 v, float (&f)[8]) {
    f[0] = __uint_as_float(v.x << 16); f[1] = __uint_as_float(v.x & 0xffff0000u); f[2] = __uint_as_float(v.y << 16); f[3] = __uint_as_float(v.y & 0xffff0000u);
    f[4] = __uint_as_float(v.z << 16); f[5] = __uint_as_float(v.z & 0xffff0000u); f[6] = __uint_as_float(v.w << 16); f[7] = __uint_as_float(v.w & 0xffff0000u);
}
__device__ __forceinline__ u32x4 pack8(const float (&f)[8]) { u32x4 w; w.x = cvt_pk_bf16(f[0], f[1]); w.y = cvt_pk_bf16(f[2], f[3]); w.z = cvt_pk_bf16(f[4], f[5]); w.w = cvt_pk_bf16(f[6], f[7]); return w; }


__device__ __forceinline__ void phase_mod(const Params& p, LAS unsigned char* lds) {
    LAS float* sc = (LAS float*)lds;
    LAS float* red = sc + 9 * 128;
    float* MOD = (float*)(p.ws + WS_MOD);
    const int tid = threadIdx.x;
    for (int item = blockIdx.x; item < 768; item += gridDim.x) {
        const int cb = item % 48, kb = item / 48;
        __syncthreads();
        for (int i = tid; i < 9 * 128; i += 512) {
            const int r = i / 128, k = i % 128;
            const float v = r < 8 ? p.c[r * DM + kb * 128 + k] : p.c_ctx[kb * 128 + k];
            sc[r * 128 + k] = silu_f(v);
        }
        __syncthreads();
        const int col = cb * 256 + (tid & 255), kh = tid >> 8;
        float acc[9];
#pragma unroll
        for (int r = 0; r < 9; ++r) acc[r] = 0.f;
        const float* wp = p.w_mod + (size_t)(kb * 128 + kh * 64) * (NMOD * DM) + col;
#pragma unroll 8
        for (int k = 0; k < 64; ++k) {
            const float w = wp[(size_t)k * (NMOD * DM)];
#pragma unroll
            for (int r = 0; r < 9; ++r) acc[r] += sc[r * 128 + kh * 64 + k] * w;
        }
        if (kh == 1) {
#pragma unroll
            for (int r = 0; r < 9; ++r) red[(tid & 255) * 9 + r] = acc[r];
        }
        __syncthreads();
        if (kh == 0) {
            const float bias = kb == 0 ? p.b_mod[col] : 0.f;
#pragma unroll
            for (int r = 0; r < 9; ++r) atomicAdd(&MOD[r * (NMOD * DM) + col], acc[r] + red[tid * 9 + r] + bias);
        }
    }
    __syncthreads();
}
__device__ __forceinline__ void phase_postab(const Params& p) {
    float* pos = (float*)(p.ws + WS_POS);
    for (int i = blockIdx.x * 512 + threadIdx.x; i < 96 * 1024; i += gridDim.x * 512) {
        const int row = i / 1024, j = i % 1024, jj = j & 511;
        const float omega = 1.0f / powf(10000.0f, (float)jj / 512.0f);
        const float pv = row < 32 ? (float)row : (float)(row - 32);
        const float a = pv * omega;
        pos[i] = j < 512 ? sinf(a) : cosf(a);
    }
    float* rwt = (float*)(p.ws + WS_RWT);
    for (int i = blockIdx.x * 512 + threadIdx.x; i < 36 * DM; i += gridDim.x * 512) {
        const int k = i / 36, j = i % 36;
        rwt[j * DM + k] = j < 4 ? p.r1_w[k * 4 + j] : p.r2_w[k * 32 + (j - 4)];
    }
    bf16_t* rwh = (bf16_t*)(p.ws + WS_RWH);
    for (int i = blockIdx.x * 512 + threadIdx.x; i < 48 * DM; i += gridDim.x * 512) {
        const int j = i / DM, k = i % DM;
        const float w = j < 4 ? p.r1_w[k * 4 + j] : j < 36 ? p.r2_w[k * 32 + (j - 4)] : 0.f;
        const bf16_t hi = f2bf(w); const bf16_t lo = f2bf(w - bf2f(hi));
        rwh[i] = hi; rwh[48 * DM + i] = lo;
    }
    float* wgt = (float*)(p.ws + WS_WGT);
    for (int i = blockIdx.x * 512 + threadIdx.x; i < NGATE * DM; i += gridDim.x * 512) { const int k = i >> 4, g = i & 15; wgt[g * DM + k] = p.w_in[(size_t)k * DIN + 4096 + g]; }
}

#define GLDS16(gptr, lptr) __builtin_amdgcn_global_load_lds((const unsigned*)(gptr), (LAS unsigned*)(lptr), 16, 0, 0)
constexpr int HXB = 68 * 256;
__device__ __forceinline__ void hx_stage(const Params& p, LAS float* ldsf, int buf, int chunk, int rowb, int wid, int lane) {
    const float* MOD = (const float*)(p.ws + WS_MOD); const float* pos = (const float*)(p.ws + WS_POS); const float* wgt = (const float*)(p.ws + WS_WGT);
    LAS float* xb = ldsf + buf * HXB; LAS float* pb = xb + 24 * 256; LAS float* mb = xb + 48 * 256; LAS float* wb = xb + 52 * 256;
    const int co = chunk * 256 + lane * 4;
#pragma unroll
    for (int r = 0; r < 3; ++r) { const int row = rowb + wid * 3 + r; const bool isx = row < NTOK; const int ts = row % SEQ;
        GLDS16((isx ? p.x + (size_t)row * DM : p.ctx + (size_t)(row - NTOK) * DM) + co, xb + (wid * 3 + r) * 256);
        if (isx) GLDS16((chunk < 4 ? pos + (ts >> 6) * 1024 : pos + 32 * 1024 + (ts & 63) * 1024 - 1024) + co, pb + (wid * 3 + r) * 256); }
    if (wid < 4) { const int row = (wid & 2) ? rowb + 23 : rowb; const int b = row < NTOK ? row / SEQ : 8;
        GLDS16(MOD + (size_t)b * (NMOD * DM) + ((wid & 1) ? 0 : DM) + co, mb + wid * 256); }
    for (int j = wid; j < 16; j += 8) GLDS16(wgt + (size_t)j * DM + co, wb + j * 256);
}
__device__ __forceinline__ void phase_hx(const Params& p, LAS unsigned char* lds) {
    bf16_t* HX = (bf16_t*)(p.ws + WS_HX); unsigned char* HX8 = (unsigned char*)(p.ws + WS_HX8);
    float* G = (float*)(p.ws + WS_GATES);
    LAS float* ldsf = (LAS float*)lds;
    const int tid = threadIdx.x, lane = tid & 63, wid = __builtin_amdgcn_readfirstlane(tid >> 6);
    for (int bt = blockIdx.x; bt < NROWS / 24; bt += gridDim.x) {
        const int rowb = bt * 24, row0 = rowb + wid * 3;
        const int bfirst = rowb < NTOK ? rowb / SEQ : 8;
        bool isx[3]; int pset[3];
#pragma unroll
        for (int r = 0; r < 3; ++r) { const int row = row0 + r; isx[r] = row < NTOK; pset[r] = ((row < NTOK ? row / SEQ : 8) != bfirst) ? 2 : 0; }
        float acc[3][NGATE];
#pragma unroll
        for (int r = 0; r < 3; ++r)
#pragma unroll
            for (int g = 0; g < NGATE; ++g) acc[r][g] = 0.f;
        asm volatile("s_waitcnt vmcnt(0) lgkmcnt(0)" ::: "memory"); __builtin_amdgcn_s_barrier();
        hx_stage(p, ldsf, 0, 0, rowb, wid, lane);
#pragma unroll 1
        for (int chunk = 0; chunk < 8; ++chunk) {
            asm volatile("s_waitcnt vmcnt(0) lgkmcnt(0)" ::: "memory"); __builtin_amdgcn_s_barrier();
            if (chunk < 7) hx_stage(p, ldsf, (chunk + 1) & 1, chunk + 1, rowb, wid, lane);
            const LAS float* xb = ldsf + (chunk & 1) * HXB + lane * 4; const LAS float* pb = xb + 24 * 256; const LAS float* mb = xb + 48 * 256; const LAS float* wb = xb + 52 * 256;
            const int col = chunk * 256 + lane * 4;
            f32x4 hv[3];
#pragma unroll
            for (int r = 0; r < 3; ++r) { f32x4 v = *(const LAS f32x4*)(xb + (wid * 3 + r) * 256);
                if (isx[r]) v += *(const LAS f32x4*)(pb + (wid * 3 + r) * 256);
                hv[r] = v * (*(const LAS f32x4*)(mb + pset[r] * 256) + 1.0f) + *(const LAS f32x4*)(mb + (pset[r] + 1) * 256);
                u32x2 o; o.x = cvt_pk_bf16(hv[r][0], hv[r][1]); o.y = cvt_pk_bf16(hv[r][2], hv[r][3]);
                *(u32x2*)(HX + (size_t)(row0 + r) * DM + col) = o;
                if (isx[r]) *(unsigned*)(HX8 + (size_t)(row0 + r) * DM + col) = pack4_fp8(hv[r][0], hv[r][1], hv[r][2], hv[r][3]); }
#pragma unroll
            for (int g = 0; g < NGATE; ++g) { const f32x4 w = *(const LAS f32x4*)(wb + g * 256);
#pragma unroll
                for (int r = 0; r < 3; ++r) acc[r][g] += hv[r][0] * w[0] + hv[r][1] * w[1] + hv[r][2] * w[2] + hv[r][3] * w[3]; }
        }
        {
            float v24[24], v12[12], v6[6];
            const bool h5 = lane & 32, h4 = lane & 16, h3 = lane & 8, h2 = lane & 4;
#pragma unroll
            for (int f = 0; f < 24; ++f) { const float lo = acc[f / 16][f % 16], hi = acc[(f + 24) / 16][(f + 24) % 16]; v24[f] = (h5 ? hi : lo) + __shfl_xor(h5 ? lo : hi, 32, 64); }
#pragma unroll
            for (int f = 0; f < 12; ++f) v12[f] = (h4 ? v24[f + 12] : v24[f]) + __shfl_xor(h4 ? v24[f] : v24[f + 12], 16, 64);
#pragma unroll
            for (int f = 0; f < 6; ++f) v6[f] = (h3 ? v12[f + 6] : v12[f]) + __shfl_xor(h3 ? v12[f] : v12[f + 6], 8, 64);
            const int f0 = (h5 ? 24 : 0) + (h4 ? 12 : 0) + (h3 ? 6 : 0) + (h2 ? 3 : 0);
#pragma unroll
            for (int f = 0; f < 3; ++f) { float x = (h2 ? v6[f + 3] : v6[f]) + __shfl_xor(h2 ? v6[f] : v6[f + 3], 4, 64); x += __shfl_xor(x, 2, 64); x += __shfl_xor(x, 1, 64);
                if ((lane & 3) == 0) { const int ff = f0 + f, r = ff >> 4, g = ff & 15; float v = x + p.gate_bias[g]; if ((g >> 2) & 1) v = logsigmoid_f(v); G[(size_t)(row0 + r) * NGATE + g] = v; } }
        }
    }
    asm volatile("s_waitcnt vmcnt(0) lgkmcnt(0)" ::: "memory"); __builtin_amdgcn_s_barrier();
}

constexpr int L1_X = 0, L1_P = 16384, L1_W = 16384 + 4096, L1_BUF = L1_W + 2 * 24576, L1_RED = 2 * L1_BUF;
constexpr int L1_LG = L1_RED;
__device__ __forceinline__ void ln1_stage(const Params& p, LAS unsigned char* lds, int buf, int chunk, int tokb, int b, int wid, int lane) {
    const bf16_t* X1 = (const bf16_t*)(p.ws + WS_X1); const bf16_t* RW = (const bf16_t*)(p.ws + WS_RWH); const float* MOD = (const float*)(p.ws + WS_MOD);
    LAS unsigned char* base = lds + buf * L1_BUF;
#pragma unroll
    for (int r2 = 0; r2 < 2; ++r2) { const int row = wid * 4 + 2 * r2 + (lane >> 5); const int gc = (lane & 31) ^ (row & 31);
        GLDS16(X1 + (size_t)(tokb + row) * DM + chunk * 256 + gc * 8, base + L1_X + (wid * 4 + 2 * r2) * 512); }
#pragma unroll
    for (int q = 0; q < 6; ++q) { const int rr = (wid * 6 + q) * 2 + (lane >> 5); const int n = rr % 48; const int gc = (lane & 31) ^ (n & 31);
        GLDS16(RW + (size_t)rr * DM + chunk * 256 + gc * 8, base + L1_W + (wid * 6 + q) * 1024); }
    const int cf = chunk * 256 + lane * 4;
    if (wid == 4) GLDS16(p.ln1_w + cf, base + L1_P);
    if (wid == 5) GLDS16(p.ln1_b + cf, base + L1_P + 1024);
    if (wid == 6) GLDS16(MOD + (size_t)b * (NMOD * DM) + 4 * DM + cf, base + L1_P + 2048);
    if (wid == 7) GLDS16(MOD + (size_t)b * (NMOD * DM) + 3 * DM + cf, base + L1_P + 3072);
}
__device__ __forceinline__ void phase_ln1(const Params& p, LAS unsigned char* lds) {
    const float* ST = (const float*)(p.ws + WS_STATS);
    unsigned char* T = (unsigned char*)(p.ws + WS_T);
    unsigned* cnt = (unsigned*)(p.ws + WS_CTL) + CW_CNT;
    int* list = (int*)(p.ws + WS_LIST);
    float* RT = (float*)(p.ws + WS_RT);
    LAS float* ldsf = (LAS float*)lds;
    const int tid = threadIdx.x, lane = tid & 63, wid = __builtin_amdgcn_readfirstlane(tid >> 6), li_ = lane & 15, lg = lane >> 4;
    for (int rb = blockIdx.x; rb < NTOK / 32; rb += gridDim.x) {
        const int tokb = rb * 32, b = tokb / SEQ, row0 = tokb + wid * 4;
        float mean[2], rstd[2];
#pragma unroll
        for (int m = 0; m < 2; ++m) { const float s1 = ST[(size_t)(tokb + 16 * m + li_) * 2], s2 = ST[(size_t)(tokb + 16 * m + li_) * 2 + 1];
            mean[m] = s1 * (1.0f / DM); rstd[m] = rsqrtf(fmaxf(s2 * (1.0f / DM) - mean[m] * mean[m], 0.f) + LN_EPS); }
        f32x4 acc[2][3];
#pragma unroll
        for (int m = 0; m < 2; ++m)
#pragma unroll
            for (int n = 0; n < 3; ++n) acc[m][n] = (f32x4){0.f, 0.f, 0.f, 0.f};
        asm volatile("s_waitcnt vmcnt(0) lgkmcnt(0)" ::: "memory"); __builtin_amdgcn_s_barrier();
        ln1_stage(p, lds, 0, 0, tokb, b, wid, lane);
#pragma unroll 1
        for (int chunk = 0; chunk < 8; ++chunk) {
            asm volatile("s_waitcnt vmcnt(0) lgkmcnt(0)" ::: "memory"); __builtin_amdgcn_s_barrier();
            if (chunk < 7) ln1_stage(p, lds, (chunk + 1) & 1, chunk + 1, tokb, b, wid, lane);
            const LAS unsigned char* base = lds + (chunk & 1) * L1_BUF;
            const int kc = 4 * wid + lg;
            const LAS float* pp = (const LAS float*)(base + L1_P) + kc * 8;
            const f32x4 lw0 = *(const LAS f32x4*)(pp), lw1 = *(const LAS f32x4*)(pp + 4), lb0 = *(const LAS f32x4*)(pp + 256), lb1 = *(const LAS f32x4*)(pp + 260);
            const f32x4 sc0 = *(const LAS f32x4*)(pp + 512) + 1.0f, sc1 = *(const LAS f32x4*)(pp + 516) + 1.0f, sh0 = *(const LAS f32x4*)(pp + 768), sh1 = *(const LAS f32x4*)(pp + 772);
            bf16x8 ahi[2], alo[2];
#pragma unroll
            for (int m = 0; m < 2; ++m) { const int row = 16 * m + li_;
                const u32x4 xw = *(const LAS u32x4*)(base + L1_X + row * 512 + ((kc ^ (row & 31)) << 4));
                float x[8]; unpack2_h16(xw.x, x[0], x[1]); unpack2_h16(xw.y, x[2], x[3]); unpack2_h16(xw.z, x[4], x[5]); unpack2_h16(xw.w, x[6], x[7]);
                float t[8];
#pragma unroll
                for (int j = 0; j < 4; ++j) { t[j] = ((x[j] - mean[m]) * rstd[m] * lw0[j] + lb0[j]) * sc0[j] + sh0[j]; t[4 + j] = ((x[4 + j] - mean[m]) * rstd[m] * lw1[j] + lb1[j]) * sc1[j] + sh1[j]; }
                u32x2 tw; tw.x = pack4_fp8(t[0], t[1], t[2], t[3]); tw.y = pack4_fp8(t[4], t[5], t[6], t[7]);
                *(u32x2*)(T + (size_t)(tokb + row) * DM + chunk * 256 + kc * 8) = tw;
                u32x4 hw, lw_; float r_[8];
                hw.x = cvt_pk_bf16(t[0], t[1]); hw.y = cvt_pk_bf16(t[2], t[3]); hw.z = cvt_pk_bf16(t[4], t[5]); hw.w = cvt_pk_bf16(t[6], t[7]);
                unpack8(hw, r_);
#pragma unroll
                for (int j = 0; j < 8; ++j) r_[j] = t[j] - r_[j];
                lw_.x = cvt_pk_bf16(r_[0], r_[1]); lw_.y = cvt_pk_bf16(r_[2], r_[3]); lw_.z = cvt_pk_bf16(r_[4], r_[5]); lw_.w = cvt_pk_bf16(r_[6], r_[7]);
                ahi[m] = __builtin_bit_cast(bf16x8, hw); alo[m] = __builtin_bit_cast(bf16x8, lw_); }
#pragma unroll
            for (int n = 0; n < 3; ++n) { const int rown = 16 * n + li_;
                const bf16x8 bhi = *(const LAS bf16x8*)(base + L1_W + rown * 512 + ((kc ^ (rown & 31)) << 4));
                const bf16x8 blo = *(const LAS bf16x8*)(base + L1_W + 24576 + rown * 512 + ((kc ^ (rown & 31)) << 4));
#pragma unroll
                for (int m = 0; m < 2; ++m) {
                    acc[m][n] = __builtin_amdgcn_mfma_f32_16x16x32_bf16(ahi[m], bhi, acc[m][n], 0, 0, 0);
                    acc[m][n] = __builtin_amdgcn_mfma_f32_16x16x32_bf16(ahi[m], blo, acc[m][n], 0, 0, 0);
                    acc[m][n] = __builtin_amdgcn_mfma_f32_16x16x32_bf16(alo[m], bhi, acc[m][n], 0, 0, 0); } }
        }
        asm volatile("s_waitcnt vmcnt(0) lgkmcnt(0)" ::: "memory"); __builtin_amdgcn_s_barrier();
        {   LAS float* red = (LAS float*)lds + wid * (32 * 48);
#pragma unroll
            for (int m = 0; m < 2; ++m)
#pragma unroll
                for (int n = 0; n < 3; ++n)
#pragma unroll
                    for (int j = 0; j < 4; ++j) red[(16 * m + 4 * lg + j) * 48 + 16 * n + li_] = acc[m][n][j]; }
        asm volatile("s_waitcnt lgkmcnt(0)" ::: "memory"); __builtin_amdgcn_s_barrier();
        LAS float* lgt = (LAS float*)(lds + L1_LG);
        for (int i = tid; i < 32 * 36; i += 512) { const int tkn = i / 36, j = i % 36; float sum = 0.f;
#pragma unroll
            for (int w = 0; w < 8; ++w) sum += ((const LAS float*)lds)[w * (32 * 48) + tkn * 48 + j];
            lgt[i] = sum; }
        asm volatile("s_waitcnt lgkmcnt(0)" ::: "memory"); __builtin_amdgcn_s_barrier();
        LAS int* esel = (LAS int*)(lds + L1_LG + 32 * 36 * 4);
        if (lane < 4) {
            const int tok = row0 + lane;
            const LAS float* lg = lgt + (wid * 4 + lane) * 36;
            int grp = 0; float l1[4];
#pragma unroll
            for (int j = 0; j < 4; ++j) l1[j] = lg[j] + p.r1_b[j];
            float best = l1[0];
#pragma unroll
            for (int j = 1; j < 4; ++j) if (l1[j] > best) { best = l1[j]; grp = j; }
            float se = 0.f;
#pragma unroll
            for (int j = 0; j < 4; ++j) se += __expf(l1[j] - best);
            const float pg = 1.0f / se;
            float v0 = -3.0e38f, v1 = -3.0e38f; int i0 = 0, i1 = 0;
#pragma unroll
            for (int j = 0; j < 8; ++j) {
                const float l = lg[4 + grp * 8 + j] + p.r2_b[grp * 8 + j];
                if (l > v0) { v1 = v0; i1 = i0; v0 = l; i0 = j; } else if (l > v1) { v1 = l; i1 = j; }
            }
            const float ex = __expf(v1 - v0);
            RT[tok * 2 + 0] = pg / (1.0f + ex); RT[tok * 2 + 1] = pg * ex / (1.0f + ex);
            esel[(wid * 4 + lane) * 2 + 0] = grp * 8 + i0; esel[(wid * 4 + lane) * 2 + 1] = grp * 8 + i1;
        }
        asm volatile("s_waitcnt lgkmcnt(0)" ::: "memory"); __builtin_amdgcn_s_barrier();
        if (tid < 32) {
            int c = 0;
            for (int i = 0; i < 64; ++i) c += (esel[i] == tid) ? 1 : 0;
            esel[64 + tid] = c > 0 ? (int)atomicAdd(&cnt[tid], (unsigned)c) : 0;
        }
        asm volatile("s_waitcnt vmcnt(0) lgkmcnt(0)" ::: "memory"); __builtin_amdgcn_s_barrier();
        if (tid < 64) {
            const int e = esel[tid]; int lr = 0;
            for (int i = 0; i < tid; ++i) lr += (esel[i] == e) ? 1 : 0;
            list[(size_t)e * NTOK + esel[64 + e] + lr] = (rb * 32 + (tid >> 1)) * 2 + (tid & 1);
        }
    }
    asm volatile("s_waitcnt vmcnt(0) lgkmcnt(0)" ::: "memory"); __builtin_amdgcn_s_barrier();
}

struct FinRaw { u32x2 ya[4], yb[4]; u32x4 x[4]; u32x2 g, st; };
__device__ __forceinline__ void fin_request(const Params& p, int tok, int lane, FinRaw& r) {
    const bf16_t* X1 = (const bf16_t*)(p.ws + WS_X1); const unsigned char* Y2 = (const unsigned char*)(p.ws + WS_Y2);
    const float* RT = (const float*)(p.ws + WS_RT); const float* ST = (const float*)(p.ws + WS_STATS);
#pragma unroll
    for (int i = 0; i < 4; ++i) { const int col = i * 512 + lane * 8;
        const unsigned char* a0 = Y2 + (size_t)(tok * 2) * DM + col; const unsigned char* a1 = a0 + DM; const bf16_t* a2 = X1 + (size_t)tok * DM + col;
        asm volatile("global_load_dwordx2 %0, %1, off" : "=v"(r.ya[i]) : "v"(a0) : "memory");
        asm volatile("global_load_dwordx2 %0, %1, off" : "=v"(r.yb[i]) : "v"(a1) : "memory");
        asm volatile("global_load_dwordx4 %0, %1, off" : "=v"(r.x[i]) : "v"(a2) : "memory"); }
    { const float* a3 = RT + tok * 2; const float* a4 = ST + (size_t)tok * 2;
      asm volatile("global_load_dwordx2 %0, %1, off" : "=v"(r.g) : "v"(a3) : "memory");
      asm volatile("global_load_dwordx2 %0, %1, off" : "=v"(r.st) : "v"(a4) : "memory"); }
}
__device__ __forceinline__ void phase_final(const Params& p, LAS unsigned char* lds) {
    const float* MOD = (const float*)(p.ws + WS_MOD);
    const int tid = threadIdx.x, lane = tid & 63, wid = __builtin_amdgcn_readfirstlane(tid >> 6);
    LAS float* PRM = (LAS float*)lds;
    LAS float* GT = PRM + 4 * DM;
    asm volatile("s_waitcnt vmcnt(0) lgkmcnt(0)" ::: "memory"); __builtin_amdgcn_s_barrier();
    {   const int col = tid * 4; const int pidx = (((col >> 9) * 2 + ((col >> 2) & 1)) * 64 + ((col & 511) >> 3)) * 4;
        *(LAS f32x4*)(PRM + pidx) = *(const f32x4*)(p.ln1_w + col) * ALPHA; *(LAS f32x4*)(PRM + DM + pidx) = *(const f32x4*)(p.ln1_b + col) * ALPHA;
        *(LAS f32x4*)(PRM + 2 * DM + pidx) = *(const f32x4*)(p.ln2_w + col); *(LAS f32x4*)(PRM + 3 * DM + pidx) = *(const f32x4*)(p.ln2_b + col);
#pragma unroll
        for (int b = 0; b < NB; ++b) *(LAS f32x4*)(GT + b * DM + pidx) = *(const f32x4*)(MOD + (size_t)b * (NMOD * DM) + 5 * DM + col);
    }
    asm volatile("s_waitcnt vmcnt(0) lgkmcnt(0)" ::: "memory"); __builtin_amdgcn_s_barrier();
    const int stride = gridDim.x * 8;
    int tok = blockIdx.x * 8 + wid;
    if (tok >= NTOK) return;
    FinRaw r; fin_request(p, tok, lane, r);
    bool first = true;
#pragma unroll 1
    for (; tok < NTOK; tok += stride) {
        if (first) asm volatile("s_waitcnt vmcnt(0)" ::: "memory"); else asm volatile("s_waitcnt vmcnt(8)" ::: "memory");
        first = false;
        const LAS float* gt = GT + (tok / SEQ) * DM;
        const unsigned ug0 = r.g.x, ug1 = r.g.y, us1 = r.st.x, us2 = r.st.y;
        const float g0 = __uint_as_float(ug0) * 0.0625f, g1 = __uint_as_float(ug1) * 0.0625f;
        const float st1 = __uint_as_float(us1), st2 = __uint_as_float(us2);
        const float mean1 = st1 * (1.0f / DM), rstd1 = rsqrtf(fmaxf(st2 * (1.0f / DM) - mean1 * mean1, 0.f) + LN_EPS);
        float v[32]; float s = 0.f;
#pragma unroll
        for (int i = 0; i < 4; ++i) {
            float ya[8], yb[8]; unpack8_fp8(r.ya[i].x, r.ya[i].y, ya); unpack8_fp8(r.yb[i].x, r.yb[i].y, yb);
            float xr[8]; unpack2_h16(r.x[i].x, xr[0], xr[1]); unpack2_h16(r.x[i].y, xr[2], xr[3]); unpack2_h16(r.x[i].z, xr[4], xr[5]); unpack2_h16(r.x[i].w, xr[6], xr[7]);
            const int o0 = (i * 2 * 64 + lane) * 4, o1 = o0 + 256;
            const f32x4 xa = ((f32x4){xr[0], xr[1], xr[2], xr[3]} - mean1) * rstd1 * *(const LAS f32x4*)(PRM + o0) + *(const LAS f32x4*)(PRM + DM + o0);
            const f32x4 xb = ((f32x4){xr[4], xr[5], xr[6], xr[7]} - mean1) * rstd1 * *(const LAS f32x4*)(PRM + o1) + *(const LAS f32x4*)(PRM + DM + o1);
            const f32x4 ga = *(const LAS f32x4*)(gt + o0), gb = *(const LAS f32x4*)(gt + o1);
#pragma unroll
            for (int j = 0; j < 4; ++j) { v[i * 8 + j] = xa[j] + ga[j] * (g0 * ya[j] + g1 * yb[j]); v[i * 8 + 4 + j] = xb[j] + gb[j] * (g0 * ya[4 + j] + g1 * yb[4 + j]); }
#pragma unroll
            for (int j = 0; j < 8; ++j) s += v[i * 8 + j];
        }
        {   const int tn = tok + stride < NTOK ? tok + stride : tok;
            fin_request(p, tn, lane, r); }
        const float mu = wave_sum(s) * (1.0f / DM);
        float q = 0.f;
#pragma unroll
        for (int i = 0; i < 32; ++i) { const float dlt = v[i] - mu; q += dlt * dlt; }
        const float rstd = rsqrtf(wave_sum(q) * (1.0f / DM) + LN_EPS);
#pragma unroll
        for (int i = 0; i < 4; ++i) {
            const int col = i * 512 + lane * 8;
            const int o0 = (i * 2 * 64 + lane) * 4, o1 = o0 + 256;
            const f32x4 wa = *(const LAS f32x4*)(PRM + 2 * DM + o0), wb = *(const LAS f32x4*)(PRM + 2 * DM + o1), ba = *(const LAS f32x4*)(PRM + 3 * DM + o0), bb = *(const LAS f32x4*)(PRM + 3 * DM + o1);
            f32x4 oa, ob;
#pragma unroll
            for (int j = 0; j < 4; ++j) { oa[j] = (v[i * 8 + j] - mu) * rstd * wa[j] + ba[j]; ob[j] = (v[i * 8 + 4 + j] - mu) * rstd * wb[j] + bb[j]; }
            *(f32x4*)(p.out + (size_t)tok * DM + col) = oa; *(f32x4*)(p.out + (size_t)tok * DM + col + 4) = ob;
        }
    }
    asm volatile("s_waitcnt vmcnt(0)" ::: "memory");
}

__device__ __forceinline__ void conv_item_src(const Params& p, int item, const float*& src, int& ld, unsigned char*& dst, int& K, bool& f8) {
    f8 = false;
    if (item < 1536) {
        const int nt = item % 48, kt = item / 48; const int n0 = nt * 128, sc = n0 < 4096 ? n0 : n0 + NGATE;
        ld = DIN; K = DM; src = p.w_in + (size_t)(kt * 64) * DIN + sc;
        if (n0 >= 3072 && n0 < 4096) { dst = (unsigned char*)(p.ws + WS_BTIN) + (size_t)3072 * DM * 2 + (size_t)(n0 - 3072) * DM + kt * 64; f8 = true; }
        else if (n0 >= 5120) { dst = (unsigned char*)(p.ws + WS_BTIN) + (size_t)5120 * DM * 2 + (size_t)(n0 - 5120) * DM + kt * 64; f8 = true; }
        else dst = (unsigned char*)(p.ws + WS_BTIN) + ((size_t)n0 * DM + kt * 64) * 2;
        return;
    }
    item -= 1536;
    if (item < 512) {
        const int nt = item % 16, kt = item / 16;
        ld = DM; K = DM; src = p.w_out + (size_t)(kt * 64) * DM + nt * 128; dst = (unsigned char*)(p.ws + WS_BTOUT) + ((size_t)(nt * 128) * DM + kt * 64) * 2; return;
    }
    item -= 512;
    if (item < 16384) {
        const int kt = item & 31, pn = (item >> 5) & 7, which = (item >> 8) & 1, e = item >> 9;
        ld = DE; K = DM; src = (which ? p.w_up : p.w_gate) + (size_t)e * DM * DE + (size_t)(kt * 64) * DE + pn * 128;
        dst = (unsigned char*)(p.ws + WS_BTGU) + ((size_t)(e * 8 + pn) * 256 + which * 128) * DM + kt * 64; f8 = true; return;
    }
    item -= 16384;
    {
        const int kt = item & 15, nt = (item >> 4) & 15, e = item >> 8;
        ld = DM; K = DE; src = p.w_down + (size_t)e * DE * DM + (size_t)(kt * 64) * DM + nt * 128;
        dst = (unsigned char*)(p.ws + WS_BTDN) + ((size_t)e * DM + nt * 128) * DE + kt * 64; f8 = true;
    }
}
constexpr int CONV_ITEMS_ALL = 1536 + 512 + 16384 + 8192;
constexpr int CT_B1 = 18;
constexpr int CONV_TAIL2 = 128 * 22;
constexpr int CONV_TAIL = 128 * CT_B1;
__device__ __forceinline__ void phase_convert(const Params& p, LAS unsigned char* lds, const int first, const int CONV_ITEMS, const int start, const int stride) {
    LAS float* tile = (LAS float*)lds;
    const int tid = threadIdx.x;
    float4 r[4];
    int item = first + start;
    const float* src; int ld; unsigned char* dst; int K; bool f8;
    if (item < CONV_ITEMS) {
        conv_item_src(p, item, src, ld, dst, K, f8);
#pragma unroll
        for (int i = 0; i < 4; ++i) { const int idx = tid + 512 * i; r[i] = *(const float4*)(src + (size_t)(idx >> 5) * ld + (idx & 31) * 4); }
    }
    for (; item < CONV_ITEMS; item += stride) {
        __syncthreads();
#pragma unroll
        for (int i = 0; i < 4; ++i) { const int idx = tid + 512 * i; LAS float* t = tile + (idx >> 5) * 129 + (idx & 31) * 4; t[0] = r[i].x; t[1] = r[i].y; t[2] = r[i].z; t[3] = r[i].w; }
        unsigned char* cdst = dst; const int cK = K; const bool cf8 = f8;
        const int nitem = item + stride;
        if (nitem < CONV_ITEMS) {
            conv_item_src(p, nitem, src, ld, dst, K, f8);
#pragma unroll
            for (int i = 0; i < 4; ++i) { const int idx = tid + 512 * i; r[i] = *(const float4*)(src + (size_t)(idx >> 5) * ld + (idx & 31) * 4); }
        }
        __syncthreads();
#pragma unroll
        for (int i = 0; i < 2; ++i) {
            const int o = tid + 512 * i, kg = o & 7, n = o >> 3;
            const LAS float* t = tile + (kg * 8) * 129 + n;
            if (cf8) { u32x2 w;
                w.x = pack4_fp8(t[0 * 129] * F8_WMUL, t[1 * 129] * F8_WMUL, t[2 * 129] * F8_WMUL, t[3 * 129] * F8_WMUL);
                w.y = pack4_fp8(t[4 * 129] * F8_WMUL, t[5 * 129] * F8_WMUL, t[6 * 129] * F8_WMUL, t[7 * 129] * F8_WMUL);
                *(u32x2*)(cdst + (size_t)n * cK + kg * 8) = w;
            } else { u32x4 w;
                w.x = cvt_pk_bf16(t[0 * 129], t[1 * 129]); w.y = cvt_pk_bf16(t[2 * 129], t[3 * 129]);
                w.z = cvt_pk_bf16(t[4 * 129], t[5 * 129]); w.w = cvt_pk_bf16(t[6 * 129], t[7 * 129]);
                *(u32x4*)(cdst + ((size_t)n * cK + kg * 8) * 2) = w; }
        }
    }
    __syncthreads();
}

namespace pg8 {
constexpr int BM = 256, BK = 64, HALF = 128, HTB = HALF * BK * 2, STAGE_BYTES = 8 * HTB;
__device__ __forceinline__ int lds_byte(int r, int c) { const int st = (r >> 4) * 2 + (c >> 5), rr = r & 15, cc = c & 31, ob = rr * 64 + cc * 2; return st * 1024 + (ob ^ (((ob >> 9) & 1) << 5)); }
__device__ __forceinline__ void stage_rc(int b, int& R, int& C) { const int st = b / 1024, sb = b % 1024, swz = sb ^ (((sb >> 9) & 1) << 5); R = (st >> 1) * 16 + swz / 64; C = (st & 1) * 32 + (swz % 64) / 2; }
__device__ __forceinline__ int perm32(int rho) { const int n = rho >> 4, i = rho & 15; return 8 * (i >> 2) + 4 * n + (i & 3); }

struct Unit {
    const char* a;
    const char* b;
    const int* rows;
    int rows_lds;
    int nvalid;
    int pm, pn, e, aux;
};

template <bool PERM, bool F8, class Epi, class Sched>
__device__ __forceinline__ void gemm_phase(LAS unsigned char* lds, const int KB, const Sched& S, const Epi& E) {
    const int tid = threadIdx.x, wid = __builtin_amdgcn_readfirstlane(tid >> 6), lane = tid & 63, wr = wid >> 2, wc = wid & 3, fr = lane & 15, fq = lane >> 4;
    const int nt = KB / 128;
    unsigned vb0, vb1;
    { int Rr[2], Cc[2]; stage_rc(tid * 16, Rr[0], Cc[0]); stage_rc(tid * 16 + 8192, Rr[1], Cc[1]);
      const int Rb0 = PERM ? ((Rr[0] & ~31) + perm32(Rr[0] & 31)) : Rr[0], Rb1 = PERM ? ((Rr[1] & ~31) + perm32(Rr[1] & 31)) : Rr[1];
      vb0 = (unsigned)(Rb0 * KB + 2 * Cc[0]); vb1 = (unsigned)(Rb1 * KB + 2 * Cc[1]); }
    const size_t kstep = (size_t)(BK * 2);
    const size_t hstepB = (size_t)HALF * KB;
    const unsigned ldsw = (unsigned)wid * 1024u;
    const int aoff = lds_byte(wr * 64 + fr, fq * 8), boff = lds_byte(wc * 32 + fr, fq * 8);
#define PG8_SA(b, h) (((b) * 2 + (h)) * HTB)
#define PG8_SB(b, h) ((4 + (b) * 2 + (h)) * HTB)
#define PG8_STAGE2(bufoff, gbase, v0, v1) do { \
        __builtin_amdgcn_global_load_lds((const unsigned*)((const char*)(gbase) + (v0)), (LAS unsigned*)(lds + (bufoff) + ldsw), 16, 0, 0); \
        __builtin_amdgcn_global_load_lds((const unsigned*)((const char*)(gbase) + (v1)), (LAS unsigned*)(lds + (bufoff) + ldsw + 8192), 16, 0, 0); } while (0)
#define PG8_LD16(off) (*(const LAS i32x4*)(lds + (off)))
#define PG8_LDA(dst, b, h) do { if constexpr (F8) { _Pragma("unroll") for (int m = 0; m < 4; ++m) dst##8[m] = __builtin_shufflevector(PG8_LD16(PG8_SA(b, h) + aoff + m * 2048), PG8_LD16(PG8_SA(b, h) + aoff + m * 2048 + 1024), 0, 1, 2, 3, 4, 5, 6, 7); } \
        else { _Pragma("unroll") for (int m = 0; m < 4; ++m) _Pragma("unroll") for (int k = 0; k < 2; ++k) dst[m][k] = *(const LAS bf16x8*)(lds + PG8_SA(b, h) + aoff + m * 2048 + k * 1024); } } while (0)
#define PG8_LDB(dst, b, h) do { if constexpr (F8) { _Pragma("unroll") for (int n = 0; n < 2; ++n) dst##8[n] = __builtin_shufflevector(PG8_LD16(PG8_SB(b, h) + boff + n * 2048), PG8_LD16(PG8_SB(b, h) + boff + n * 2048 + 1024), 0, 1, 2, 3, 4, 5, 6, 7); } \
        else { _Pragma("unroll") for (int n = 0; n < 2; ++n) _Pragma("unroll") for (int k = 0; k < 2; ++k) dst[n][k] = *(const LAS bf16x8*)(lds + PG8_SB(b, h) + boff + n * 2048 + k * 1024); } } while (0)
#define PG8_MMA(ai, bj, At, Bt) do { __builtin_amdgcn_s_setprio(1); \
        if constexpr (F8) { _Pragma("unroll") for (int m = 0; m < 4; ++m) _Pragma("unroll") for (int n = 0; n < 2; ++n) \
            asm volatile("v_mfma_scale_f32_16x16x128_f8f6f4 %0, %1, %2, %0, %3, %4 op_sel_hi:[0,0,0]" : "+v"(acc[ai][bj][m][n]) : "v"(Bt##8[n]), "v"(At##8[m]), "v"(f8sw), "v"(f8sa)); } \
        else { _Pragma("unroll") for (int m = 0; m < 4; ++m) _Pragma("unroll") for (int n = 0; n < 2; ++n) _Pragma("unroll") for (int k = 0; k < 2; ++k) \
            acc[ai][bj][m][n] = __builtin_amdgcn_mfma_f32_16x16x32_bf16(Bt[n][k], At[m][k], acc[ai][bj][m][n], 0, 0, 0); } \
        __builtin_amdgcn_s_setprio(0); } while (0)
#define PG8_WAIT_V(n) asm volatile("s_waitcnt vmcnt(" #n ")" ::: "memory")
#define PG8_WAIT_L(n) asm volatile("s_waitcnt lgkmcnt(" #n ")" ::: "memory")
#define PG8_BAR __builtin_amdgcn_s_barrier()
#define PG8_SCHED __builtin_amdgcn_sched_barrier(0)
#define PG8_VOFF(u, v00, v01, v10, v11) do { int Rr[2], Cc[2]; int tq = tid; asm volatile("" : "+v"(tq)); stage_rc(tq * 16, Rr[0], Cc[0]); stage_rc(tq * 16 + 8192, Rr[1], Cc[1]); \
        if ((u).rows_lds >= 0) { const int nvm = (u).nvalid - 1; const LAS int* rl_ = (const LAS int*)(lds + (u).rows_lds); \
            const int r00 = Rr[0] < nvm ? Rr[0] : nvm, r01 = Rr[1] < nvm ? Rr[1] : nvm, r10 = (Rr[0] + 128) < nvm ? (Rr[0] + 128) : nvm, r11 = (Rr[1] + 128) < nvm ? (Rr[1] + 128) : nvm; \
            v00 = (unsigned)((rl_[r00] >> 1) * KB + 2 * Cc[0]); v01 = (unsigned)((rl_[r01] >> 1) * KB + 2 * Cc[1]); \
            v10 = (unsigned)((rl_[r10] >> 1) * KB + 2 * Cc[0]); v11 = (unsigned)((rl_[r11] >> 1) * KB + 2 * Cc[1]); \
        } else { v00 = (unsigned)(Rr[0] * KB + 2 * Cc[0]); v01 = (unsigned)(Rr[1] * KB + 2 * Cc[1]); v10 = (unsigned)((Rr[0] + 128) * KB + 2 * Cc[0]); v11 = (unsigned)((Rr[1] + 128) * KB + 2 * Cc[1]); } } while (0)
    Unit cur, nxt; int ui = 0;
    if (!S.next(0, cur)) return;
    f32x4 acc[2][2][4][2];
#pragma unroll
    for (int a = 0; a < 2; ++a)
#pragma unroll
        for (int b = 0; b < 2; ++b)
#pragma unroll
            for (int m = 0; m < 4; ++m)
#pragma unroll
                for (int n = 0; n < 2; ++n) acc[a][b][m][n] = (f32x4){0.f, 0.f, 0.f, 0.f};
    bf16x8 At[4][2], B0[2][2], B1[2][2]; i32x8 At8[4], B08[2], B18[2];
    const int f8sw = F8_SCALE_W, f8sa = F8_SCALE_A;
    unsigned vc00, vc01, vc10, vc11, vn00, vn01, vn10, vn11;
    PG8_VOFF(cur, vc00, vc01, vc10, vc11);
    const char* cA = cur.a; const char* cB = cur.b;
    PG8_STAGE2(PG8_SB(0, 0), cB, vb0, vb1); PG8_STAGE2(PG8_SA(0, 0), cA, vc00, vc01); PG8_STAGE2(PG8_SB(0, 1), cB + hstepB, vb0, vb1); PG8_STAGE2(PG8_SA(0, 1), cA, vc10, vc11);
    if (wr == 1) PG8_BAR;
    PG8_WAIT_V(4); PG8_BAR;
    PG8_STAGE2(PG8_SB(1, 0), cB + kstep, vb0, vb1); PG8_STAGE2(PG8_SA(1, 0), cA + kstep, vc00, vc01); PG8_STAGE2(PG8_SB(1, 1), cB + hstepB + kstep, vb0, vb1);
    PG8_WAIT_V(6); PG8_BAR;
    for (;;) {
        const bool has_next = S.next(ui + 1, nxt);
        const char* nA = has_next ? nxt.a : cA; const char* nB = has_next ? nxt.b : cB;
        if (has_next) { PG8_VOFF(nxt, vn00, vn01, vn10, vn11); } else { vn00 = vc00; vn01 = vc01; vn10 = vc10; vn11 = vc11; }
        for (int t = 0; t < nt; t += 2) {
            const bool last = (t == nt - 2);
            const char* a1 = cA + (size_t)(t + 1) * kstep;
            const char* a2 = last ? nA : cA + (size_t)(t + 2) * kstep; const char* b2 = last ? nB : cB + (size_t)(t + 2) * kstep;
            const char* a3 = a2 + kstep; const char* b3 = b2 + kstep;
            const unsigned w00 = last ? vn00 : vc00, w01 = last ? vn01 : vc01, w10 = last ? vn10 : vc10, w11 = last ? vn11 : vc11;
            PG8_LDB(B0, 0, 0); PG8_SCHED; PG8_LDA(At, 0, 0); PG8_STAGE2(PG8_SA(1, 1), a1, vc10, vc11);
            PG8_WAIT_L(8); PG8_BAR; PG8_WAIT_L(0); PG8_MMA(0, 0, At, B0); PG8_BAR; PG8_SCHED;
            PG8_LDB(B1, 0, 1); PG8_STAGE2(PG8_SB(0, 0), b2, vb0, vb1);
            PG8_BAR; PG8_WAIT_L(0); PG8_MMA(0, 1, At, B1); PG8_BAR;
            PG8_LDA(At, 0, 1); PG8_STAGE2(PG8_SA(0, 0), a2, w00, w01);
            PG8_BAR; PG8_WAIT_L(0); PG8_MMA(1, 0, At, B0); PG8_BAR; PG8_SCHED;
            PG8_STAGE2(PG8_SB(0, 1), b2 + hstepB, vb0, vb1);
            PG8_WAIT_V(6); PG8_BAR; PG8_MMA(1, 1, At, B1); PG8_BAR;
            PG8_LDB(B0, 1, 0); PG8_SCHED; PG8_LDA(At, 1, 0); PG8_STAGE2(PG8_SA(0, 1), a2, w10, w11);
            PG8_WAIT_L(8); PG8_BAR; PG8_WAIT_L(0); PG8_MMA(0, 0, At, B0); PG8_BAR; PG8_SCHED;
            PG8_LDB(B1, 1, 1); PG8_STAGE2(PG8_SB(1, 0), b3, vb0, vb1);
            PG8_BAR; PG8_WAIT_L(0); PG8_MMA(0, 1, At, B1); PG8_BAR;
            PG8_LDA(At, 1, 1); PG8_STAGE2(PG8_SA(1, 0), a3, w00, w01);
            PG8_BAR; PG8_WAIT_L(0); PG8_MMA(1, 0, At, B0); PG8_BAR; PG8_SCHED;
            PG8_STAGE2(PG8_SB(1, 1), b3 + hstepB, vb0, vb1);
            PG8_WAIT_V(6); PG8_BAR; PG8_MMA(1, 1, At, B1); PG8_BAR;
        }
        if constexpr (F8) asm volatile("s_nop 15\n\ts_nop 15" ::: "memory");
        E(acc, cur, wr, wc, fr, fq);
        if (!has_next) break;
#pragma unroll
        for (int a = 0; a < 2; ++a)
#pragma unroll
            for (int b = 0; b < 2; ++b)
#pragma unroll
                for (int m = 0; m < 4; ++m)
#pragma unroll
                    for (int n = 0; n < 2; ++n) acc[a][b][m][n] = (f32x4){0.f, 0.f, 0.f, 0.f};
        cur = nxt; cA = nA; cB = nB; vc00 = vn00; vc01 = vn01; vc10 = vn10; vc11 = vn11; ++ui;
    }
    PG8_WAIT_V(0);
    if (wr == 0) PG8_BAR;
    PG8_BAR;
#undef PG8_SA
#undef PG8_SB
#undef PG8_STAGE2
#undef PG8_LDA
#undef PG8_LDB
#undef PG8_LD16
#undef PG8_MMA
#undef PG8_WAIT_V
#undef PG8_WAIT_L
#undef PG8_BAR
#undef PG8_SCHED
#undef PG8_VOFF
}

__device__ __forceinline__ void static_tile(int L, int nM, int nN, int& pm, int& pn) {
    const int nwg = nM * nN; int wgid = L;
    { const int q = nwg / 8, r = nwg % 8, xcd = wgid % 8, off = wgid / 8; wgid = (xcd < r ? xcd * (q + 1) : r * (q + 1) + (xcd - r) * q) + off; }
    const int nig = 8 * nN, gid = wgid / nig, fm = gid * 8, gsz = (nM - fm) < 8 ? (nM - fm) : 8;
    pm = fm + ((wgid % nig) % gsz); pn = (wgid % nig) / gsz;
}
}

struct SchedIn {
    const Params* p;
    __device__ __forceinline__ bool next(int i, pg8::Unit& u) const {
        const long L = (long)i * gridDim.x + blockIdx.x;
        const char* HXb = (const char*)(p->ws + WS_HX); const char* BT = (const char*)(p->ws + WS_BTIN);
        u.rows = nullptr; u.rows_lds = -1; u.nvalid = 256; u.e = 0;
        if (L < 1024) { int j; pg8::static_tile((int)L, 64, 16, u.pm, j); u.pn = j < 12 ? j : j + 4; u.aux = 0; u.a = HXb + (size_t)u.pm * 256 * DM * 2; u.b = BT + (size_t)u.pn * 256 * DM * 2; return true; }
        if (L < 1088) { const int l = (int)L - 1024; u.pm = l >> 3; u.pn = l & 7; u.aux = 1; u.a = HXb + (size_t)(NTOK + u.pm * 256) * DM * 2; u.b = BT + (size_t)(4 + u.pn) * 256 * DM * 2; return true; }
        return false;
    }
};
struct SchedIn8 {
    const Params* p;
    __device__ __forceinline__ bool next(int i, pg8::Unit& u) const {
        int U;
        if (gridDim.x == 256) { const int c = blockIdx.x;
            if (c < 64) { if (i >= 1) return false; U = c; } else if (c < 192) { if (i >= 2) return false; U = 64 + (c - 64) * 2 + i; } else { if (i >= 3) return false; U = 320 + (c - 192) * 3 + i; }
        } else { const long L = (long)i * gridDim.x + blockIdx.x; if (L >= 512) return false; U = (int)L; }
        const int idx = U & 7;
        u.rows = nullptr; u.rows_lds = -1; u.nvalid = 256; u.e = 0; u.aux = 0; u.pm = U >> 3; u.pn = idx < 4 ? 12 + idx : 16 + idx;
        u.a = (const char*)(p->ws + WS_HX8) + (size_t)u.pm * 256 * DM;
        u.b = (const char*)(p->ws + WS_BTIN) + (idx < 4 ? (size_t)3072 * DM * 2 + (size_t)idx * 256 * DM : (size_t)5120 * DM * 2 + (size_t)(idx - 4) * 256 * DM); return true;
    }
};
struct EpiIn {
    const Params* p;
    __device__ __forceinline__ void operator()(const f32x4 (&acc)[2][2][4][2], const pg8::Unit& u, int wr, int wc, int fr, int fq) const {
        bf16_t* O; int ldc; bool act = false;
        if (u.aux == 0) { O = (bf16_t*)(p->ws + WS_P); ldc = PW; act = u.pn >= 16; } else { O = (bf16_t*)(p->ws + WS_PC); ldc = 2048; }
        const int row0 = u.pm * 256 + wr * 64 + fr, col0 = u.pn * 256 + wc * 32 + 8 * fq;
#pragma unroll
        for (int ai = 0; ai < 2; ++ai)
#pragma unroll
            for (int m = 0; m < 4; ++m) { bf16_t* rowp = O + (size_t)(row0 + ai * 128 + m * 16) * ldc + col0;
#pragma unroll
                for (int bj = 0; bj < 2; ++bj) { f32x4 v0 = acc[ai][bj][m][0], v1 = acc[ai][bj][m][1];
                    if (act) {
#pragma unroll
                        for (int j = 0; j < 4; ++j) { v0[j] = gelu_tanh_f(v0[j]); v1[j] = gelu_tanh_f(v1[j]); } }
                    u32x4 w; w.x = cvt_pk_bf16(v0[0], v0[1]); w.y = cvt_pk_bf16(v0[2], v0[3]); w.z = cvt_pk_bf16(v1[0], v1[1]); w.w = cvt_pk_bf16(v1[2], v1[3]);
                    *(u32x4*)(rowp + bj * 128) = w; } }
    }
};
struct SchedOut {
    const Params* p;
    __device__ __forceinline__ bool next(int i, pg8::Unit& u) const {
        const long L = (long)i * gridDim.x + blockIdx.x; if (L >= 512) return false;
        pg8::static_tile((int)L, 64, 8, u.pm, u.pn); u.rows = nullptr; u.rows_lds = -1; u.nvalid = 256; u.e = 0; u.aux = 0;
        u.a = (const char*)(p->ws + WS_YCAT) + (size_t)u.pm * 256 * DM * 2; u.b = (const char*)(p->ws + WS_BTOUT) + (size_t)u.pn * 256 * DM * 2; return true;
    }
};
struct EpiOut {
    const Params* p;
    __device__ __forceinline__ void operator()(const f32x4 (&acc)[2][2][4][2], const pg8::Unit& u, int wr, int wc, int fr, int fq) const {
        bf16_t* X1 = (bf16_t*)(p->ws + WS_X1); const float* pos = (const float*)(p->ws + WS_POS); const float* MOD = (const float*)(p->ws + WS_MOD); float* ST = (float*)(p->ws + WS_STATS);
        const int row0 = u.pm * 256 + wr * 64 + fr, col0 = u.pn * 256 + wc * 32 + 4 * fq;
        const int b = (u.pm * 256) / SEQ;
        f32x4 g1[2][2];
#pragma unroll
        for (int bj = 0; bj < 2; ++bj)
#pragma unroll
            for (int n = 0; n < 2; ++n) g1[bj][n] = *(const f32x4*)(MOD + (size_t)b * (NMOD * DM) + 2 * DM + col0 + bj * 128 + n * 16);
#pragma unroll
        for (int ai = 0; ai < 2; ++ai)
#pragma unroll
            for (int mp = 0; mp < 2; ++mp) {
                f32x4 xv[2][2][2], pv[2][2][2];
#pragma unroll
                for (int mm = 0; mm < 2; ++mm) { const int row = row0 + ai * 128 + (mp * 2 + mm) * 16; const int ts = row % SEQ, rr = ts >> 6, cc = ts & 63;
#pragma unroll
                    for (int bj = 0; bj < 2; ++bj)
#pragma unroll
                        for (int n = 0; n < 2; ++n) { const int col = col0 + bj * 128 + n * 16;
                            xv[mm][bj][n] = *(const f32x4*)(p->x + (size_t)row * DM + col);
                            pv[mm][bj][n] = *(const f32x4*)(col < 1024 ? pos + rr * 1024 + col : pos + 32 * 1024 + cc * 1024 + (col - 1024)); } }
#pragma unroll
                for (int mm = 0; mm < 2; ++mm) { const int m = mp * 2 + mm; const int row = row0 + ai * 128 + m * 16;
                    float s1 = 0.f, s2 = 0.f;
#pragma unroll
                    for (int bj = 0; bj < 2; ++bj)
#pragma unroll
                        for (int n = 0; n < 2; ++n) { const int col = col0 + bj * 128 + n * 16;
                            const f32x4 v = (xv[mm][bj][n] + pv[mm][bj][n]) * ALPHA + g1[bj][n] * acc[ai][bj][m][n];
                            { u32x2 o; o.x = pack2_h16(v[0], v[1]); o.y = pack2_h16(v[2], v[3]); *(u32x2*)(X1 + (size_t)row * DM + col) = o; }
                            s1 += (v[0] + v[1]) + (v[2] + v[3]); s2 += (v[0] * v[0] + v[1] * v[1]) + (v[2] * v[2] + v[3] * v[3]); }
                    s1 += __shfl_xor(s1, 16, 64); s2 += __shfl_xor(s2, 16, 64); s1 += __shfl_xor(s1, 32, 64); s2 += __shfl_xor(s2, 32, 64);
                    if (fq == 0) { atomicAdd(ST + (size_t)row * 2, s1); atomicAdd(ST + (size_t)row * 2 + 1, s2); } }
            }
    }
};
__device__ __forceinline__ bool moe_unit(int i, const LAS int* tab, int& P, int& nt) {
    const int G = gridDim.x, c = blockIdx.x;
    const int wgid = (G % 8 == 0) ? (c % 8) * (G / 8) + c / 8 : c;
    const long L = (long)i * G + wgid; P = (int)(L >> 3); nt = (int)(L & 7);
    return P < tab[160 * 4];
}
__device__ __forceinline__ void moe_build_table(const Params& p, LAS int* tab) {
    if (threadIdx.x == 0) {
        const unsigned* cnt = (const unsigned*)(p.ws + WS_CTL) + CW_CNT;
        int np = 0, off = 0;
        for (int e = 0; e < NE; ++e) { const int c = (int)cnt[e]; const int nmt = (c + 255) >> 8;
            for (int mt = 0; mt < nmt; ++mt) { tab[np * 4 + 0] = e; tab[np * 4 + 1] = mt; tab[np * 4 + 2] = off + mt * 256; tab[np * 4 + 3] = (c - mt * 256) < 256 ? (c - mt * 256) : 256; ++np; }
            off += nmt * 256; }
        tab[160 * 4] = np;
    }
    __syncthreads();
    LAS int* rl = (LAS int*)((LAS unsigned char*)tab - LDS_TAB + LDS_ROWS);
    for (int i = 0; i < 8; ++i) { int P, nt; if (!moe_unit(i, tab, P, nt)) break;
        const int e = tab[P * 4], mt = tab[P * 4 + 1];
        if (threadIdx.x < 256) rl[i * 256 + threadIdx.x] = ((const int*)(p.ws + WS_LIST))[(size_t)e * NTOK + mt * 256 + threadIdx.x]; }
    __syncthreads();
}
struct SchedMoe1 {
    const Params* p; const LAS int* tab;
    __device__ __forceinline__ bool next(int i, pg8::Unit& u) const {
        int P, nt; if (!moe_unit(i, tab, P, nt)) return false;
        const int e = tab[P * 4], mt = tab[P * 4 + 1];
        u.e = e; u.pm = P; u.pn = nt; u.aux = tab[P * 4 + 2]; u.nvalid = tab[P * 4 + 3];
        u.rows = nullptr; u.rows_lds = LDS_ROWS + i * 1024;
        u.a = (const char*)(p->ws + WS_T); u.b = (const char*)(p->ws + WS_BTGU) + (size_t)(e * 8 + nt) * 256 * DM; return true;
    }
};
struct EpiMoe1 {
    const Params* p;
    __device__ __forceinline__ void operator()(const f32x4 (&acc)[2][2][4][2], const pg8::Unit& u, int wr, int wc, int fr, int fq) const {
        unsigned char* H = (unsigned char*)(p->ws + WS_H);
        const int row0 = u.aux + wr * 64 + fr, col0 = u.pn * 128 + wc * 32 + 8 * fq;
#pragma unroll
        for (int ai = 0; ai < 2; ++ai)
#pragma unroll
            for (int m = 0; m < 4; ++m) { unsigned char* rowp = H + (size_t)(row0 + ai * 128 + m * 16) * DE + col0;
                float h[8];
#pragma unroll
                for (int n = 0; n < 2; ++n)
#pragma unroll
                    for (int j = 0; j < 4; ++j) h[n * 4 + j] = silu_f(acc[ai][0][m][n][j]) * acc[ai][1][m][n][j];
                u32x2 w; w.x = pack4_fp8(h[0], h[1], h[2], h[3]); w.y = pack4_fp8(h[4], h[5], h[6], h[7]);
                *(u32x2*)rowp = w; }
    }
};
struct SchedMoe2 {
    const Params* p; const LAS int* tab;
    __device__ __forceinline__ bool next(int i, pg8::Unit& u) const {
        int P, nt; if (!moe_unit(i, tab, P, nt)) return false;
        const int e = tab[P * 4], mt = tab[P * 4 + 1];
        u.e = LDS_ROWS + i * 1024; u.pm = P; u.pn = nt; u.aux = mt; u.nvalid = tab[P * 4 + 3]; u.rows = nullptr; u.rows_lds = -1;
        u.a = (const char*)(p->ws + WS_H) + (size_t)tab[P * 4 + 2] * DE; u.b = (const char*)(p->ws + WS_BTDN) + ((size_t)e * DM + nt * 256) * DE; return true;
    }
};
struct EpiMoe2 {
    const Params* p; LAS unsigned char* lds;
    __device__ __forceinline__ void operator()(const f32x4 (&acc)[2][2][4][2], const pg8::Unit& u, int wr, int wc, int fr, int fq) const {
        unsigned char* Y2 = (unsigned char*)(p->ws + WS_Y2);
        const LAS int* list = (const LAS int*)(lds + u.e);
        const int r0 = wr * 64 + fr, col0 = u.pn * 256 + wc * 32 + 8 * fq;
        int ents[2][4];
#pragma unroll
        for (int ai = 0; ai < 2; ++ai)
#pragma unroll
            for (int m = 0; m < 4; ++m) { const int r = r0 + ai * 128 + m * 16; ents[ai][m] = r < u.nvalid ? list[r] : 0; }
#pragma unroll
        for (int ai = 0; ai < 2; ++ai)
#pragma unroll
            for (int m = 0; m < 4; ++m) { const int r = r0 + ai * 128 + m * 16;
                if (r < u.nvalid) { const int ent = ents[ai][m]; unsigned char* rowp = Y2 + (size_t)ent * DM + col0;
#pragma unroll
                    for (int bj = 0; bj < 2; ++bj) { const f32x4 v0 = acc[ai][bj][m][0] * 16.0f, v1 = acc[ai][bj][m][1] * 16.0f;
                        u32x2 w; w.x = pack4_fp8(v0[0], v0[1], v0[2], v0[3]); w.y = pack4_fp8(v1[0], v1[1], v1[2], v1[3]);
                        *(u32x2*)(rowp + bj * 128) = w; } } }
    }
};

typedef short s16x4 __attribute__((ext_vector_type(4)));
__device__ __forceinline__ s16x4 tr16(const LAS unsigned char* p) { return __builtin_bit_cast(s16x4, __builtin_amdgcn_ds_read_tr16_b64_v4i16((LAS s16x4*)p)); }
__device__ __forceinline__ bf16x8 tr_frag(const LAS unsigned char* tile, int pitchB, int k0, int c0, int lane) {
    const int g = lane >> 4, i = lane & 15;
    const LAS unsigned char* a = tile + (k0 + 8 * g + (i >> 2)) * pitchB + (c0 + 4 * (i & 3)) * 2;
    const s16x4 lo = tr16(a), hi = tr16(a + 4 * pitchB);
    return (bf16x8){lo[0], lo[1], lo[2], lo[3], hi[0], hi[1], hi[2], hi[3]};
}
__device__ __forceinline__ bf16x8 row_frag(const LAS unsigned char* tile, int pitchB, int r0, int k0, int lane) {
    return *(const LAS bf16x8*)(tile + (r0 + (lane & 15)) * pitchB + (k0 + 8 * (lane >> 4)) * 2);
}
#define DPPF(old_, src_, ctrl_, rmask_) __int_as_float(__builtin_amdgcn_update_dpp(__float_as_int(old_), __float_as_int(src_), (ctrl_), (rmask_), 0xf, false))
__device__ __forceinline__ float row16_sum(float v) {
    v += DPPF(0.f, v, 0x128, 0xf); v += DPPF(0.f, v, 0x124, 0xf); v += DPPF(0.f, v, 0x122, 0xf); v += DPPF(0.f, v, 0x121, 0xf); return v;
}
__device__ __forceinline__ float wscan_sum(float v, int) {
    v += DPPF(0.f, v, 0x111, 0xf); v += DPPF(0.f, v, 0x112, 0xf); v += DPPF(0.f, v, 0x114, 0xf); v += DPPF(0.f, v, 0x118, 0xf);
    v += DPPF(0.f, v, 0x142, 0xa); v += DPPF(0.f, v, 0x143, 0xc); return v;
}
__device__ __forceinline__ float wscan_max(float v, int) {
    const float ninf = -3.0e38f;
    v = fmaxf(v, DPPF(ninf, v, 0x111, 0xf)); v = fmaxf(v, DPPF(ninf, v, 0x112, 0xf)); v = fmaxf(v, DPPF(ninf, v, 0x114, 0xf)); v = fmaxf(v, DPPF(ninf, v, 0x118, 0xf));
    v = fmaxf(v, DPPF(ninf, v, 0x142, 0xa)); v = fmaxf(v, DPPF(ninf, v, 0x143, 0xc)); return v;
}
__device__ __forceinline__ float wave_max(float v) {
#pragma unroll
    for (int o = 32; o > 0; o >>= 1) v = fmaxf(v, __shfl_xor(v, o, 64));
    return v;
}
__device__ __forceinline__ void conv8x8_load(const bf16_t* src, size_t pitch, int tfirst, int len, u32x4 (&raw)[10]) {
#pragma unroll
    for (int i = 0; i < 10; ++i) { const int ts = tfirst - 1 + i; raw[i] = (ts >= 0 && ts < len) ? *(const u32x4*)(src + (size_t)ts * pitch) : (u32x4){0u, 0u, 0u, 0u}; }
}
__device__ __forceinline__ void conv8x8_compute(const u32x4 (&raw)[10], const float* cw, const float* cb, int ch, float scale, LAS unsigned char* dst, int dpitchB) {
    float w0[8], w1[8], w2[8], bb[8];
#pragma unroll
    for (int j = 0; j < 8; ++j) { w0[j] = cw[ch + j]; w1[j] = cw[2048 + ch + j]; w2[j] = cw[4096 + ch + j]; bb[j] = cb[ch + j]; }
    float a[8], b[8], c[8];
    unpack8(raw[0], a); unpack8(raw[1], b);
#pragma unroll
    for (int r = 0; r < 8; ++r) {
        unpack8(raw[r + 2], c);
        float o[8];
#pragma unroll
        for (int j = 0; j < 8; ++j) o[j] = silu_f(bb[j] + w0[j] * a[j] + w1[j] * b[j] + w2[j] * c[j]) * scale;
        *(LAS u32x4*)(dst + r * dpitchB) = pack8(o);
#pragma unroll
        for (int j = 0; j < 8; ++j) { a[j] = b[j]; b[j] = c[j]; }
    }
}
__device__ __forceinline__ void conv8x8(const bf16_t* src, size_t pitch, int tfirst, int len, const float* cw, const float* cb, int ch, float scale, LAS unsigned char* dst, int dpitchB) {
    u32x4 raw[10]; conv8x8_load(src, pitch, tfirst, len, raw); conv8x8_compute(raw, cw, cb, ch, scale, dst, dpitchB);
}

constexpr int SC_V0 = 0, SC_V1 = 65536, SC_K = 131072, SC_VEC = SC_K + 18432;
struct ScanSrc { const bf16_t* src; size_t pitch; int kcol, vcol, len, t0, c; const float* grow; bool isx; };
__device__ __forceinline__ ScanSrc scan_src(const Params& p, int step, int b, int h, int dir, int es) {
    ScanSrc q; q.isx = step >= 2;
    q.c = q.isx ? (dir ? 17 - step : step - 2) : (dir ? 1 - step : step);
    q.src = q.isx ? (const bf16_t*)(p.ws + WS_P) + (size_t)(b * SEQ) * PW : (const bf16_t*)(p.ws + WS_PC) + (size_t)(b * CTXL) * 2048;
    q.pitch = q.isx ? PW : 2048;
    q.kcol = (q.isx ? 1024 : 0) + h * HD + es * 64; q.vcol = (q.isx ? 2048 : 1024) + h * HD; q.len = q.isx ? SEQ : CTXL; q.t0 = q.c * CHK;
    q.grow = (const float*)(p.ws + WS_GATES) + (size_t)(q.isx ? b * SEQ + q.t0 : NTOK + b * CTXL + q.t0) * NGATE + dir * 8 + h;
    return q;
}
__device__ __forceinline__ void scan_vdma(const ScanSrc& q, LAS unsigned char* vb, int wid, int lane) {
#pragma unroll
    for (int i = 0; i < 8; ++i) { const int row = 2 * (8 * wid + i) + (lane >> 5); const int gc = (lane & 31) ^ (row & 7);
        GLDS16(q.src + (size_t)(q.t0 + row) * q.pitch + q.vcol + gc * 8, vb + (8 * wid + i) * 1024); }
}
__device__ __forceinline__ bf16x8 tr_frag_swz(const LAS unsigned char* tile, int k0, int c0, int lane) {
    const int g = lane >> 4, i = lane & 15, r = i >> 2, col = c0 + 4 * (i & 3);
    const int row = k0 + 8 * g + r;
    const LAS unsigned char* a0 = tile + row * 512 + (((col >> 3) ^ r) << 4) + ((col & 4) << 1);
    const LAS unsigned char* a1 = tile + (row + 4) * 512 + (((col >> 3) ^ (r + 4)) << 4) + ((col & 4) << 1);
    const s16x4 lo = tr16(a0), hi = tr16(a1);
    return (bf16x8){lo[0], lo[1], lo[2], lo[3], hi[0], hi[1], hi[2], hi[3]};
}
__device__ __forceinline__ void conv4x8_load(const bf16_t* src, size_t pitch, int tfirst, int len, u32x4 (&raw)[6]) {
#pragma unroll
    for (int i = 0; i < 6; ++i) { const int ts = tfirst - 1 + i; raw[i] = (ts >= 0 && ts < len) ? *(const u32x4*)(src + (size_t)ts * pitch) : (u32x4){0u, 0u, 0u, 0u}; }
}
__device__ __forceinline__ void conv4x8_load_async(const bf16_t* src, size_t pitch, int tfirst, int len, u32x4 (&raw)[6]) {
#pragma unroll
    for (int i = 0; i < 6; ++i) { const int ts = tfirst - 1 + i; const bf16_t* a = src + (size_t)ts * pitch;
        raw[i] = (u32x4){0u, 0u, 0u, 0u};
        if (ts >= 0 && ts < len) asm volatile("global_load_dwordx4 %0, %1, off" : "+v"(raw[i]) : "v"(a) : "memory"); }
}
__device__ __forceinline__ void conv4x8_compute(const u32x4 (&raw)[6], const float (&w0)[8], const float (&w1)[8], const float (&w2)[8], const float (&bb)[8], const LAS float* wrow, LAS unsigned char* dst, int dpitchB) {
    float a[8], b[8], c[8];
    unpack8(raw[0], a); unpack8(raw[1], b);
#pragma unroll
    for (int r = 0; r < 4; ++r) {
        unpack8(raw[r + 2], c);
        const float sc = 0.0625f * wrow[r];
        float o[8];
#pragma unroll
        for (int j = 0; j < 8; ++j) o[j] = silu_f(bb[j] + w0[j] * a[j] + w1[j] * b[j] + w2[j] * c[j]) * sc;
        const u32x4 pk = pack8(o);
        *(LAS u32x2*)(dst + r * dpitchB) = (u32x2){pk.x, pk.y}; *(LAS u32x2*)(dst + r * dpitchB + 32) = (u32x2){pk.z, pk.w};
#pragma unroll
        for (int j = 0; j < 8; ++j) { a[j] = b[j]; b[j] = c[j]; }
    }
}
__device__ __forceinline__ void phase_scan(const Params& p, LAS unsigned char* lds) {
    const int tid = threadIdx.x, lane = tid & 63, wid = __builtin_amdgcn_readfirstlane(tid >> 6), wm = wid >> 1, wn = wid & 1;
    LAS float* wtab = (LAS float*)(lds + SC_VEC);
    LAS float* sbl = wtab + 18 * 128;
    bf16_t* CST = (bf16_t*)(p.ws + WS_CST); float* NST = (float*)(p.ws + WS_NST); float* MST = (float*)(p.ws + WS_MST);
    const int cg = tid & 7, rb = (tid >> 3) & 31;
    const bf16x8 ones = (bf16x8){0x3f80, 0x3f80, 0x3f80, 0x3f80, 0x3f80, 0x3f80, 0x3f80, 0x3f80};
    for (int unit0 = blockIdx.x; unit0 < 256; unit0 += gridDim.x) {
        const int es = (unit0 >> 3) & 3, combo = (unit0 >> 5) * 8 + (unit0 & 7);
        const int dir = combo & 1, h = (combo >> 1) & 3, b = combo >> 3;
        const int sidx = (b * 4 + h) * 2 + dir;
        const int s0 = dir ? 127 - lane : lane, s1 = dir ? 63 - lane : 64 + lane;
        asm volatile("s_waitcnt vmcnt(0) lgkmcnt(0)" ::: "memory"); __builtin_amdgcn_s_barrier();
        float cw0[8], cw1[8], cw2[8], cbb[8];
        { const int ch = 1024 + h * HD + es * 64 + cg * 8;
#pragma unroll
          for (int j = 0; j < 8; ++j) { cw0[j] = p.conv_w[ch + j]; cw1[j] = p.conv_w[2048 + ch + j]; cw2[j] = p.conv_w[4096 + ch + j]; cbb[j] = p.conv_b[ch + j]; } }
        u32x4 kraw[6];
        {   const ScanSrc q = scan_src(p, 0, b, h, dir, es);
            scan_vdma(q, lds + SC_V0, wid, lane);
            if (tid < 256) conv4x8_load_async(q.src + q.kcol + cg * 8, q.pitch, q.t0 + rb * 4, q.len, kraw); }
        for (int st = wid; st < 18; st += 8) {
            const ScanSrc q = scan_src(p, st, b, h, dir, es);
            const float li0 = q.grow[(size_t)s0 * NGATE], lf0 = q.grow[(size_t)s0 * NGATE + 4], li1 = q.grow[(size_t)s1 * NGATE], lf1 = q.grow[(size_t)s1 * NGATE + 4];
            const float b0 = wscan_sum(lf0, lane); const float tot0 = __shfl(b0, 63, 64); const float b1 = wscan_sum(lf1, lane) + tot0; const float blast = __shfl(b1, 63, 64);
            const float a0 = blast - b0 + li0, a1 = blast - b1 + li1;
            const float mloc = wave_max(fmaxf(a0, a1));
            wtab[st * 128 + s0] = a0; wtab[st * 128 + s1] = a1;
            if (lane == 0) { sbl[st] = blast; sbl[32 + st] = mloc; }
        }
        asm volatile("s_waitcnt lgkmcnt(0)" ::: "memory"); __builtin_amdgcn_s_barrier();
        if (tid == 0) { float m = 0.f;
            for (int st = 0; st < 18; ++st) { const float bl = sbl[st], ml = sbl[32 + st]; const float mn = fmaxf(bl + m, ml); sbl[64 + st] = __expf(bl + m - mn); sbl[96 + st] = m; sbl[128 + st] = mn; m = mn; } }
        asm volatile("s_waitcnt lgkmcnt(0)" ::: "memory"); __builtin_amdgcn_s_barrier();
        for (int i = tid; i < 18 * 128; i += 512) wtab[i] = __expf(wtab[i] - sbl[128 + (i >> 7)]);
        f32x4 acc[2][4], accn[2];
#pragma unroll
        for (int n = 0; n < 2; ++n) { accn[n] = (f32x4){0.f, 0.f, 0.f, 0.f};
#pragma unroll
            for (int m = 0; m < 4; ++m) acc[n][m] = (f32x4){0.f, 0.f, 0.f, 0.f}; }
#define SCAN_STEP(step, KCUR, KNXT) do { \
            const ScanSrc q = scan_src(p, (step), b, h, dir, es); \
            if ((step) >= 3) asm volatile("s_waitcnt vmcnt(4) lgkmcnt(0)" ::: "memory"); else asm volatile("s_waitcnt vmcnt(0) lgkmcnt(0)" ::: "memory");     \
            __builtin_amdgcn_s_barrier();      \
            if (q.isx) { \
                if (wm == 0 && (lane & 15) == 0) { _Pragma("unroll") for (int n = 0; n < 2; ++n) *(f32x4*)(NST + ((size_t)sidx * 16 + q.c) * 256 + es * 64 + 32 * wn + 8 * (lane >> 4) + 4 * n) = accn[n]; } \
                if (es == 0 && tid == 0) MST[sidx * 16 + q.c] = sbl[96 + (step)]; \
            } \
            if ((step) < 17) { const ScanSrc qn = scan_src(p, (step) + 1, b, h, dir, es); scan_vdma(qn, lds + (((step) + 1) & 1 ? SC_V1 : SC_V0), wid, lane); }     \
            if (tid < 256) conv4x8_compute(KCUR, cw0, cw1, cw2, cbb, wtab + (step) * 128 + rb * 4, lds + SC_K + (rb * 4) * 144 + (cg >> 2) * 64 + (cg & 3) * 8, 144); \
            if ((step) < 17 && tid < 256) { const ScanSrc qn = scan_src(p, (step) + 1, b, h, dir, es); conv4x8_load_async(qn.src + qn.kcol + cg * 8, qn.pitch, qn.t0 + rb * 4, qn.len, KNXT); } \
            asm volatile("" ::: "memory"); \
            if (q.isx) {                                                          \
                bf16_t* cdst = CST + ((size_t)sidx * 16 + q.c) * 65536 + es * 64 + 32 * wn + 8 * (lane >> 4); \
                _Pragma("unroll") for (int m = 0; m < 4; ++m) { u32x4 o; o.x = cvt_pk_bf16(acc[0][m][0], acc[0][m][1]); o.y = cvt_pk_bf16(acc[0][m][2], acc[0][m][3]); o.z = cvt_pk_bf16(acc[1][m][0], acc[1][m][1]); o.w = cvt_pk_bf16(acc[1][m][2], acc[1][m][3]); \
                        *(u32x4*)(cdst + (size_t)(64 * wm + 16 * m + (lane & 15)) * 256) = o; } \
            } \
            asm volatile("s_waitcnt lgkmcnt(0)" ::: "memory"); __builtin_amdgcn_s_barrier();                 \
            const LAS unsigned char* vt = lds + (((step) & 1) ? SC_V1 : SC_V0); \
            const float so = sbl[64 + (step)]; \
            _Pragma("unroll") for (int n = 0; n < 2; ++n) { accn[n] *= so; _Pragma("unroll") for (int m = 0; m < 4; ++m) acc[n][m] *= so; } \
            _Pragma("unroll") for (int ks = 0; ks < 4; ++ks) { \
                bf16x8 af[4], bfr[2]; \
                _Pragma("unroll") for (int m = 0; m < 4; ++m) af[m] = tr_frag_swz(vt, ks * 32, 64 * wm + 16 * m, lane); \
                _Pragma("unroll") for (int n = 0; n < 2; ++n) bfr[n] = tr_frag(lds + SC_K, 144, ks * 32, 32 * wn + 16 * n, lane); \
                _Pragma("unroll") for (int n = 0; n < 2; ++n) { accn[n] = __builtin_amdgcn_mfma_f32_16x16x32_bf16(bfr[n], ones, accn[n], 0, 0, 0); \
                    _Pragma("unroll") for (int m = 0; m < 4; ++m) acc[n][m] = __builtin_amdgcn_mfma_f32_16x16x32_bf16(bfr[n], af[m], acc[n][m], 0, 0, 0); } \
            } } while (0)
#pragma unroll 1
        for (int step = 0; step < 18; ++step) { SCAN_STEP(step, kraw, kraw); }
#undef SCAN_STEP
    }
    asm volatile("s_waitcnt vmcnt(0) lgkmcnt(0)" ::: "memory"); __builtin_amdgcn_s_barrier();
}

constexpr int MX_Q = 0, MX_K = 67584, MX_P = 100352, MX_VEC = 135168;
enum { V_GF = 0, V_GB = 128, V_MF = 256, V_MB = 384, V_SIF = 512, V_SIB = 640, V_EMF = 768, V_EMB = 896, V_RF = 1024, V_RB = 1152, V_AF = 1280, V_AB = 1408, V_DQF = 1536, V_DQB = 1664,
       V_NF = 1792, V_NB = 2048, V_RSF = 2304, V_RSB = 2816, V_END = 3328 };
__device__ __forceinline__ void mix_unit(const Params& p, LAS unsigned char* lds, int unit) {
    const int tid = threadIdx.x, lane = tid & 63, wid = __builtin_amdgcn_readfirstlane(tid >> 6), wm = wid >> 2, wn = wid & 3, lg = lane >> 4, li_ = lane & 15;
    LAS float* vec = (LAS float*)(lds + MX_VEC);
    const int c = unit & 15, h = (unit >> 4) & 3, b = unit >> 6;
    const bf16_t* P = (const bf16_t*)(p.ws + WS_P); const float* G = (const float*)(p.ws + WS_GATES);
    const bf16_t* CST = (const bf16_t*)(p.ws + WS_CST); const float* NST = (const float*)(p.ws + WS_NST); const float* MST = (const float*)(p.ws + WS_MST);
    const int sf = (b * 4 + h) * 2, sb = sf + 1;
    const int t0 = c * CHK; const size_t tok0 = (size_t)b * SEQ + t0;
    const bf16_t* srcb = P + (size_t)(b * SEQ) * PW;
    __syncthreads();
    float gq[5] = {0.f, 0.f, 0.f, 0.f, 0.f}, nfq = 0.f, nbq = 0.f;
    if (wid < 2) { const int dir = wid; const float* grow = G + tok0 * NGATE + dir * 8 + h; const int s0 = dir ? 127 - lane : lane, s1 = dir ? 63 - lane : 64 + lane;
        gq[0] = grow[(size_t)s0 * NGATE]; gq[1] = grow[(size_t)s0 * NGATE + 4]; gq[2] = grow[(size_t)s1 * NGATE]; gq[3] = grow[(size_t)s1 * NGATE + 4]; gq[4] = MST[(dir ? sb : sf) * 16 + c]; }
    if (tid < 256) { nfq = NST[((size_t)sf * 16 + c) * 256 + tid]; nbq = NST[((size_t)sb * 16 + c) * 256 + tid]; }
    { const int cg = tid & 31, rb = tid >> 5;
      u32x4 qraw[10], kraw[10];
      conv8x8_load(srcb + h * HD + cg * 8, PW, t0 + rb * 8, SEQ, qraw); conv8x8_load(srcb + 1024 + h * HD + cg * 8, PW, t0 + rb * 8, SEQ, kraw);
      conv8x8_compute(qraw, p.conv_w, p.conv_b, h * HD + cg * 8, 1.0f, lds + MX_Q + (rb * 8) * 528 + cg * 16, 528);
      conv8x8_compute(kraw, p.conv_w, p.conv_b, 1024 + h * HD + cg * 8, 0.0625f, lds + MX_K + (rb * 8) * 528 + cg * 16, 528); }
    if (tid < 256) { vec[V_NF + tid] = nfq; vec[V_NB + tid] = nbq; }
    if (wid < 2) {
        const int dir = wid;
        const int s0 = dir ? 127 - lane : lane, s1 = dir ? 63 - lane : 64 + lane;
        const float min_ = gq[4], li0 = gq[0], lf0 = gq[1], li1 = gq[2], lf1 = gq[3];
        const float b0 = wscan_sum(lf0, lane); const float tot0 = __shfl(b0, 63, 64); const float b1 = wscan_sum(lf1, lane) + tot0;
        const float g0 = li0 - b0, g1 = li1 - b1;
        const float cm0 = wscan_max(g0, lane); const float tm0 = __shfl(cm0, 63, 64); const float cm1 = fmaxf(wscan_max(g1, lane), tm0);
        const float M0 = fmaxf(min_, cm0), M1 = fmaxf(min_, cm1);
        const int o = dir * 128;
        vec[V_GF + o + s0] = g0; vec[V_GF + o + s1] = g1; vec[V_MF + o + s0] = M0; vec[V_MF + o + s1] = M1;
        vec[V_SIF + o + s0] = __expf(min_ - M0); vec[V_SIF + o + s1] = __expf(min_ - M1);
        vec[V_EMF + o + s0] = __expf(-b0 - M0); vec[V_EMF + o + s1] = __expf(-b1 - M1);
    }
    __syncthreads();
    f32x4 sacc[4][2];
#pragma unroll
    for (int m = 0; m < 4; ++m)
#pragma unroll
        for (int n = 0; n < 2; ++n) sacc[m][n] = (f32x4){0.f, 0.f, 0.f, 0.f};
#pragma unroll 2
    for (int ks = 0; ks < 8; ++ks) {
        bf16x8 af[4], bfr[2];
#pragma unroll
        for (int m = 0; m < 4; ++m) af[m] = row_frag(lds + MX_Q, 528, 64 * wm + 16 * m, ks * 32, lane);
#pragma unroll
        for (int n = 0; n < 2; ++n) bfr[n] = row_frag(lds + MX_K, 528, 32 * wn + 16 * n, ks * 32, lane);
#pragma unroll
        for (int m = 0; m < 4; ++m)
#pragma unroll
            for (int n = 0; n < 2; ++n) sacc[m][n] = __builtin_amdgcn_mfma_f32_16x16x32_bf16(af[m], bfr[n], sacc[m][n], 0, 0, 0);
    }
    {
        const int t = tid >> 2, part = tid & 3; float df = 0.f, db = 0.f;
#pragma unroll 4
        for (int i = 0; i < 8; ++i) { float f[8]; unpack8(*(const LAS u32x4*)(lds + MX_Q + t * 528 + (part * 64 + i * 8) * 2), f);
#pragma unroll
            for (int j = 0; j < 8; ++j) { df += f[j] * vec[V_NF + part * 64 + i * 8 + j]; db += f[j] * vec[V_NB + part * 64 + i * 8 + j]; } }
        df += __shfl_xor(df, 1, 64); df += __shfl_xor(df, 2, 64); db += __shfl_xor(db, 1, 64); db += __shfl_xor(db, 2, 64);
        if (part == 0) { vec[V_DQF + t] = df; vec[V_DQB + t] = db; }
    }
    f32x4 pf[4][2], pb[4][2];
    {
        float gf[2], gb[2];
#pragma unroll
        for (int n = 0; n < 2; ++n) { const int s_ = 32 * wn + 16 * n + li_; gf[n] = vec[V_GF + s_]; gb[n] = vec[V_GB + s_]; }
#pragma unroll
        for (int m = 0; m < 4; ++m)
#pragma unroll
            for (int j = 0; j < 4; ++j) {
                const int t = 64 * wm + 16 * m + 4 * lg + j; const float Mf = vec[V_MF + t], Mb = vec[V_MB + t];
                float rsf = 0.f, rsb = 0.f;
#pragma unroll
                for (int n = 0; n < 2; ++n) { const int s_ = 32 * wn + 16 * n + li_;
                    const float ef = (s_ <= t) ? __expf(fminf(gf[n] - Mf, 0.f)) : 0.f, eb = (s_ >= t) ? __expf(fminf(gb[n] - Mb, 0.f)) : 0.f;
                    const float sv = sacc[m][n][j]; pf[m][n][j] = sv * ef; pb[m][n][j] = sv * eb; rsf += pf[m][n][j]; rsb += pb[m][n][j]; }
                rsf = row16_sum(rsf); rsb = row16_sum(rsb);
                if (li_ == 0) { vec[V_RSF + t * 4 + wn] = rsf; vec[V_RSB + t * 4 + wn] = rsb; }
            }
    }
    __syncthreads();
    if (tid < 128) { const int t = tid;
        const float denf = vec[V_RSF + t * 4] + vec[V_RSF + t * 4 + 1] + vec[V_RSF + t * 4 + 2] + vec[V_RSF + t * 4 + 3] + vec[V_SIF + t] * vec[V_DQF + t];
        const float denb = vec[V_RSB + t * 4] + vec[V_RSB + t * 4 + 1] + vec[V_RSB + t * 4 + 2] + vec[V_RSB + t * 4 + 3] + vec[V_SIB + t] * vec[V_DQB + t];
        const float rf = 1.0f / fmaxf(fabsf(denf), vec[V_EMF + t]), rb = 1.0f / fmaxf(fabsf(denb), vec[V_EMB + t]);
        vec[V_RF + t] = rf; vec[V_RB + t] = rb; vec[V_AF + t] = rf * vec[V_SIF + t]; vec[V_AB + t] = rb * vec[V_SIB + t]; }
    __syncthreads();
#pragma unroll
    for (int m = 0; m < 4; ++m)
#pragma unroll
        for (int j = 0; j < 4; ++j) { const int t = 64 * wm + 16 * m + 4 * lg + j; const float rf = vec[V_RF + t], rb = vec[V_RB + t];
#pragma unroll
            for (int n = 0; n < 2; ++n) *(LAS bf16_t*)(lds + MX_P + t * 272 + (32 * wn + 16 * n + li_) * 2) = f2bf(rf * pf[m][n][j] + rb * pb[m][n][j]); }
    f32x4 acc[4][4];
    {
        const bf16_t* cqf = CST + ((size_t)sf * 16 + c) * 65536 + (size_t)(64 * wn + li_) * 256 + 8 * lg;
        const bf16_t* cqb = CST + ((size_t)sb * 16 + c) * 65536 + (size_t)(64 * wn + li_) * 256 + 8 * lg;
        bf16x8 bq0[4], bq1[4];
#pragma unroll
        for (int n = 0; n < 4; ++n) bq0[n] = *(const bf16x8*)(cqf + (size_t)(16 * n) * 256);
#pragma unroll 1
        for (int dirq = 0; dirq < 2; ++dirq) {
            f32x4 accx[4][4];
#pragma unroll
            for (int m = 0; m < 4; ++m)
#pragma unroll
                for (int n = 0; n < 4; ++n) accx[m][n] = (f32x4){0.f, 0.f, 0.f, 0.f};
            const bf16_t* cx = dirq ? cqb : cqf;
#pragma unroll 1
            for (int ks = 0; ks < 8; ks += 2) {
#pragma unroll
                for (int n = 0; n < 4; ++n) bq1[n] = *(const bf16x8*)(cx + (size_t)(16 * n) * 256 + (ks + 1) * 32);
                {   bf16x8 af[4];
#pragma unroll
                    for (int m = 0; m < 4; ++m) af[m] = row_frag(lds + MX_Q, 528, 64 * wm + 16 * m, ks * 32, lane);
#pragma unroll
                    for (int m = 0; m < 4; ++m)
#pragma unroll
                        for (int n = 0; n < 4; ++n) accx[m][n] = __builtin_amdgcn_mfma_f32_16x16x32_bf16(af[m], bq0[n], accx[m][n], 0, 0, 0); }
                {   const bf16_t* nx = ks < 6 ? cx + (ks + 2) * 32 : cqb;
#pragma unroll
                    for (int n = 0; n < 4; ++n) bq0[n] = *(const bf16x8*)(nx + (size_t)(16 * n) * 256); }
                {   bf16x8 af[4];
#pragma unroll
                    for (int m = 0; m < 4; ++m) af[m] = row_frag(lds + MX_Q, 528, 64 * wm + 16 * m, (ks + 1) * 32, lane);
#pragma unroll
                    for (int m = 0; m < 4; ++m)
#pragma unroll
                        for (int n = 0; n < 4; ++n) accx[m][n] = __builtin_amdgcn_mfma_f32_16x16x32_bf16(af[m], bq1[n], accx[m][n], 0, 0, 0); }
            }
#pragma unroll
            for (int m = 0; m < 4; ++m)
#pragma unroll
                for (int j = 0; j < 4; ++j) { const int t = 64 * wm + 16 * m + 4 * lg + j; const float a_x = vec[(dirq ? V_AB : V_AF) + t];
#pragma unroll
                    for (int n = 0; n < 4; ++n) acc[m][n][j] = dirq ? acc[m][n][j] + a_x * accx[m][n][j] : a_x * accx[m][n][j]; }
        }
    }
    u32x4 vreg[8];
#pragma unroll
    for (int i = 0; i < 8; ++i) { const int piece = tid + 512 * i; vreg[i] = *(const u32x4*)(srcb + (size_t)(t0 + (piece >> 5)) * PW + 2048 + h * HD + (piece & 31) * 8); }
    __syncthreads();
#pragma unroll
    for (int i = 0; i < 8; ++i) { const int piece = tid + 512 * i, row = piece >> 5; *(LAS u32x4*)(lds + MX_Q + row * 528 + (piece & 31) * 16) = vreg[i]; }
    __syncthreads();
#pragma unroll
    for (int ks = 0; ks < 4; ++ks) {
        bf16x8 af[4], bfr[4];
#pragma unroll
        for (int m = 0; m < 4; ++m) af[m] = row_frag(lds + MX_P, 272, 64 * wm + 16 * m, ks * 32, lane);
#pragma unroll
        for (int n = 0; n < 4; ++n) bfr[n] = tr_frag(lds + MX_Q, 528, ks * 32, 64 * wn + 16 * n, lane);
#pragma unroll
        for (int m = 0; m < 4; ++m)
#pragma unroll
            for (int n = 0; n < 4; ++n) acc[m][n] = __builtin_amdgcn_mfma_f32_16x16x32_bf16(af[m], bfr[n], acc[m][n], 0, 0, 0);
    }
    u32x4 oraw[8];
#pragma unroll
    for (int i = 0; i < 8; ++i) { const int piece = tid + 512 * i; oraw[i] = *(const u32x4*)(P + (tok0 + (piece >> 5)) * PW + 3072 + h * HD + (piece & 31) * 8); }
#pragma unroll
    for (int m = 0; m < 4; ++m)
#pragma unroll
        for (int j = 0; j < 4; ++j) { const float sm = row16_sum(acc[m][0][j] + acc[m][1][j] + acc[m][2][j] + acc[m][3][j]);
            if (li_ == 0) vec[V_RSF + (64 * wm + 16 * m + 4 * lg + j) * 4 + wn] = sm; }
    __syncthreads();
    float mu[4][4];
#pragma unroll
    for (int m = 0; m < 4; ++m)
#pragma unroll
        for (int j = 0; j < 4; ++j) { const int t = 64 * wm + 16 * m + 4 * lg + j;
            mu[m][j] = (vec[V_RSF + t * 4] + vec[V_RSF + t * 4 + 1] + vec[V_RSF + t * 4 + 2] + vec[V_RSF + t * 4 + 3]) * (1.0f / 256.0f);
            float sq = 0.f;
#pragma unroll
            for (int n = 0; n < 4; ++n) { const float dl = acc[m][n][j] - mu[m][j]; sq += dl * dl; }
            sq = row16_sum(sq);
            if (li_ == 0) vec[V_RSB + t * 4 + wn] = sq; }
    __syncthreads();
#pragma unroll
    for (int m = 0; m < 4; ++m)
#pragma unroll
        for (int j = 0; j < 4; ++j) { const int t = 64 * wm + 16 * m + 4 * lg + j;
            const float rstd = rsqrtf((vec[V_RSB + t * 4] + vec[V_RSB + t * 4 + 1] + vec[V_RSB + t * 4 + 2] + vec[V_RSB + t * 4 + 3]) * (1.0f / 256.0f) + LN_EPS);
#pragma unroll
            for (int n = 0; n < 4; ++n) *(LAS float*)(lds + (t * 260 + 64 * wn + 16 * n + li_) * 4) = (acc[m][n][j] - mu[m][j]) * rstd; }
    __syncthreads();
    bf16_t* Y = (bf16_t*)(p.ws + WS_YCAT);
#pragma unroll
    for (int i = 0; i < 8; ++i) { const int piece = tid + 512 * i, row = piece >> 5, dg = piece & 31; const int col = h * HD + dg * 8;
        float o[8]; unpack8(oraw[i], o);
        const f32x4 h0 = *(const LAS f32x4*)(lds + (row * 260 + dg * 8) * 4), h1 = *(const LAS f32x4*)(lds + (row * 260 + dg * 8 + 4) * 4);
        const f32x4 w0 = *(const f32x4*)(p.mlstm_norm_w + col), w1 = *(const f32x4*)(p.mlstm_norm_w + col + 4);
        float y[8];
#pragma unroll
        for (int j = 0; j < 4; ++j) { y[j] = h0[j] * w0[j] * sigmoid_f(o[j]); y[4 + j] = h1[j] * w1[j] * sigmoid_f(o[4 + j]); }
        *(u32x4*)(Y + (tok0 + row) * DM + col) = pack8(y); }
}

constexpr int CM_W = 0, CM_V = 34816;
__device__ __forceinline__ void cmlp_unit(const Params& p, LAS unsigned char* lds, int unit) {
    const int tid = threadIdx.x, lane = tid & 63, wid = __builtin_amdgcn_readfirstlane(tid >> 6), wm = wid >> 2, wn = wid & 3, lg = lane >> 4, li_ = lane & 15;
    const int g = unit & 3, bc = unit >> 2;
    const size_t tok0 = (size_t)bc * CHK;
    const bf16_t* P = (const bf16_t*)(p.ws + WS_P);
    __syncthreads();
#pragma unroll
    for (int i = 0; i < 8; ++i) { const int idx = tid + 512 * i, row = idx >> 5, c4 = idx & 31;
        const float4 w = *(const float4*)(p.w_s + ((size_t)g * CHK + row) * CHK + c4 * 4);
        u32x2 o; o.x = cvt_pk_bf16(w.x, w.y); o.y = cvt_pk_bf16(w.z, w.w);
        *(LAS u32x2*)(lds + CM_W + row * 272 + c4 * 8) = o; }
#pragma unroll 2
    for (int i = 0; i < 8; ++i) { const int piece = tid + 512 * i, row = piece >> 5, dg = piece & 31;
        float f[8]; unpack8(*(const u32x4*)(P + (tok0 + row) * PW + 5120 + g * 256 + dg * 8), f);
        float sm = 0.f;
#pragma unroll
        for (int j = 0; j < 8; ++j) sm += f[j];
        sm = row16_sum(sm); sm += __shfl_xor(sm, 16, 64);
        const float mu = sm * (1.0f / 256.0f); float sq = 0.f;
#pragma unroll
        for (int j = 0; j < 8; ++j) { f[j] -= mu; sq += f[j] * f[j]; }
        sq = row16_sum(sq); sq += __shfl_xor(sq, 16, 64);
        const float rstd = rsqrtf(sq * (1.0f / 256.0f) + LN_EPS);
#pragma unroll
        for (int j = 0; j < 8; ++j) f[j] = f[j] * rstd * p.cmlp_norm_w[g * 256 + dg * 8 + j];
        *(LAS u32x4*)(lds + CM_V + row * 528 + dg * 16) = pack8(f); }
    __syncthreads();
    f32x4 acc[4][4];
#pragma unroll
    for (int m = 0; m < 4; ++m)
#pragma unroll
        for (int n = 0; n < 4; ++n) acc[m][n] = (f32x4){0.f, 0.f, 0.f, 0.f};
#pragma unroll
    for (int ks = 0; ks < 4; ++ks) {
        bf16x8 af[4], bfr[4];
#pragma unroll
        for (int m = 0; m < 4; ++m) af[m] = row_frag(lds + CM_W, 272, 64 * wm + 16 * m, ks * 32, lane);
#pragma unroll
        for (int n = 0; n < 4; ++n) bfr[n] = tr_frag(lds + CM_V, 528, ks * 32, 64 * wn + 16 * n, lane);
#pragma unroll
        for (int m = 0; m < 4; ++m)
#pragma unroll
            for (int n = 0; n < 4; ++n) acc[m][n] = __builtin_amdgcn_mfma_f32_16x16x32_bf16(af[m], bfr[n], acc[m][n], 0, 0, 0);
    }
    __syncthreads();
#pragma unroll
    for (int m = 0; m < 4; ++m)
#pragma unroll
        for (int j = 0; j < 4; ++j) { const int pp = 64 * wm + 16 * m + 4 * lg + j; const float bs = p.b_s[g * CHK + pp];
#pragma unroll
            for (int n = 0; n < 4; ++n) *(LAS float*)(lds + (pp * 260 + 64 * wn + 16 * n + li_) * 4) = acc[m][n][j] + bs; }
    __syncthreads();
    bf16_t* Y = (bf16_t*)(p.ws + WS_YCAT);
#pragma unroll 2
    for (int i = 0; i < 8; ++i) { const int piece = tid + 512 * i, row = piece >> 5, dg = piece & 31;
        float u[8]; unpack8(*(const u32x4*)(P + (tok0 + row) * PW + 4096 + g * 256 + dg * 8), u);
        const f32x4 s0 = *(const LAS f32x4*)(lds + (row * 260 + dg * 8) * 4), s1 = *(const LAS f32x4*)(lds + (row * 260 + dg * 8 + 4) * 4);
        float y[8];
#pragma unroll
        for (int j = 0; j < 4; ++j) { y[j] = u[j] * s0[j]; y[4 + j] = u[4 + j] * s1[j]; }
        *(u32x4*)(Y + (tok0 + row) * DM + 1024 + g * 256 + dg * 8) = pack8(y); }
}
__device__ __forceinline__ void phase_mix(const Params& p, LAS unsigned char* lds) {
#pragma unroll 1
    for (int u = blockIdx.x; u < 512; u += gridDim.x) mix_unit(p, lds, u);
#pragma unroll 1
    for (int u = blockIdx.x; u < 512; u += gridDim.x) cmlp_unit(p, lds, u);
    __syncthreads();
}

#define XB_TMO      128
#define XB_XCNT(j)  (256  + 64 * (j))
#define XB_XSUB(j)  (1280 + 64 * (j))
#define XB_XGEN(j)  (2304 + 64 * (j))
#define XB_TOP      3328
#define XB_TOPGEN   3392
#define XCD_BAR_WORDS 3456
#define XB_SPIN_CAP (1u << 18)

__device__ __forceinline__ unsigned xb_ld(unsigned* p)              { return __hip_atomic_load(p, __ATOMIC_RELAXED, __HIP_MEMORY_SCOPE_AGENT); }
__device__ __forceinline__ unsigned xb_add(unsigned* p, unsigned v) { return __hip_atomic_fetch_add(p, v, __ATOMIC_RELAXED, __HIP_MEMORY_SCOPE_AGENT); }
__device__ __forceinline__ unsigned xb_xcc_id() { return (unsigned)__builtin_amdgcn_s_getreg((3 << 11) | 20) & 0xFu; }
#define XB_SPIN(cond, bar) do { unsigned _sp = 0; while (cond) { __builtin_amdgcn_s_sleep(1); \
    if ((++_sp & 255u) == 0u) { if (xb_ld(&(bar)[XB_TMO])) break; if (_sp > XB_SPIN_CAP) { atomicAdd(&(bar)[XB_TMO], 1u); break; } } } } while (0)

struct XcdBarrier {
    unsigned* bar; unsigned x;
    volatile LAS unsigned* st;
};
__device__ __forceinline__ XcdBarrier xcd_barrier_post(unsigned* bar, volatile LAS unsigned* st) {
    XcdBarrier b; b.bar = bar; b.x = xb_xcc_id(); b.st = st;
    if (threadIdx.x == 0) (void)xb_add(&bar[XB_XCNT(b.x)], 1u);
    return b;
}
__device__ __forceinline__ void xcd_barrier_complete(unsigned* bar, unsigned x, unsigned& nloc, unsigned& nx) {
    const unsigned G = gridDim.x * gridDim.y * gridDim.z;
    unsigned sum, cnt, mine, sp = 0u;
    for (;;) {
        sum = 0u; cnt = 0u; mine = 0u;
#pragma unroll
        for (unsigned j = 0; j < 16; ++j) { const unsigned c = xb_ld(&bar[XB_XCNT(j)]); sum += c; cnt += (c > 0u) ? 1u : 0u; mine = (j == x) ? c : mine; }
        if (sum == G) break;
        __builtin_amdgcn_s_sleep(1);
        if ((++sp & 255u) == 0u) { if (xb_ld(&bar[XB_TMO])) break; if (sp > XB_SPIN_CAP) { atomicAdd(&bar[XB_TMO], 1u); break; } }
    }
    nloc = mine > 0u ? mine : 1u; nx = cnt > 0u ? cnt : 1u;
}
__device__ __forceinline__ void xcd_barrier(const XcdBarrier& b) {
    asm volatile("s_waitcnt vmcnt(0)" ::: "memory");
    __syncthreads();
    if (threadIdx.x == 0) {
        unsigned* bar = b.bar;
        __builtin_amdgcn_s_waitcnt(0);
        unsigned nloc = b.st[0], nx = b.st[1];
        if (nloc == 0u) { xcd_barrier_complete(bar, b.x, nloc, nx); b.st[0] = nloc; b.st[1] = nx; }
        const unsigned old = xb_add(&bar[XB_XSUB(b.x)], 1u);
        const unsigned gen = old / nloc;
        if (old + 1u == (gen + 1u) * nloc) {
            __builtin_amdgcn_fence(__ATOMIC_RELEASE, "agent");
            asm volatile("s_waitcnt vmcnt(0)" ::: "memory");
            const unsigned og = xb_add(&bar[XB_TOP], 1u);
            const unsigned tg = og / nx;
            if (og + 1u == (tg + 1u) * nx) xb_add(&bar[XB_TOPGEN], 1u);
            else XB_SPIN(xb_ld(&bar[XB_TOPGEN]) == tg, bar);
            __builtin_amdgcn_fence(__ATOMIC_ACQUIRE, "agent");
            xb_add(&bar[XB_XGEN(b.x)], 1u);
            asm volatile("s_waitcnt vmcnt(0)" ::: "memory");
        } else {
            XB_SPIN(xb_ld(&bar[XB_XGEN(b.x)]) == gen, bar);
            __builtin_amdgcn_fence(__ATOMIC_ACQUIRE, "agent");
            asm volatile("s_waitcnt vmcnt(0)" ::: "memory");
        }
    }
    __syncthreads();
}

enum { PH_PREP = 0, PH_HX = 1, PH_INPROJ = 2, PH_SCAN = 3, PH_MIX = 4, PH_OUTPROJ = 5, PH_LN1 = 6, PH_MOE1 = 7, PH_MOE2 = 8, PH_FINAL = 9, PH_END = 10 };
#ifndef DUP_PHASE
#define DUP_PHASE (-1)
#endif
constexpr int CW_BAR = 256;
__global__ void __launch_bounds__(512, 2) fwd(Params p, int lo, int hi) {
    extern __shared__ __attribute__((aligned(16))) unsigned char shm[];
    LAS unsigned char* lds = (LAS unsigned char*)shm;
    if (threadIdx.x < 4) ((LAS unsigned*)(lds + LDS_MISC))[threadIdx.x] = 0u;
    __syncthreads();
    XcdBarrier bar; bar.bar = (unsigned*)(p.ws + WS_CTL) + CW_BAR; bar.x = 0; bar.st = (volatile LAS unsigned*)(lds + LDS_MISC);
    if (hi - lo > 1) bar = xcd_barrier_post((unsigned*)(p.ws + WS_CTL) + CW_BAR, (volatile LAS unsigned*)(lds + LDS_MISC));
#define IN(k) (lo <= (k) && (k) < hi)
#define SEAM(k) do { if (IN(k) && IN((k) + 1)) xcd_barrier(bar); } while (0)
#define PHASE(k, ...) do { if (IN(k)) { __VA_ARGS__; if (DUP_PHASE == (k)) { xcd_barrier(bar); __VA_ARGS__; } } SEAM(k); } while (0)
    PHASE(PH_PREP, { phase_mod(p, lds); phase_postab(p); phase_convert(p, lds, 0, gridDim.x == 256 ? CONV_ITEMS_ALL - CONV_TAIL - CONV_TAIL2 : CONV_ITEMS_ALL, blockIdx.x, gridDim.x); });
    PHASE(PH_HX, phase_hx(p, lds));
    PHASE(PH_INPROJ, { { SchedIn S{&p}; EpiIn E{&p}; pg8::gemm_phase<true, false>(lds, DM * 2, S, E); }
        { SchedIn8 S{&p}; EpiIn E{&p}; pg8::gemm_phase<true, true>(lds, DM, S, E); }
        if (gridDim.x == 256 && blockIdx.x >= 64 && blockIdx.x < 192) {
            const int f = CONV_ITEMS_ALL - CONV_TAIL + ((int)blockIdx.x - 64) * CT_B1; phase_convert(p, lds, f, f + CT_B1, 0, 1); } });
    PHASE(PH_SCAN, phase_scan(p, lds));
    PHASE(PH_MIX, phase_mix(p, lds));
    PHASE(PH_OUTPROJ, { SchedOut S{&p}; EpiOut E{&p}; pg8::gemm_phase<false, false>(lds, DM * 2, S, E); });
    PHASE(PH_LN1, phase_ln1(p, lds));
    PHASE(PH_MOE1, { LAS int* tab = (LAS int*)(lds + LDS_TAB); moe_build_table(p, tab); { SchedMoe1 S{&p, tab}; EpiMoe1 E{&p}; pg8::gemm_phase<true, true>(lds, DM, S, E); }
        if (gridDim.x == 256) {
            const int np8 = tab[160 * 4] * 8, R = (np8 + 255) >> 8, nl = np8 - (R - 1) * 256; const int c = blockIdx.x, wg = (c % 8) * 32 + c / 8;
            int rank = wg - nl, cnt = 256 - nl; if (cnt < 64) { rank = wg; cnt = 256; }
            const int f = CONV_ITEMS_ALL - CONV_TAIL - CONV_TAIL2;
            if (rank >= 0) phase_convert(p, lds, f, f + CONV_TAIL2, rank, cnt); } });
    PHASE(PH_MOE2, { LAS int* tab = (LAS int*)(lds + LDS_TAB); moe_build_table(p, tab); SchedMoe2 S{&p, tab}; EpiMoe2 E{&p, lds}; pg8::gemm_phase<true, true>(lds, DE, S, E); });
    PHASE(PH_FINAL, phase_final(p, lds));
#undef PHASE
#undef IN
#undef SEAM
}

#ifndef MK_N_LAUNCHES
#define MK_N_LAUNCHES 1
#endif
extern "C" void kernel_launch(void* const* d_in, const int* in_sizes, int n_in, void* d_out, int out_size, void* d_ws, size_t ws_size, hipStream_t stream) {
    static int grid = 0;
    if (grid == 0) {
        if (n_in != 26 || out_size != NTOK * DM || ws_size < WS_END) { fprintf(stderr, "kernel_launch: unexpected shapes: n_in %d out %d ws %zu (need %zu)\n", n_in, out_size, ws_size, (size_t)WS_END); grid = -1; return; }
        int dev = 0, cus = 0, per_cu = 0;
        if (hipGetDevice(&dev) != hipSuccess || hipDeviceGetAttribute(&cus, hipDeviceAttributeMultiprocessorCount, dev) != hipSuccess) { grid = -1; return; }
        if (hipFuncSetAttribute((const void*)fwd, hipFuncAttributeMaxDynamicSharedMemorySize, LDS_TOTAL) != hipSuccess) { fprintf(stderr, "kernel_launch: hipFuncSetAttribute failed\n"); grid = -1; return; }
        if (hipOccupancyMaxActiveBlocksPerMultiprocessor(&per_cu, (const void*)fwd, 512, LDS_TOTAL) != hipSuccess || per_cu < 1) { fprintf(stderr, "kernel_launch: occupancy query says %d\n", per_cu); }
        (void)hipGetLastError();
        grid = cus;
    }
    if (grid < 0) return;
    Params p{};
    const float* const* in = (const float* const*)d_in;
    p.x = in[0]; p.c = in[1]; p.ctx = in[2]; p.c_ctx = in[3]; p.w_mod = in[4]; p.b_mod = in[5]; p.w_in = in[6]; p.conv_w = in[7]; p.conv_b = in[8]; p.gate_bias = in[9];
    p.mlstm_norm_w = in[10]; p.cmlp_norm_w = in[11]; p.w_s = in[12]; p.b_s = in[13]; p.w_out = in[14]; p.ln1_w = in[15]; p.ln1_b = in[16];
    p.r1_w = in[17]; p.r1_b = in[18]; p.r2_w = in[19]; p.r2_b = in[20]; p.w_gate = in[21]; p.w_up = in[22]; p.w_down = in[23]; p.ln2_w = in[24]; p.ln2_b = in[25];
    p.out = (float*)d_out; p.ws = (unsigned char*)d_ws;
    (void)hipMemsetAsync(p.ws, 0, WS_ZERO_END, stream);
#if MK_N_LAUNCHES == 1
    fwd<<<grid, 512, LDS_TOTAL, stream>>>(p, 0, PH_END);
#else
    for (int ph = 0; ph < PH_END; ++ph) fwd<<<grid, 512, LDS_TOTAL, stream>>>(p, ph, ph + 1);
#endif
}
```
